# Optimizing an MI355X kernel written in HIP

```python
import math
import jax, jax.numpy as jnp
from jax import lax
import numpy as np

D_MODEL = 4096
BATCH = 4
SEQ = 4096
DEPTH = 1

HEAD_DIM = 128
ATTN_GROUPS = ((128, 1), (512, 4), (2048, 16))
N_ATTN_GROUPS = len(ATTN_GROUPS)
HEADS_PER_GROUP = D_MODEL // 512
ATTN_WIDTH = HEADS_PER_GROUP * HEAD_DIM
ATTN_QKV_WIDTH = N_ATTN_GROUPS * ATTN_WIDTH
BAND_BLOCK = 128
SGU_WIDTH = D_MODEL // 2
SGU_GROUP_CH = 128
SGU_GROUPS = SGU_WIDTH // SGU_GROUP_CH
CHUNK = 128
IN_WIDTH = 3 * ATTN_QKV_WIDTH + 2 * SGU_WIDTH
ROPE_THETA = 500000.0
ROT_DIM = HEAD_DIM // 4
XA_HEADS = 4
XA_WIDTH = XA_HEADS * HEAD_DIM
N_MEM = 256
D_FF = 4 * D_MODEL
EPS = 1e-6
NEG = -1e30

kernel_name = "hybrid_dilated_attn_gmlp_gated_block"


def rms_norm(x, g):
    x32 = x.astype(jnp.float32)
    y = x32 * lax.rsqrt(jnp.mean(x32 * x32, axis=-1, keepdims=True) + EPS)
    return (y * g.astype(jnp.float32)).astype(x.dtype)


def layer_norm(x, g, b):
    x32 = x.astype(jnp.float32)
    mu = jnp.mean(x32, axis=-1, keepdims=True)
    var = jnp.mean(jnp.square(x32 - mu), axis=-1, keepdims=True)
    y = (x32 - mu) * lax.rsqrt(var + EPS)
    return (y * g.astype(jnp.float32) + b.astype(jnp.float32)).astype(x.dtype)


def rope_tables(positions):
    inv = ROPE_THETA ** (-jnp.arange(0, ROT_DIM, 2, dtype=jnp.float32) / ROT_DIM)
    ang = positions.astype(jnp.float32)[..., None] * inv
    return jnp.cos(ang), jnp.sin(ang)


def apply_partial_rope(t, cos, sin):
    c = cos[:, :, None, None, :].astype(t.dtype)
    s = sin[:, :, None, None, :].astype(t.dtype)
    half = ROT_DIM // 2
    t1, t2, rest = t[..., :half], t[..., half:ROT_DIM], t[..., ROT_DIM:]
    return jnp.concatenate([t1 * c - t2 * s, t2 * c + t1 * s, rest], axis=-1)


def banded_causal_attention(q, k, v, n_back):
    N, L, H, hd = q.shape
    nb = -(-L // BAND_BLOCK)
    Lp = nb * BAND_BLOCK
    pad = Lp - L
    qb = jnp.pad(q, ((0, 0), (0, pad), (0, 0), (0, 0))).reshape(N, nb, BAND_BLOCK, H, hd)
    kp = jnp.pad(k, ((0, 0), (BAND_BLOCK, pad), (0, 0), (0, 0))).reshape(N, nb + 1, BAND_BLOCK, H, hd)
    vp = jnp.pad(v, ((0, 0), (BAND_BLOCK, pad), (0, 0), (0, 0))).reshape(N, nb + 1, BAND_BLOCK, H, hd)
    kw = jnp.concatenate([kp[:, :-1], kp[:, 1:]], axis=2)
    vw = jnp.concatenate([vp[:, :-1], vp[:, 1:]], axis=2)
    qi = jnp.arange(BAND_BLOCK)[:, None]
    kj = jnp.arange(2 * BAND_BLOCK)[None, :]
    dist = qi + BAND_BLOCK - kj
    keypos = jnp.arange(nb)[:, None, None] * BAND_BLOCK - BAND_BLOCK + kj[None]
    mask = (dist >= 0)[None] & (dist <= n_back)[None] & (keypos >= 0)
    s = jnp.einsum('nbqhd,nbkhd->nbhqk', qb, kw).astype(jnp.float32)
    s = jnp.where(mask[None, :, None], s, NEG)
    lse = jax.nn.logsumexp(s, axis=-1)
    p = jnp.exp(s - lse[..., None])
    o = jnp.einsum('nbhqk,nbkhd->nbqhd', p.astype(v.dtype), vw)
    o = o.reshape(N, Lp, H, hd)[:, :L]
    lse = lse.transpose(0, 1, 3, 2).reshape(N, Lp, H)[:, :L]
    return o, lse


def dilated_causal_attention(q, k, v, window, dilation):
    B, S, H, hd = q.shape
    L = S // dilation

    def to_res(t):
        return t.reshape(B, L, dilation, H, hd).transpose(0, 2, 1, 3, 4).reshape(B * dilation, L, H, hd)

    o, lse = banded_causal_attention(to_res(q), to_res(k), to_res(v), window // dilation)
    o = o.reshape(B, dilation, L, H, hd).transpose(0, 2, 1, 3, 4).reshape(B, S, H, hd)
    lse = lse.reshape(B, dilation, L, H).transpose(0, 2, 1, 3).reshape(B, S, H)
    return o, lse


def setup_inputs(seed: int = 0) -> dict:
    key = jax.random.key(seed)
    ks = jax.random.split(key, 32)
    f32 = jnp.float32

    def nrm(k, shape, fan_in):
        return jax.random.normal(k, shape, f32) * (fan_in ** -0.5)

    def gain(k, shape):
        return 1.0 + 0.05 * jax.random.normal(k, shape, f32)

    x = jax.random.normal(ks[0], (BATCH, SEQ, D_MODEL), f32)
    mem = jax.random.normal(ks[1], (BATCH, N_MEM, D_MODEL), f32)
    offset = jax.random.randint(ks[2], (BATCH, 1), 0, 1024, dtype=jnp.int32)
    positions = offset + jnp.arange(SEQ, dtype=jnp.int32)[None, :]
    return {
        "x": x,
        "mem": mem,
        "positions": positions,
        "mix_pre_g": gain(ks[3], (DEPTH, D_MODEL)),
        "w_in": nrm(ks[4], (DEPTH, D_MODEL, IN_WIDTH), D_MODEL),
        "sgu_ln_g": gain(ks[5], (DEPTH, SGU_WIDTH)),
        "sgu_ln_b": 0.01 * jax.random.normal(ks[6], (DEPTH, SGU_WIDTH), f32),
        "w_spatial": nrm(ks[7], (DEPTH, SGU_GROUPS, CHUNK, CHUNK), CHUNK),
        "b_spatial": 1.0 + 0.01 * jax.random.normal(ks[8], (DEPTH, SGU_GROUPS, CHUNK), f32),
        "w_branch_a": nrm(ks[9], (DEPTH, ATTN_WIDTH, D_MODEL), ATTN_WIDTH),
        "w_branch_b": nrm(ks[10], (DEPTH, SGU_WIDTH, D_MODEL), SGU_WIDTH),
        "w_gate": nrm(ks[11], (DEPTH, D_MODEL, 2 * D_MODEL), D_MODEL),
        "b_gate": 0.01 * jax.random.normal(ks[12], (DEPTH, 2 * D_MODEL), f32),
        "w_out": nrm(ks[13], (DEPTH, D_MODEL, D_MODEL), D_MODEL),
        "mix_post_g": gain(ks[14], (DEPTH, D_MODEL)),
        "xa_pre_g": gain(ks[15], (DEPTH, D_MODEL)),
        "mem_norm_g": gain(ks[16], (DEPTH, D_MODEL)),
        "w_xq": nrm(ks[17], (DEPTH, D_MODEL, XA_WIDTH), D_MODEL),
        "w_xk": nrm(ks[18], (DEPTH, D_MODEL, XA_WIDTH), D_MODEL),
        "w_xv": nrm(ks[19], (DEPTH, D_MODEL, XA_WIDTH), D_MODEL),
        "w_xo": nrm(ks[20], (DEPTH, XA_WIDTH, D_MODEL), XA_WIDTH),
        "xa_post_g": gain(ks[21], (DEPTH, D_MODEL)),
        "mlp_pre_g": gain(ks[22], (DEPTH, D_MODEL)),
        "w_up": nrm(ks[23], (DEPTH, D_MODEL, D_FF), D_MODEL),
        "w_down": nrm(ks[24], (DEPTH, D_FF, D_MODEL), D_FF),
        "mlp_post_g": gain(ks[25], (DEPTH, D_MODEL)),
    }


def reference(x, mem, positions, mix_pre_g, w_in, sgu_ln_g, sgu_ln_b, w_spatial, b_spatial,
              w_branch_a, w_branch_b, w_gate, b_gate, w_out, mix_post_g, xa_pre_g, mem_norm_g,
              w_xq, w_xk, w_xv, w_xo, xa_post_g, mlp_pre_g, w_up, w_down, mlp_post_g):
    B, S, _ = x.shape
    M = mem.shape[1]
    dt = x.dtype
    scale = HEAD_DIM ** -0.5
    cos, sin = rope_tables(positions)
    causal_tri = jnp.tril(jnp.ones((CHUNK, CHUNK), dtype=dt))

    for l in range(DEPTH):
        h = rms_norm(x, mix_pre_g[l])
        proj = h @ w_in[l]
        q_all, k_all, v_all, u_b, v_b = jnp.split(
            proj, [ATTN_QKV_WIDTH, 2 * ATTN_QKV_WIDTH, 3 * ATTN_QKV_WIDTH,
                   3 * ATTN_QKV_WIDTH + SGU_WIDTH], axis=-1)
        gshape = (B, S, N_ATTN_GROUPS, HEADS_PER_GROUP, HEAD_DIM)
        q_all = apply_partial_rope(q_all.reshape(gshape), cos, sin) * jnp.asarray(scale, dt)
        k_all = apply_partial_rope(k_all.reshape(gshape), cos, sin)
        v_all = v_all.reshape(gshape)

        outs, lses = [], []
        for g, (window, dilation) in enumerate(ATTN_GROUPS):
            o, lse = dilated_causal_attention(q_all[:, :, g], k_all[:, :, g], v_all[:, :, g],
                                              window, dilation)
            outs.append(o)
            lses.append(lse)
        alpha = jax.nn.softmax(jnp.stack(lses, axis=0), axis=0)
        y_a = jnp.sum(alpha[..., None] * jnp.stack(outs, axis=0).astype(jnp.float32), axis=0)
        y_a = y_a.astype(dt).reshape(B, S, ATTN_WIDTH)

        u_b = jax.nn.gelu(u_b)
        v_b = layer_norm(jax.nn.gelu(v_b), sgu_ln_g[l], sgu_ln_b[l])
        vc = v_b.reshape(B, S // CHUNK, CHUNK, SGU_GROUPS, SGU_GROUP_CH)
        ws = w_spatial[l] * causal_tri
        mixed = jnp.einsum('gij,bnjgc->bnigc', ws, vc) + b_spatial[l].T[None, None, :, :, None]
        y_b = u_b * mixed.reshape(B, S, SGU_WIDTH)

        gates = jax.nn.sigmoid(h @ w_gate[l] + b_gate[l])
        g_a, g_b = jnp.split(gates, 2, axis=-1)
        merged = g_a * (y_a @ w_branch_a[l]) + g_b * (y_b @ w_branch_b[l])
        x = x + rms_norm(merged @ w_out[l], mix_post_g[l])

        h = rms_norm(x, xa_pre_g[l])
        m = rms_norm(mem, mem_norm_g[l])
        q = (h @ w_xq[l]).reshape(B, S, XA_HEADS, HEAD_DIM) * jnp.asarray(scale, dt)
        k = (m @ w_xk[l]).reshape(B, M, XA_HEADS, HEAD_DIM)
        v = (m @ w_xv[l]).reshape(B, M, XA_HEADS, HEAD_DIM)
        p = jax.nn.softmax(jnp.einsum('bshd,bmhd->bhsm', q, k).astype(jnp.float32), axis=-1)
        o = jnp.einsum('bhsm,bmhd->bshd', p.astype(dt), v).reshape(B, S, XA_WIDTH)
        x = x + rms_norm(o @ w_xo[l], xa_post_g[l])

        h = rms_norm(x, mlp_pre_g[l])
        a = jnp.square(jax.nn.relu(h @ w_up[l]))
        x = x + rms_norm(a @ w_down[l], mlp_post_g[l])
    return x
```

```cpp
#include <hip/hip_runtime.h>
#include <cstdio>
#include <cstdint>
namespace pg8 {
#define PG8_LAS __attribute__((address_space(3)))
typedef unsigned short bf16_t;
typedef short bf16x8 __attribute__((ext_vector_type(8)));
typedef float f32x4 __attribute__((ext_vector_type(4)));
typedef unsigned u32x4 __attribute__((ext_vector_type(4)));
constexpr int BM = 256, BK = 64, HALF = 128, HTB = HALF * BK * 2  , STAGE_BYTES = 8 * HTB, NXCD = 8, WGM = 8;

__host__ __device__ __forceinline__ int lds_byte(int r, int c) { const int st = (r >> 4) * 2 + (c >> 5), rr = r & 15, cc = c & 31, ob = rr * 64 + cc * 2; return st * 1024 + (ob ^ (((ob >> 9) & 1) << 5)); }
__host__ __device__ __forceinline__ void stage_rc(int b, int& R, int& C) { const int st = b / 1024, sb = b % 1024, swz = sb ^ (((sb >> 9) & 1) << 5); R = (st >> 1) * 16 + swz / 64; C = (st & 1) * 32 + (swz % 64) / 2; }
__host__ __device__ __forceinline__ int perm32(int rho) { const int n = rho >> 4, i = rho & 15; return 8 * (i >> 2) + 4 * n + (i & 3); }

struct Unit { int pm, pn; };
struct Gemm { const bf16_t* A; const bf16_t* Bt; int M, N, K; };

struct StaticOrder {
    int nM, nN, nwg, G, c;
    __host__ __device__ void init(int M, int N, int G_, int c_) { nM = M / BM; nN = N / BM; nwg = nM * nN; G = G_; c = c_; }
    __host__ __device__ bool next(int i, Unit& u) const {
        const long L = (long)i * G + c; if (L >= nwg) return false;
        int wgid = (int)L; { const int q = nwg / NXCD, r = nwg % NXCD, xcd = wgid % NXCD, off = wgid / NXCD; wgid = (xcd < r ? xcd * (q + 1) : r * (q + 1) + (xcd - r) * q) + off; }
        const int nig = WGM * nN, gid = wgid / nig, fm = gid * WGM, gsz = (nM - fm) < WGM ? (nM - fm) : WGM;
        u.pm = fm + ((wgid % nig) % gsz); u.pn = (wgid % nig) / gsz; return true;
    }
    __device__ __forceinline__ void a_ready(const Unit&) const {}
    __device__ __forceinline__ void done(const Unit&) const {}
};

__device__ __forceinline__ unsigned cvt_pk_bf16(float lo, float hi) { unsigned r; asm volatile("s_nop 0\n\tv_cvt_pk_bf16_f32 %0, %1, %2" : "=v"(r) : "v"(lo), "v"(hi)); return r; }
typedef float f32x2 __attribute__((ext_vector_type(2)));
__device__ __forceinline__ u32x4 pack8(const f32x4 a, const f32x4 b) { u32x4 w; w.x = cvt_pk_bf16(a[0], a[1]); w.y = cvt_pk_bf16(a[2], a[3]); w.z = cvt_pk_bf16(b[0], b[1]); w.w = cvt_pk_bf16(b[2], b[3]); return w; }
__device__ __forceinline__ float bf_lo(unsigned w) { return __uint_as_float(w << 16); }
__device__ __forceinline__ float bf_hi(unsigned w) { return __uint_as_float(w & 0xffff0000u); }
__device__ __forceinline__ void unpack8(const u32x4 w, f32x4& a, f32x4& b) { a = (f32x4){bf_lo(w.x), bf_hi(w.x), bf_lo(w.y), bf_hi(w.y)}; b = (f32x4){bf_lo(w.z), bf_hi(w.z), bf_lo(w.w), bf_hi(w.w)}; }
__device__ __forceinline__ float gelu_tanh(float x) { const float u = x * (0.7978845608028654f + 0.035677408136300125f * x * x);
    const float e = __builtin_amdgcn_exp2f(-2.885390081777927f * u); return x * __builtin_amdgcn_rcpf(1.0f + e); }
__device__ __forceinline__ float sigmoid_f(float z) { return __builtin_amdgcn_rcpf(1.0f + __builtin_amdgcn_exp2f(-1.4426950408889634f * z)); }
__device__ __forceinline__ f32x4 gelu4(f32x4 v) { return (f32x4){gelu_tanh(v[0]), gelu_tanh(v[1]), gelu_tanh(v[2]), gelu_tanh(v[3])}; }
__device__ __forceinline__ f32x4 sigm4(f32x4 v) { return (f32x4){sigmoid_f(v[0]), sigmoid_f(v[1]), sigmoid_f(v[2]), sigmoid_f(v[3])}; }
__device__ __forceinline__ float hsum4(f32x4 v) { return (v[0] + v[1]) + (v[2] + v[3]); }

struct EpiPlain {
    static constexpr bool PERM = true, AFTER_DRAIN = false, HAS_MID = false;
    bf16_t* O; int ldc;
    __device__ __forceinline__ void operator()(const f32x4 (&acc)[2][2][4][2], const Unit& u, int wr, int wc, int fr, int fq) const {
        const int row0 = u.pm * BM + wr * 64 + fr, col0 = u.pn * BM + wc * 32 + 8 * fq;
#pragma unroll
        for (int ai = 0; ai < 2; ++ai)
#pragma unroll
            for (int m = 0; m < 4; ++m) { bf16_t* rowp = O + (size_t)(row0 + ai * HALF + m * 16) * ldc + col0;
#pragma unroll
                for (int bj = 0; bj < 2; ++bj) *(u32x4*)(rowp + bj * HALF) = pack8(acc[ai][bj][m][0], acc[ai][bj][m][1]); }
    }
};
struct EpiRelu2 {
    static constexpr bool PERM = true, AFTER_DRAIN = false, HAS_MID = false;
    bf16_t* O; int ldc;
    __device__ __forceinline__ void operator()(const f32x4 (&acc)[2][2][4][2], const Unit& u, int wr, int wc, int fr, int fq) const {
        const int row0 = u.pm * BM + wr * 64 + fr, col0 = u.pn * BM + wc * 32 + 8 * fq;
#pragma unroll
        for (int ai = 0; ai < 2; ++ai)
#pragma unroll
            for (int m = 0; m < 4; ++m) { bf16_t* rowp = O + (size_t)(row0 + ai * HALF + m * 16) * ldc + col0;
#pragma unroll
                for (int bj = 0; bj < 2; ++bj) { f32x4 v0 = acc[ai][bj][m][0], v1 = acc[ai][bj][m][1];
                    v0 = __builtin_elementwise_max(v0, (f32x4){0.f, 0.f, 0.f, 0.f}); v1 = __builtin_elementwise_max(v1, (f32x4){0.f, 0.f, 0.f, 0.f});
                    *(u32x4*)(rowp + bj * HALF) = pack8(v0 * v0, v1 * v1); } }
    }
};
struct EpiNorm {
    static constexpr bool PERM = true, AFTER_DRAIN = false, HAS_MID = false;
    bf16_t* O; int ldc; float* ssq;
    __device__ __forceinline__ void operator()(const f32x4 (&acc)[2][2][4][2], const Unit& u, int wr, int wc, int fr, int fq) const {
        const int row0 = u.pm * BM + wr * 64 + fr, col0 = u.pn * BM + wc * 32 + 8 * fq;
#pragma unroll
        for (int ai = 0; ai < 2; ++ai)
#pragma unroll
            for (int m = 0; m < 4; ++m) { const int row = row0 + ai * HALF + m * 16; bf16_t* rowp = O + (size_t)row * ldc + col0; float q = 0.f;
#pragma unroll
                for (int bj = 0; bj < 2; ++bj) { const f32x4 v0 = acc[ai][bj][m][0], v1 = acc[ai][bj][m][1]; q += hsum4(v0 * v0) + hsum4(v1 * v1);
                    *(u32x4*)(rowp + bj * HALF) = pack8(v0, v1); }
                q += __shfl_xor(q, 16); q += __shfl_xor(q, 32);
                if (fq == 0) ssq[(size_t)row * 64 + u.pn * 4 + wc] = q; }
    }
};
struct EpiMerge {
    static constexpr bool PERM = true, AFTER_DRAIN = false, HAS_MID = true;
    const bf16_t* G; bf16_t* MG; int tmid;
    __device__ __forceinline__ void mid(f32x4 (&acc)[2][2][4][2], const Unit& u, int wr, int wc, int fr, int fq) const {
        const int row0 = u.pm * BM + wr * 64 + fr, col0 = u.pn * BM + wc * 32 + 8 * fq;
        size_t off0 = (size_t)row0 * 8192 + col0; asm volatile("" : "+v"(off0));
#pragma unroll
        for (int ai = 0; ai < 2; ++ai)
#pragma unroll
            for (int m = 0; m < 4; ++m) { const bf16_t* gp = G + off0 + (size_t)(ai * HALF + m * 16) * 8192;
#pragma unroll
                for (int bj = 0; bj < 2; ++bj) { f32x4 a0, a1, b0, b1; unpack8(*(const u32x4*)(gp + bj * HALF), a0, a1); unpack8(*(const u32x4*)(gp + 4096 + bj * HALF), b0, b1);
#pragma unroll
                    for (int e = 0; e < 4; ++e) { a0[e] *= __builtin_amdgcn_rcpf(fmaxf(b0[e], 1e-20f)); a1[e] *= __builtin_amdgcn_rcpf(fmaxf(b1[e], 1e-20f)); }
                    acc[ai][bj][m][0] *= a0; acc[ai][bj][m][1] *= a1; }
                asm volatile("" ::: "memory"); }
    }
    __device__ __forceinline__ void operator()(const f32x4 (&acc)[2][2][4][2], const Unit& u, int wr, int wc, int fr, int fq) const {
        const int row0 = u.pm * BM + wr * 64 + fr, col0 = u.pn * BM + wc * 32 + 8 * fq;
#pragma unroll
        for (int ai = 0; ai < 2; ++ai)
#pragma unroll
            for (int m = 0; m < 4; ++m) { const size_t row = (size_t)(row0 + ai * HALF + m * 16);
#pragma unroll
                for (int bj = 0; bj < 2; ++bj) { f32x4 b0, b1; unpack8(*(const u32x4*)(G + row * 8192 + 4096 + col0 + bj * HALF), b0, b1);
                    b0 = __builtin_elementwise_max(b0, (f32x4){1e-20f, 1e-20f, 1e-20f, 1e-20f}); b1 = __builtin_elementwise_max(b1, (f32x4){1e-20f, 1e-20f, 1e-20f, 1e-20f});
                    *(u32x4*)(MG + row * 4096 + col0 + bj * HALF) = pack8(acc[ai][bj][m][0] * b0, acc[ai][bj][m][1] * b1); } }
    }
};
struct EpiProj {
    static constexpr bool PERM = true, AFTER_DRAIN = false, HAS_MID = false;
    bf16_t *Q, *K, *V, *U, *VB, *G; const float* rope; const float* bgate; float* lnstat;
    __device__ __forceinline__ void operator()(const f32x4 (&acc)[2][2][4][2], const Unit& u, int wr, int wc, int fr, int fq) const {
        const int pn = u.pn, row0 = u.pm * BM + wr * 64 + fr, lc0 = wc * 32 + 8 * fq;
        const int t12 = pn % 12, grp = t12 >> 2, sh = 2 * grp, hd0 = (t12 & 3) * 2;
        if (pn < 24) {
            bf16_t* base = pn < 12 ? Q : K; const float sgn = (fq & 2) ? 1.f : -1.f;
#pragma unroll
            for (int ai = 0; ai < 2; ++ai)
#pragma unroll
                for (int m = 0; m < 4; ++m) { const size_t row = (size_t)(row0 + ai * HALF + m * 16); const int tt = (int)row & 4095, slot = (tt & ((1 << sh) - 1)) * (4096 >> sh) + (tt >> sh);
                    bf16_t* rowp = base + ((((row >> 12) * 3 + grp) * 8 + hd0) * 4096 + slot) * 128 + lc0;
                    f32x4 c0 = {0.f, 0.f, 0.f, 0.f}, c1 = c0, s0 = c0, s1 = c0;
                    if (wc == 0) { const float* rp = rope + row * 32 + 8 * (fq & 1); c0 = *(const f32x4*)rp; c1 = *(const f32x4*)(rp + 4); s0 = *(const f32x4*)(rp + 16); s1 = *(const f32x4*)(rp + 20); }
#pragma unroll
                    for (int bj = 0; bj < 2; ++bj) { f32x4 v0 = acc[ai][bj][m][0], v1 = acc[ai][bj][m][1];
                        if (wc == 0) { f32x4 p0, p1;
#pragma unroll
                            for (int e = 0; e < 4; ++e) { p0[e] = __shfl_xor(v0[e], 32); p1[e] = __shfl_xor(v1[e], 32); }
                            v0 = v0 * c0 + (p0 * s0) * sgn; v1 = v1 * c1 + (p1 * s1) * sgn; }
                        *(u32x4*)(rowp + (size_t)bj * 4096 * 128) = pack8(v0, v1); } }
        } else if (pn < 36) {
#pragma unroll
            for (int ai = 0; ai < 2; ++ai)
#pragma unroll
                for (int m = 0; m < 4; ++m) { const size_t row = (size_t)(row0 + ai * HALF + m * 16); const int tt = (int)row & 4095, slot = (tt & ((1 << sh) - 1)) * (4096 >> sh) + (tt >> sh);
                    bf16_t* rowp = V + ((((row >> 12) * 3 + grp) * 8 + hd0) * 4096 + slot) * 128 + lc0;
#pragma unroll
                    for (int bj = 0; bj < 2; ++bj) *(u32x4*)(rowp + (size_t)bj * 4096 * 128) = pack8(acc[ai][bj][m][0], acc[ai][bj][m][1]); }
        } else if (pn < 44) {
            const int colt = (pn - 36) * BM + lc0;
#pragma unroll
            for (int ai = 0; ai < 2; ++ai)
#pragma unroll
                for (int m = 0; m < 4; ++m) { bf16_t* rowp = U + (size_t)(row0 + ai * HALF + m * 16) * 2048 + colt;
#pragma unroll
                    for (int bj = 0; bj < 2; ++bj) *(u32x4*)(rowp + bj * HALF) = pack8(gelu4(acc[ai][bj][m][0]), gelu4(acc[ai][bj][m][1])); }
        } else if (pn < 52) {
            const int colt = (pn - 44) * BM + lc0;
#pragma unroll
            for (int ai = 0; ai < 2; ++ai)
#pragma unroll
                for (int m = 0; m < 4; ++m) { const size_t row = (size_t)(row0 + ai * HALF + m * 16); bf16_t* rowp = VB + row * 2048 + colt; float s = 0.f, q = 0.f;
#pragma unroll
                    for (int bj = 0; bj < 2; ++bj) { const f32x4 v0 = gelu4(acc[ai][bj][m][0]), v1 = gelu4(acc[ai][bj][m][1]);
                        s += hsum4(v0) + hsum4(v1); q += hsum4(v0 * v0) + hsum4(v1 * v1); *(u32x4*)(rowp + bj * HALF) = pack8(v0, v1); }
                    s += __shfl_xor(s, 16); s += __shfl_xor(s, 32); q += __shfl_xor(q, 16); q += __shfl_xor(q, 32);
                    if (fq == 0) *(f32x2*)(lnstat + (row * 32 + (pn - 44) * 4 + wc) * 2) = (f32x2){s, q}; }
        } else {
            const int colt = (pn - 52) * BM + lc0;
            f32x4 bv[2][2];
#pragma unroll
            for (int bj = 0; bj < 2; ++bj) { bv[bj][0] = *(const f32x4*)(bgate + colt + bj * HALF); bv[bj][1] = *(const f32x4*)(bgate + colt + bj * HALF + 4); }
#pragma unroll
            for (int ai = 0; ai < 2; ++ai)
#pragma unroll
                for (int m = 0; m < 4; ++m) { bf16_t* rowp = G + (size_t)(row0 + ai * HALF + m * 16) * 8192 + colt;
#pragma unroll
                    for (int bj = 0; bj < 2; ++bj) *(u32x4*)(rowp + bj * HALF) = pack8(sigm4(acc[ai][bj][m][0] + bv[bj][0]), sigm4(acc[ai][bj][m][1] + bv[bj][1])); }
        }
    }
};
struct SmallOrder {
    int nN, nwg, c;
    __device__ void init(int M, int N, int first, int bx) { nN = N / BM; nwg = (M / BM) * nN; c = bx - first; }
    __device__ bool next(int i, Unit& u) const { if (i != 0 || c < 0 || c >= nwg) return false; u.pm = c / nN; u.pn = c % nN; return true; }
    __device__ __forceinline__ void a_ready(const Unit&) const {}
    __device__ __forceinline__ void done(const Unit&) const {}
};
template <class Epi, class Sched, bool ALIGN_EPI = false, bool SP2 = false>
__device__ __forceinline__ void gemm_phase(PG8_LAS unsigned char* lds, const Gemm g, const Sched& S, const Epi& E) {
    const int tid = threadIdx.x, wid = __builtin_amdgcn_readfirstlane(tid >> 6), lane = tid & 63, wr = wid >> 2, wc = wid & 3, fr = lane & 15, fq = lane >> 4;
    const int K = g.K, nt = K / BK;
    unsigned voffA[2], voffB[2];
#pragma unroll
    for (int i = 0; i < 2; ++i) { int R, C; stage_rc(tid * 16 + i * 8192, R, C); const int Rb = Epi::PERM ? ((R & ~31) + perm32(R & 31)) : R;
        voffA[i] = (unsigned)(R * K + C) * 2u; voffB[i] = (unsigned)(Rb * K + C) * 2u; }
    const size_t kstep = (size_t)(BK * 2);
    const size_t hstep = (size_t)HALF * K * 2;
    const size_t tstep = 2 * hstep;
    const unsigned ldsw = (unsigned)wid * 1024u;
    const int aoff = lds_byte(wr * 64 + fr, fq * 8), boff = lds_byte(wc * 32 + fr, fq * 8);
#define PG8_SA(b, h) (((b) * 2 + (h)) * HTB)
#define PG8_SB(b, h) ((4 + (b) * 2 + (h)) * HTB)
#define PG8_STAGE(bufoff, gbase, voff) do { _Pragma("unroll") for (int _i = 0; _i < 2; ++_i) \
        __builtin_amdgcn_global_load_lds((const unsigned*)((const char*)(gbase) + (voff)[_i]), (PG8_LAS unsigned*)(lds + (bufoff) + ldsw + _i * 8192), 16, 0, 0); } while (0)
#define PG8_LDA(dst, b, h) do { _Pragma("unroll") for (int m = 0; m < 4; ++m) _Pragma("unroll") for (int k = 0; k < 2; ++k) dst[m][k] = *(const PG8_LAS bf16x8*)(lds + PG8_SA(b, h) + aoff + m * 2048 + k * 1024); } while (0)
#define PG8_LDB(dst, b, h) do { _Pragma("unroll") for (int n = 0; n < 2; ++n) _Pragma("unroll") for (int k = 0; k < 2; ++k) dst[n][k] = *(const PG8_LAS bf16x8*)(lds + PG8_SB(b, h) + boff + n * 2048 + k * 1024); } while (0)
#define PG8_MMA(ai, bj, At, Bt) do { __builtin_amdgcn_s_setprio(1); _Pragma("unroll") for (int m = 0; m < 4; ++m) _Pragma("unroll") for (int n = 0; n < 2; ++n) _Pragma("unroll") for (int k = 0; k < 2; ++k) \
        acc[ai][bj][m][n] = __builtin_amdgcn_mfma_f32_16x16x32_bf16(Bt[n][k], At[m][k], acc[ai][bj][m][n], 0, 0, 0); __builtin_amdgcn_s_setprio(0); } while (0)
#define PG8_WAIT_V(n) asm volatile("s_waitcnt vmcnt(" #n ")" ::: "memory")
#define PG8_WAIT_L(n) asm volatile("s_waitcnt lgkmcnt(" #n ")" ::: "memory")
#define PG8_BAR __builtin_amdgcn_s_barrier()
#define PG8_SCHED __builtin_amdgcn_sched_barrier(0)
    Unit cur, nxt; int ui = 0;
    if (!S.next(0, cur)) return;
    f32x4 acc[2][2][4][2];
#pragma unroll
    for (int a = 0; a < 2; ++a)
#pragma unroll
        for (int b = 0; b < 2; ++b)
#pragma unroll
            for (int m = 0; m < 4; ++m)
#pragma unroll
                for (int n = 0; n < 2; ++n) acc[a][b][m][n] = (f32x4){0.f, 0.f, 0.f, 0.f};
    bf16x8 At[4][2], B0[2][2], B1[2][2];
    const char* cA = (const char*)g.A + (size_t)cur.pm * tstep; const char* cB = (const char*)g.Bt + (size_t)cur.pn * tstep;
    S.a_ready(cur);
    if constexpr (SP2) {
        PG8_STAGE(PG8_SB(0, 0), cB, voffB); PG8_STAGE(PG8_SB(0, 1), cB + hstep, voffB); PG8_STAGE(PG8_SA(0, 0), cA, voffA); PG8_STAGE(PG8_SA(0, 1), cA + hstep, voffA);
        if (wr == 1) PG8_BAR;
        PG8_WAIT_V(2); PG8_BAR;
        PG8_STAGE(PG8_SB(1, 0), cB + kstep, voffB); PG8_STAGE(PG8_SA(1, 0), cA + kstep, voffA); PG8_STAGE(PG8_SB(1, 1), cB + hstep + kstep, voffB);
        PG8_WAIT_V(6); PG8_BAR;
    } else {
        PG8_STAGE(PG8_SB(0, 0), cB, voffB); PG8_STAGE(PG8_SA(0, 0), cA, voffA); PG8_STAGE(PG8_SB(0, 1), cB + hstep, voffB); PG8_STAGE(PG8_SA(0, 1), cA + hstep, voffA);
        if (wr == 1) PG8_BAR;
        PG8_WAIT_V(4); PG8_BAR;
        PG8_STAGE(PG8_SB(1, 0), cB + kstep, voffB); PG8_STAGE(PG8_SA(1, 0), cA + kstep, voffA); PG8_STAGE(PG8_SB(1, 1), cB + hstep + kstep, voffB);
        PG8_WAIT_V(6); PG8_BAR;
    }
    for (;;) {
        const bool has_next = S.next(ui + 1, nxt);
        const char* nA = has_next ? (const char*)g.A + (size_t)nxt.pm * tstep : cA; const char* nB = has_next ? (const char*)g.Bt + (size_t)nxt.pn * tstep : cB;
#define PG8_KITER(t) do { \
            const bool last = ((t) == nt - 2); \
            const char* a1 = cA + (size_t)((t) + 1) * kstep; \
            const char* a2 = last ? nA : cA + (size_t)((t) + 2) * kstep; const char* b2 = last ? nB : cB + (size_t)((t) + 2) * kstep; \
            const char* a3 = a2 + kstep; const char* b3 = b2 + kstep; \
            if (last && has_next) S.a_ready(nxt); \
            PG8_LDB(B0, 0, 0); PG8_LDB(B1, 0, 1); PG8_SCHED; PG8_LDA(At, 0, 0); PG8_STAGE(PG8_SA(1, 1), a1 + hstep, voffA); \
            PG8_WAIT_V(8); PG8_WAIT_L(0); PG8_BAR; PG8_MMA(0, 0, At, B0); PG8_MMA(0, 1, At, B1); PG8_BAR; PG8_SCHED; \
            PG8_LDA(At, 0, 1); PG8_STAGE(PG8_SB(0, 0), b2, voffB); PG8_STAGE(PG8_SB(0, 1), b2 + hstep, voffB); PG8_STAGE(PG8_SA(0, 0), a2, voffA); \
            PG8_WAIT_V(8); PG8_WAIT_L(0); PG8_BAR; PG8_MMA(1, 0, At, B0); PG8_MMA(1, 1, At, B1); PG8_BAR; PG8_SCHED; \
            PG8_LDB(B0, 1, 0); PG8_LDB(B1, 1, 1); PG8_SCHED; PG8_LDA(At, 1, 0); PG8_STAGE(PG8_SA(0, 1), a2 + hstep, voffA); \
            PG8_WAIT_V(8); PG8_WAIT_L(0); PG8_BAR; PG8_MMA(0, 0, At, B0); PG8_MMA(0, 1, At, B1); PG8_BAR; PG8_SCHED; \
            PG8_LDA(At, 1, 1); PG8_STAGE(PG8_SB(1, 0), b3, voffB); PG8_STAGE(PG8_SB(1, 1), b3 + hstep, voffB); PG8_STAGE(PG8_SA(1, 0), a3, voffA); \
            PG8_WAIT_V(8); PG8_WAIT_L(0); PG8_BAR; PG8_MMA(1, 0, At, B0); PG8_MMA(1, 1, At, B1); PG8_BAR; PG8_SCHED; \
        } while (0)
        static_assert(SP2, "this copy of the body keeps only the two-super-phase K-loop");
        if constexpr (Epi::HAS_MID) {
            const int tm = E.tmid;
            for (int t = 0; t < tm; t += 2) PG8_KITER(t);
            E.mid(acc, cur, wr, wc, fr, fq);
            for (int t = tm; t < nt; t += 2) PG8_KITER(t);
        } else {
            for (int t = 0; t < nt; t += 2) PG8_KITER(t);
        }
#undef PG8_KITER
        if constexpr (ALIGN_EPI) { if (wr == 0) PG8_BAR; }
        if constexpr (!Epi::AFTER_DRAIN) { E(acc, cur, wr, wc, fr, fq); S.done(cur); }
        if (!has_next) break;
#pragma unroll
        for (int a = 0; a < 2; ++a)
#pragma unroll
            for (int b = 0; b < 2; ++b)
#pragma unroll
                for (int m = 0; m < 4; ++m)
#pragma unroll
                    for (int n = 0; n < 2; ++n) acc[a][b][m][n] = (f32x4){0.f, 0.f, 0.f, 0.f};
        cur = nxt; cA = nA; cB = nB; ++ui;
        if constexpr (ALIGN_EPI) { if (wr == 1) PG8_BAR; }
    }
    PG8_WAIT_V(0);
    if constexpr (!ALIGN_EPI) { if (wr == 0) PG8_BAR; }
    PG8_BAR;
    if constexpr (Epi::AFTER_DRAIN) { E.fused(acc, cur, wr, wc, fr, fq, lds, wid, lane); S.done(cur); }
#undef PG8_SA
#undef PG8_SB
#undef PG8_STAGE
#undef PG8_LDA
#undef PG8_LDB
#undef PG8_MMA
#undef PG8_WAIT_V
#undef PG8_WAIT_L
#undef PG8_BAR
#undef PG8_SCHED
}
}
#ifndef PG8_SP2
#define PG8_SP2 true
#endif
#ifndef PG8_ALIGN
#define PG8_ALIGN true
#endif
constexpr int NWAVES = 8;
#ifndef MK_PER_PHASE
#define MK_PER_PHASE 0
#endif
constexpr int N_PHASES = 14;

constexpr int BATCH = 4, SEQ = 4096, DM = 4096, M = BATCH * SEQ;
constexpr int AW = 1024, QKVW = 3072, SGW = 2048, INW = 13312, GW = 8192, NPROJ = INW + GW;
constexpr int XAW = 512, NMEM = 256, MROWS = BATCH * NMEM, DFF = 16384;
constexpr float EPS = 1e-6f;

constexpr size_t MiB = 1u << 20;
constexpr size_t WS_CTL = 0, CTL_ZERO_BYTES = 1 * MiB;
constexpr size_t WS_ROPE = 1 * MiB;
constexpr size_t WS_LNST = 3 * MiB;
constexpr size_t WS_SSQ = 7 * MiB;
constexpr size_t WS_LSE = 11 * MiB;
constexpr size_t WS_WSP = 13 * MiB;
constexpr size_t WS_WING = 16 * MiB;
constexpr size_t WS_WA = 184 * MiB;
constexpr size_t WS_WOUT = 208 * MiB;
constexpr size_t WS_WXQ = 240 * MiB;
constexpr size_t WS_WKV = 244 * MiB;
constexpr size_t WS_WXO = 252 * MiB;
constexpr size_t WS_H = 256 * MiB;
constexpr size_t WS_Q = 384 * MiB, WS_K = 480 * MiB, WS_V = 576 * MiB;
constexpr size_t WS_U = 672 * MiB, WS_VB = 736 * MiB;
constexpr size_t WS_G = 800 * MiB;
constexpr size_t WS_MRG = 1056 * MiB;
constexpr size_t WS_OG = 1056 * MiB;
constexpr size_t WS_KVX = 1216 * MiB;
constexpr size_t WS_MB = 1218 * MiB;
constexpr size_t WS_T = 384 * MiB;
constexpr size_t WS_QX = 512 * MiB, WS_OX = 528 * MiB;
constexpr size_t WS_A = 384 * MiB;
constexpr size_t WS_WUP = 896 * MiB;
constexpr size_t WS_WDN = 1024 * MiB;
constexpr size_t WS_YAB = 16 * MiB;
constexpr size_t WS_T3 = 256 * MiB;
constexpr size_t WS_XB = 16 * MiB;
constexpr size_t WS_END = 1226 * MiB;
constexpr int CW_TMO = 0, CW_CODE = 1, CW_BAR = 4096;

constexpr int RING_OFF = 0, RING_BYTES = 131072;
constexpr int ATT_KSTR = 272;
constexpr int ATT_K_OFF = 0, ATT_V_OFF = 256 * ATT_KSTR, ATT_END = ATT_V_OFF + 272 * ATT_KSTR;
constexpr int MISC_OFF = 144384, LDS_BYTES = 147456;
static_assert(ATT_END <= MISC_OFF && MISC_OFF + 128 <= LDS_BYTES, "LDS map");

#define GAS __attribute__((address_space(1)))
#define LAS __attribute__((address_space(3)))
typedef unsigned short bf16;
typedef unsigned v4u __attribute__((ext_vector_type(4)));
typedef unsigned v2u __attribute__((ext_vector_type(2)));
typedef float f32x4 __attribute__((ext_vector_type(4)));
typedef float f32x2 __attribute__((ext_vector_type(2)));
typedef short bf16x8 __attribute__((ext_vector_type(8)));
typedef short s16x4 __attribute__((ext_vector_type(4)));
typedef GAS unsigned gu32;
#define RLX_AGENT __ATOMIC_RELAXED, __HIP_MEMORY_SCOPE_AGENT
#define LDS_WAIT() asm volatile("s_waitcnt lgkmcnt(0)" ::: "memory")
#define VM_WAIT() asm volatile("s_waitcnt vmcnt(0)" ::: "memory")
__device__ __forceinline__ unsigned f2bf(float f) { unsigned u = __builtin_bit_cast(unsigned, f); return (u + 0x7fffu + ((u >> 16) & 1u)) >> 16; }
__device__ __forceinline__ unsigned pk2(float lo, float hi) { return f2bf(lo) | (f2bf(hi) << 16); }
__device__ __forceinline__ float bflo(unsigned w) { return __uint_as_float(w << 16); }
__device__ __forceinline__ float bfhi(unsigned w) { return __uint_as_float(w & 0xffff0000u); }

#define XB_TMO      128
#define XB_XCNT(j)  (256  + 64 * (j))
#define XB_XSUB(j)  (1280 + 64 * (j))
#define XB_XGEN(j)  (2304 + 64 * (j))
#define XB_TOP      3328
#define XB_TOPGEN   3392
#define XCD_BAR_WORDS 3456
#define XB_SPIN_CAP (1u << 18)

__device__ __forceinline__ unsigned xb_ld(unsigned* p)              { return __hip_atomic_load(p, __ATOMIC_RELAXED, __HIP_MEMORY_SCOPE_AGENT); }
__device__ __forceinline__ unsigned xb_add(unsigned* p, unsigned v) { return __hip_atomic_fetch_add(p, v, __ATOMIC_RELAXED, __HIP_MEMORY_SCOPE_AGENT); }
__device__ __forceinline__ unsigned xb_xcc_id() { return (unsigned)__builtin_amdgcn_s_getreg((3 << 11) | 20) & 0xFu; }
#define XB_SPIN(cond, bar) do { unsigned _sp = 0; while (cond) { __builtin_amdgcn_s_sleep(1); \
    if ((++_sp & 255u) == 0u) { if (xb_ld(&(bar)[XB_TMO])) break; if (_sp > XB_SPIN_CAP) { atomicAdd(&(bar)[XB_TMO], 1u); break; } } } } while (0)

struct XcdBarrier {
    unsigned* bar; unsigned x;
    volatile LAS unsigned* st;
};

__device__ __forceinline__ XcdBarrier xcd_barrier_post(unsigned* bar, volatile LAS unsigned* st) {
    XcdBarrier b; b.bar = bar; b.x = xb_xcc_id(); b.st = st;
    if (threadIdx.x == 0) (void)xb_add(&bar[XB_XCNT(b.x)], 1u);
    return b;
}
__device__ __forceinline__ void xcd_barrier_complete(unsigned* bar, unsigned x, unsigned& nloc, unsigned& nx) {
    const unsigned G = gridDim.x * gridDim.y * gridDim.z;
    unsigned sum, cnt, mine, sp = 0u;
    for (;;) {
        sum = 0u; cnt = 0u; mine = 0u;
#pragma unroll
        for (unsigned j = 0; j < 16; ++j) { const unsigned c = xb_ld(&bar[XB_XCNT(j)]); sum += c; cnt += (c > 0u) ? 1u : 0u; mine = (j == x) ? c : mine; }
        if (sum == G) break;
        __builtin_amdgcn_s_sleep(1);
        if ((++sp & 255u) == 0u) { if (xb_ld(&bar[XB_TMO])) break; if (sp > XB_SPIN_CAP) { atomicAdd(&bar[XB_TMO], 1u); break; } }
    }
    nloc = mine > 0u ? mine : 1u; nx = cnt > 0u ? cnt : 1u;
}

__device__ __forceinline__ void xcd_barrier(const XcdBarrier& b) {
    asm volatile("s_waitcnt vmcnt(0)" ::: "memory");
    __syncthreads();
    if (threadIdx.x == 0) {
        unsigned* bar = b.bar;
        __builtin_amdgcn_s_waitcnt(0);
        unsigned nloc = b.st[0], nx = b.st[1];
        if (nloc == 0u) { xcd_barrier_complete(bar, b.x, nloc, nx); b.st[0] = nloc; b.st[1] = nx; }
        const unsigned old = xb_add(&bar[XB_XSUB(b.x)], 1u);
        const unsigned gen = old / nloc;
        if (old + 1u == (gen + 1u) * nloc) {
            __builtin_amdgcn_fence(__ATOMIC_RELEASE, "agent");
            asm volatile("s_waitcnt vmcnt(0)" ::: "memory");
            const unsigned og = xb_add(&bar[XB_TOP], 1u);
            const unsigned tg = og / nx;
            if (og + 1u == (tg + 1u) * nx) xb_add(&bar[XB_TOPGEN], 1u);
            else XB_SPIN(xb_ld(&bar[XB_TOPGEN]) == tg, bar);
            __builtin_amdgcn_fence(__ATOMIC_ACQUIRE, "agent");
            xb_add(&bar[XB_XGEN(b.x)], 1u);
            asm volatile("s_waitcnt vmcnt(0)" ::: "memory");
        } else {
            XB_SPIN(xb_ld(&bar[XB_XGEN(b.x)]) == gen, bar);
            __builtin_amdgcn_fence(__ATOMIC_ACQUIRE, "agent");
            asm volatile("s_waitcnt vmcnt(0)" ::: "memory");
        }
    }
    __syncthreads();
}

struct Frame {
    LAS unsigned char* lds;
    volatile LAS unsigned* MISC;
    gu32* ctl;
    int tid, lane, wave;
    int vcu, G;
    unsigned char* ws;
};
__device__ __forceinline__ float wave_sum(float v) {
#pragma unroll
    for (int o = 1; o < 64; o <<= 1) v += __shfl_xor(v, o);
    return v;
}
__device__ __forceinline__ void p0_transpose_item(const float* W, int K, int N, bf16* WT, int row_off, LAS float* scr, int item, int lane, int ldk = 0, int koff = 0) {
    if (ldk == 0) ldk = K;
    const int nblk = N / 32, kb = item / nblk, nb = item % nblk, k0 = 64 * kb, n0 = 32 * nb;
#pragma unroll 8
    for (int i = 0; i < 32; ++i) { const int kk = 2 * i + (lane >> 5); scr[kk * 33 + (lane & 31)] = W[(size_t)(k0 + kk) * N + n0 + (lane & 31)]; }
    LDS_WAIT(); asm volatile("" ::: "memory");
    const int c = lane & 7;
#pragma unroll
    for (int j = 0; j < 4; ++j) { const int n = (lane >> 3) + 8 * j; const LAS float* s = scr + (8 * c) * 33 + n;
        v4u o; o.x = pk2(s[0 * 33], s[1 * 33]); o.y = pk2(s[2 * 33], s[3 * 33]); o.z = pk2(s[4 * 33], s[5 * 33]); o.w = pk2(s[6 * 33], s[7 * 33]);
        *(GAS v4u*)(WT + (size_t)(row_off + n0 + n) * ldk + koff + k0 + 8 * c) = o; }
    LDS_WAIT(); asm volatile("" ::: "memory");
}
__device__ __forceinline__ void rms_row_to_bf16(const float* xrow, const float* g, bf16* orow, int lane) {
    const GAS f32x4* xr = (const GAS f32x4*)xrow + lane; const GAS f32x4* gr = (const GAS f32x4*)g + lane;
    f32x4 v[16]; float s = 0.f;
#pragma unroll
    for (int j = 0; j < 16; ++j) { v[j] = xr[64 * j]; s += (v[j].x * v[j].x + v[j].y * v[j].y) + (v[j].z * v[j].z + v[j].w * v[j].w); }
    const float r = 1.0f / sqrtf(wave_sum(s) * (1.f / 4096.f) + EPS);
    GAS v2u* o8 = (GAS v2u*)orow + lane;
#pragma unroll
    for (int j = 0; j < 16; ++j) { const f32x4 gg = gr[64 * j]; v2u o; o.x = pk2(v[j].x * r * gg.x, v[j].y * r * gg.y); o.y = pk2(v[j].z * r * gg.z, v[j].w * r * gg.w); o8[64 * j] = o; }
}
template <bool XIB, bool XOB>
__device__ __forceinline__ void row_norm_res(const void* xin, const bf16* trow, const float* ssq, const float* gpost, const float* gpre, void* xout, bf16* hout, int lane) {
    const float r1 = 1.0f / sqrtf(wave_sum(ssq[lane]) * (1.f / 4096.f) + EPS);
    const GAS v2u* tr = (const GAS v2u*)trow + lane; const GAS f32x4* gp = (const GAS f32x4*)gpost + lane;
    f32x4 v[16]; float s = 0.f;
#pragma unroll
    for (int j = 0; j < 16; ++j) { f32x4 xv;
        if (XIB) { const v2u xw = ((const GAS v2u*)xin + lane)[64 * j]; xv = (f32x4){bflo(xw.x), bfhi(xw.x), bflo(xw.y), bfhi(xw.y)}; } else xv = ((const GAS f32x4*)xin + lane)[64 * j];
        const v2u tw = tr[64 * j]; const f32x4 gg = gp[64 * j];
        f32x4 o; o.x = xv.x + bflo(tw.x) * r1 * gg.x; o.y = xv.y + bfhi(tw.x) * r1 * gg.y; o.z = xv.z + bflo(tw.y) * r1 * gg.z; o.w = xv.w + bfhi(tw.y) * r1 * gg.w;
        v[j] = o; s += (o.x * o.x + o.y * o.y) + (o.z * o.z + o.w * o.w);
        if (XOB) { v2u ow; ow.x = pk2(o.x, o.y); ow.y = pk2(o.z, o.w); ((GAS v2u*)xout + lane)[64 * j] = ow; } else ((GAS f32x4*)xout + lane)[64 * j] = o; }
    if (hout) {
        const float r2 = 1.0f / sqrtf(wave_sum(s) * (1.f / 4096.f) + EPS);
        const GAS f32x4* gq = (const GAS f32x4*)gpre + lane; GAS v2u* o8 = (GAS v2u*)hout + lane;
#pragma unroll
        for (int j = 0; j < 16; ++j) { const f32x4 gg = gq[64 * j]; v2u o; o.x = pk2(v[j].x * r2 * gg.x, v[j].y * r2 * gg.y); o.y = pk2(v[j].z * r2 * gg.z, v[j].w * r2 * gg.w); o8[64 * j] = o; }
    }
}
__device__ __forceinline__ void sincos_d(float angf, float& sn, float& cs) {
    const double a = (double)angf; const double n = __builtin_rint(a * 0.6366197723675814);
    double r = __builtin_fma(-n, 1.5707963267948966, a); r = __builtin_fma(-n, 6.123233995736766e-17, r);
    const double r2 = r * r;
    double sp = 1.0 / 6227020800.0; sp = sp * r2 - 1.0 / 39916800.0; sp = sp * r2 + 1.0 / 362880.0; sp = sp * r2 - 1.0 / 5040.0; sp = sp * r2 + 1.0 / 120.0; sp = sp * r2 - 1.0 / 6.0; sp = sp * r2 + 1.0; sp = sp * r;
    double cp = -1.0 / 87178291200.0; cp = cp * r2 + 1.0 / 479001600.0; cp = cp * r2 - 1.0 / 3628800.0; cp = cp * r2 + 1.0 / 40320.0; cp = cp * r2 - 1.0 / 720.0; cp = cp * r2 + 1.0 / 24.0; cp = cp * r2 - 0.5; cp = cp * r2 + 1.0;
    const int q = (int)n & 3;
    const double s = (q == 0) ? sp : (q == 1) ? cp : (q == 2) ? -sp : -cp;
    const double c = (q == 0) ? cp : (q == 1) ? -sp : (q == 2) ? -cp : sp;
    sn = (float)s; cs = (float)c;
}

typedef short v4i16_t __attribute__((ext_vector_type(4)));
__device__ __forceinline__ s16x4 vtr(const LAS unsigned char* p) { return __builtin_bit_cast(s16x4, __builtin_amdgcn_ds_read_tr16_b64_v4i16((LAS v4i16_t*)p)); }
__device__ __forceinline__ unsigned cvtpk(float lo, float hi) { unsigned r; asm volatile("s_nop 0\n\tv_cvt_pk_bf16_f32 %0, %1, %2\n\ts_nop 1" : "=v"(r) : "v"(lo), "v"(hi)); return r; }
constexpr float ATT_C2 = 0.08838834764831845f * 1.4426950408889634f;
constexpr float ATT_SCALE = 0.08838834764831845f;

template <int NR>
__device__ __forceinline__ void att_issue(v4u (&st)[NR / 32], const bf16* src, size_t gstride, int tid) {
#pragma unroll
    for (int it = 0; it < NR / 32; ++it) st[it] = *(const GAS v4u*)(src + (size_t)((tid >> 4) + 32 * it) * gstride + (tid & 15) * 8);
}
template <int NR>
__device__ __forceinline__ void att_write(const v4u (&st)[NR / 32], LAS unsigned char* img, int lrow0, int tid) {
#pragma unroll
    for (int it = 0; it < NR / 32; ++it) *(LAS v4u*)(img + (lrow0 + (tid >> 4) + 32 * it) * ATT_KSTR + (tid & 15) * 16) = st[it];
}
__device__ __forceinline__ void att_q(bf16x8 (&qf)[4], const bf16* qrow, int lane) {
#pragma unroll
    for (int s = 0; s < 4; ++s) qf[s] = *(const GAS bf16x8*)(qrow + 32 * s + 8 * (lane >> 4));
}
template <int NT, bool BAND>
__device__ __forceinline__ void att_core(const LAS unsigned char* Kimg, const LAS unsigned char* Vimg, int krow0, int kmin, int rot  ,
                                         const bf16x8 (&qf)[4]  , bf16* orow  , float* lse_out  , int lane) {
    const int fr = lane & 15, fq = lane >> 4;
    f32x4 sc[NT];
    const LAS unsigned char* kb = Kimg + fr * ATT_KSTR + 16 * fq;
#pragma unroll
    for (int T = 0; T < NT; ++T) { sc[T] = (f32x4){0.f, 0.f, 0.f, 0.f}; const int trow = (krow0 + rot + 16 * T) & 255;
#pragma unroll
        for (int s = 0; s < 4; ++s) { const bf16x8 kf = *(const LAS bf16x8*)(kb + trow * ATT_KSTR + 64 * s);
            sc[T] = __builtin_amdgcn_mfma_f32_16x16x32_bf16(kf, qf[s], sc[T], 0, 0, 0); } }
    const float NEG = -__builtin_inff();
    if (BAND) {
#pragma unroll
        for (int r = 0; r < 4; ++r) { if (4 * fq + r < fr) sc[0][r] = NEG; if (4 * fq + r > fr) sc[NT - 1][r] = NEG; }
        if (kmin > 0) {
#pragma unroll
            for (int T = 0; T < NT; ++T)
#pragma unroll
                for (int r = 0; r < 4; ++r) if (krow0 + 16 * T + 4 * fq + r < kmin) sc[T][r] = NEG;
        }
    }
    float mx = sc[0][0];
#pragma unroll
    for (int T = 0; T < NT; ++T)
#pragma unroll
        for (int r = 0; r < 4; ++r) mx = fmaxf(mx, sc[T][r]);
    mx = fmaxf(mx, __shfl_xor(mx, 16)); mx = fmaxf(mx, __shfl_xor(mx, 32));
    const float mL = mx * ATT_C2; float l = 0.f;
#pragma unroll
    for (int T = 0; T < NT; ++T)
#pragma unroll
        for (int r = 0; r < 4; ++r) { const float p = __builtin_amdgcn_exp2f(sc[T][r] * ATT_C2 - mL); sc[T][r] = p; l += p; }
    l += __shfl_xor(l, 16); l += __shfl_xor(l, 32);
    constexpr int NKS = (NT + 1) / 2;
    f32x4 oa[8];
#pragma unroll
    for (int c = 0; c < 8; ++c) oa[c] = (f32x4){0.f, 0.f, 0.f, 0.f};
    const LAS unsigned char* vb = Vimg + (4 * fq + (fr >> 2)) * ATT_KSTR + 8 * (fr & 3);
#pragma unroll
    for (int ks = 0; ks < NKS; ++ks) { const int vr0 = (krow0 + rot + 32 * ks) & 255, vr1 = (krow0 + rot + 32 * ks + 16) & 255;
        v4u pw; pw.x = cvtpk(sc[2 * ks][0], sc[2 * ks][1]); pw.y = cvtpk(sc[2 * ks][2], sc[2 * ks][3]);
        if (2 * ks + 1 < NT) { pw.z = cvtpk(sc[2 * ks + 1 < NT ? 2 * ks + 1 : 0][0], sc[2 * ks + 1 < NT ? 2 * ks + 1 : 0][1]); pw.w = cvtpk(sc[2 * ks + 1 < NT ? 2 * ks + 1 : 0][2], sc[2 * ks + 1 < NT ? 2 * ks + 1 : 0][3]); }
        else { pw.z = 0u; pw.w = 0u; }
        const bf16x8 pf = __builtin_bit_cast(bf16x8, pw);
#pragma unroll
        for (int c = 0; c < 8; ++c) { const s16x4 lo = vtr(vb + vr0 * ATT_KSTR + 32 * c), hi = vtr(vb + vr1 * ATT_KSTR + 32 * c);
            const bf16x8 vf = __builtin_shufflevector(lo, hi, 0, 1, 2, 3, 4, 5, 6, 7);
            oa[c] = __builtin_amdgcn_mfma_f32_16x16x32_bf16(vf, pf, oa[c], 0, 0, 0); }
    }
    const float rl = 1.0f / l;
#pragma unroll
    for (int c = 0; c < 8; ++c) { v2u o; o.x = cvtpk(oa[c][0] * rl, oa[c][1] * rl); o.y = cvtpk(oa[c][2] * rl, oa[c][3] * rl); *(GAS v2u*)(orow + 16 * c + 4 * fq) = o; }
    if (lse_out && fq == 0) *lse_out = mx * ATT_SCALE + __logf(l);
}
struct SaUnit { int g, d, qb, h; size_t tok0, slab; };
__device__ __forceinline__ SaUnit sa_unit(int i, int per, int G, int bx) {
    int c, h;
    if (per > 0) { c = (bx >> 3) * per + i; h = bx & 7; } else { const int idx = bx + i * G; c = idx >> 3; h = idx & 7; }
    SaUnit u; u.g = c >> 7; const int cc = c & 127, sh = 2 * u.g, nblk = 32 >> sh; u.d = 1 << sh;
    u.qb = cc % nblk; const int t1 = cc / nblk, r = t1 % u.d, b = t1 / u.d; u.h = h;
    u.tok0 = (size_t)b * SEQ + r; u.slab = ((((size_t)b * 3 + u.g) * 8 + h) * 4096 + (size_t)r * (4096 >> sh)) * 128; return u;
}
__device__ __forceinline__ void sa_issue(v4u (&stK)[8], v4u (&stV)[8], const bf16* K, const bf16* V, const SaUnit& u, bool shared, int tid) {
    const size_t gs = 128; const int pb = 128 * (u.qb - 1) + (tid >> 4); const int fix = u.qb == 0 ? 128 : 0;
    const size_t base = u.slab + (tid & 15) * 8;
    if (!shared) {
#pragma unroll
        for (int it = 0; it < 4; ++it) { const size_t off = base + (size_t)(pb + 32 * it + fix) * gs; stK[it] = *(const GAS v4u*)(K + off); stV[it] = *(const GAS v4u*)(V + off); } }
#pragma unroll
    for (int it = 4; it < 8; ++it) { const size_t off = base + (size_t)(pb + 32 * it) * gs; stK[it] = *(const GAS v4u*)(K + off); stV[it] = *(const GAS v4u*)(V + off); }
}
__device__ __forceinline__ void sa_write(const v4u (&stK)[8], const v4u (&stV)[8], LAS unsigned char* Kimg, LAS unsigned char* Vimg, bool shared, int rot, int tid) {
    if (!shared) {
#pragma unroll
        for (int it = 0; it < 4; ++it) { const int o = ((((tid >> 4) + 32 * it) + rot) & 255) * ATT_KSTR + (tid & 15) * 16; *(LAS v4u*)(Kimg + o) = stK[it]; *(LAS v4u*)(Vimg + o) = stV[it]; } }
#pragma unroll
    for (int it = 4; it < 8; ++it) { const int o = ((((tid >> 4) + 32 * it) + rot) & 255) * ATT_KSTR + (tid & 15) * 16; *(LAS v4u*)(Kimg + o) = stK[it]; *(LAS v4u*)(Vimg + o) = stV[it]; }
}
__device__ __forceinline__ void self_attn_stream(Frame& F, const bf16* Q, const bf16* K, const bf16* V, bf16* OG, float* LSE) {
    LAS unsigned char* Kimg = F.lds + ATT_K_OFF; LAS unsigned char* Vimg = F.lds + ATT_V_OFF;
    const int bx = (int)blockIdx.x, G = F.G, per = (G % 8 == 0 && 3072 % G == 0) ? 3072 / G : 0, n = per ? per : (3072 - bx + G - 1) / G;
    if (n <= 0) return;
    v4u stK[8], stV[8]; SaUnit u = sa_unit(0, per, G, bx); bool shared = false; int rot = 0;
    size_t tok = u.tok0 + (size_t)(128 * u.qb + 16 * F.wave + (F.lane & 15)) * u.d;
    bf16x8 qn[4]; att_q(qn, Q + u.slab + (size_t)(128 * u.qb + 16 * F.wave + (F.lane & 15)) * 128, F.lane);
    sa_issue(stK, stV, K, V, u, false, F.tid);
    for (int i = 0; i < n; ++i) {
        sa_write(stK, stV, Kimg, Vimg, shared, rot, F.tid);
        __syncthreads();
        bf16x8 qf[4];
#pragma unroll
        for (int s = 0; s < 4; ++s) qf[s] = qn[s];
        const int kmin = u.qb == 0 ? 128 : 0, crot = rot; bf16* orow = OG + ((size_t)u.g * M + tok) * AW + u.h * 128; float* lse = LSE + ((size_t)u.g * M + tok) * 8 + u.h;
        const bool more = i + 1 < n;
        if (more) { const SaUnit nu = sa_unit(i + 1, per, G, bx);
            shared = (nu.g == u.g) && (nu.tok0 == u.tok0) && (nu.h == u.h) && (nu.qb == u.qb + 1);
            rot = shared ? (rot ^ 128) : 0; u = nu;
            tok = u.tok0 + (size_t)(128 * u.qb + 16 * F.wave + (F.lane & 15)) * u.d;
            sa_issue(stK, stV, K, V, u, shared, F.tid); att_q(qn, Q + u.slab + (size_t)(128 * u.qb + 16 * F.wave + (F.lane & 15)) * 128, F.lane); }
        att_core<9, true>(Kimg, Vimg, 16 * F.wave, kmin, crot, qf, orow, lse, F.lane);
        __syncthreads();
    }
}
__device__ __forceinline__ void cross_attn_stream(Frame& F, const bf16* QX, const bf16* KVX, bf16* OX) {
    LAS unsigned char* Kimg = F.lds + ATT_K_OFF; LAS unsigned char* Vimg = F.lds + ATT_V_OFF;
    const int per = (512 % F.G == 0) ? 512 / F.G : 0;
    const int n = per ? per : (512 - (int)blockIdx.x + F.G - 1) / F.G; int loaded = -1;
    for (int i = 0; i < n; ++i) { const int idx = per ? (int)blockIdx.x * per + i : (int)blockIdx.x + i * F.G; if (idx >= 512) break;
        const int qblk = idx & 31, bh = idx >> 5, h = bh & 3, b = bh >> 2;
        if (bh != loaded) { if (loaded >= 0) __syncthreads();
            const size_t off = (size_t)b * NMEM * 1024 + h * 128;
            v4u stK[8], stV[8]; att_issue<256>(stK, KVX + off, 1024, F.tid); att_issue<256>(stV, KVX + off + 512, 1024, F.tid);
            att_write<256>(stK, Kimg, 0, F.tid); att_write<256>(stV, Vimg, 0, F.tid);
            __syncthreads(); loaded = bh; }
        const size_t tok = (size_t)b * SEQ + 128 * qblk + 16 * F.wave + (F.lane & 15);
        bf16x8 qf[4]; att_q(qf, QX + tok * XAW + h * 128, F.lane);
        att_core<16, false>(Kimg, Vimg, 0, 0, 0, qf, OX + tok * XAW + h * 128, nullptr, F.lane);
    }
    __syncthreads();
}
__device__ __forceinline__ void sgu_unit(Frame& F, int idx, const bf16* U, bf16* YB, const bf16* VB, const float* lnstat, const float* lng, const float* lnb, const bf16* WSP, const float* bsp) {
    const int g = idx & 15, cn = idx >> 4, C0 = g * 128; const size_t tok0 = (size_t)cn * 128;
    LAS unsigned char* img = F.lds; LAS f32x2* stat = (LAS f32x2*)(F.lds + 40960);
    if (F.tid < 128) { const float* sp = lnstat + (tok0 + F.tid) * 64; float s = 0.f, q = 0.f;
#pragma unroll
        for (int k = 0; k < 16; ++k) { const f32x4 v = *(const GAS f32x4*)(sp + 4 * k); s += v.x + v.z; q += v.y + v.w; }
        const float mu = s * (1.f / 2048.f), var = q * (1.f / 2048.f) - mu * mu; stat[F.tid] = (f32x2){mu, 1.0f / sqrtf(var + EPS)}; }
    __syncthreads();
    { const int ch = F.tid & 15; const float* gp = lng + C0 + 8 * ch; const float* bp = lnb + C0 + 8 * ch;
      const f32x4 g0 = *(const GAS f32x4*)gp, g1 = *(const GAS f32x4*)(gp + 4), b0 = *(const GAS f32x4*)bp, b1 = *(const GAS f32x4*)(bp + 4);
      v4u raw[4];
#pragma unroll
      for (int it = 0; it < 4; ++it) raw[it] = *(const GAS v4u*)(VB + (tok0 + (F.tid >> 4) + 32 * it) * SGW + C0 + 8 * ch);
#pragma unroll
      for (int it = 0; it < 4; ++it) { const int j = (F.tid >> 4) + 32 * it; const f32x2 st = stat[j]; const v4u w = raw[it]; v4u o;
          o.x = cvtpk((bflo(w.x) - st.x) * st.y * g0.x + b0.x, (bfhi(w.x) - st.x) * st.y * g0.y + b0.y); o.y = cvtpk((bflo(w.y) - st.x) * st.y * g0.z + b0.z, (bfhi(w.y) - st.x) * st.y * g0.w + b0.w);
          o.z = cvtpk((bflo(w.z) - st.x) * st.y * g1.x + b1.x, (bfhi(w.z) - st.x) * st.y * g1.y + b1.y); o.w = cvtpk((bflo(w.w) - st.x) * st.y * g1.z + b1.z, (bfhi(w.w) - st.x) * st.y * g1.w + b1.w);
          *(LAS v4u*)(img + j * ATT_KSTR + ch * 16) = o; } }
    __syncthreads();
    const int fr = F.lane & 15, fq = F.lane >> 4, w = F.wave, nsteps = (w >> 1) + 1;
    f32x4 acc[8];
#pragma unroll
    for (int c = 0; c < 8; ++c) acc[c] = (f32x4){0.f, 0.f, 0.f, 0.f};
    const bf16* wrow = WSP + ((size_t)g * 128 + 16 * w + fr) * 128 + 8 * fq;
    const LAS unsigned char* vb = img + (8 * fq + (fr >> 2)) * ATT_KSTR + 8 * (fr & 3);
    for (int s = 0; s < nsteps; ++s) { const bf16x8 wf = *(const GAS bf16x8*)(wrow + 32 * s);
#pragma unroll
        for (int c = 0; c < 8; ++c) { const s16x4 lo = vtr(vb + (32 * s) * ATT_KSTR + 32 * c), hi = vtr(vb + (32 * s + 4) * ATT_KSTR + 32 * c);
            const bf16x8 vf = __builtin_shufflevector(lo, hi, 0, 1, 2, 3, 4, 5, 6, 7);
            acc[c] = __builtin_amdgcn_mfma_f32_16x16x32_bf16(vf, wf, acc[c], 0, 0, 0); } }
    const float bias = bsp[g * 128 + 16 * w + fr];
    const bf16* urow = U + (tok0 + 16 * w + fr) * SGW + C0 + 4 * fq; bf16* yrow = YB + (tok0 + 16 * w + fr) * (AW + SGW) + AW + C0 + 4 * fq;
#pragma unroll
    for (int c = 0; c < 8; ++c) { const v2u uw = *(const GAS v2u*)(urow + 16 * c); v2u o;
        o.x = cvtpk(bflo(uw.x) * (acc[c][0] + bias), bfhi(uw.x) * (acc[c][1] + bias)); o.y = cvtpk(bflo(uw.y) * (acc[c][2] + bias), bfhi(uw.y) * (acc[c][3] + bias));
        *(GAS v2u*)(yrow + 16 * c) = o; }
    __syncthreads();
}

__device__ __forceinline__ void sgu_stream(Frame& F, int per, const bf16* U, bf16* YB, const bf16* VB, const float* lnstat, const float* lng, const float* lnb, const bf16* WSP, const float* bsp) {
    const int idx0 = (int)blockIdx.x * per, cn = idx0 >> 4, g0 = idx0 & 15; const size_t tok0 = (size_t)cn * 128;
    LAS unsigned char* img = F.lds; LAS f32x2* stat = (LAS f32x2*)(F.lds + 40960);
    if (F.tid < 128) { const float* sp = lnstat + (tok0 + F.tid) * 64; float s = 0.f, q = 0.f;
#pragma unroll
        for (int k = 0; k < 16; ++k) { const f32x4 v = *(const GAS f32x4*)(sp + 4 * k); s += v.x + v.z; q += v.y + v.w; }
        const float mu = s * (1.f / 2048.f), var = q * (1.f / 2048.f) - mu * mu; stat[F.tid] = (f32x2){mu, 1.0f / sqrtf(var + EPS)}; }
    const int ch = F.tid & 15, fr = F.lane & 15, fq = F.lane >> 4, w = F.wave, nsteps = (w >> 1) + 1;
    v4u raw[4];
#pragma unroll
    for (int it = 0; it < 4; ++it) raw[it] = *(const GAS v4u*)(VB + (tok0 + (F.tid >> 4) + 32 * it) * SGW + g0 * 128 + 8 * ch);
    __syncthreads();
    const LAS unsigned char* vb = img + (8 * fq + (fr >> 2)) * ATT_KSTR + 8 * (fr & 3);
    for (int i = 0; i < per; ++i) { const int g = g0 + i, C0 = g * 128;
        { const float* gp = lng + C0 + 8 * ch; const float* bp = lnb + C0 + 8 * ch;
          const f32x4 ga = *(const GAS f32x4*)gp, gb = *(const GAS f32x4*)(gp + 4), ba = *(const GAS f32x4*)bp, bb = *(const GAS f32x4*)(bp + 4);
#pragma unroll
          for (int it = 0; it < 4; ++it) { const int j = (F.tid >> 4) + 32 * it; const f32x2 st = stat[j]; const v4u wv = raw[it]; v4u o;
              o.x = cvtpk((bflo(wv.x) - st.x) * st.y * ga.x + ba.x, (bfhi(wv.x) - st.x) * st.y * ga.y + ba.y); o.y = cvtpk((bflo(wv.y) - st.x) * st.y * ga.z + ba.z, (bfhi(wv.y) - st.x) * st.y * ga.w + ba.w);
              o.z = cvtpk((bflo(wv.z) - st.x) * st.y * gb.x + bb.x, (bfhi(wv.z) - st.x) * st.y * gb.y + bb.y); o.w = cvtpk((bflo(wv.w) - st.x) * st.y * gb.z + bb.z, (bfhi(wv.w) - st.x) * st.y * gb.w + bb.w);
              *(LAS v4u*)(img + j * ATT_KSTR + ch * 16) = o; } }
        __syncthreads();
        const bf16* wrow = WSP + ((size_t)g * 128 + 16 * w + fr) * 128 + 8 * fq;
        bf16x8 wf[4];
#pragma unroll
        for (int s = 0; s < 4; ++s) wf[s] = *(const GAS bf16x8*)(wrow + 32 * (s < nsteps ? s : 0));
        const bf16* urow = U + (tok0 + 16 * w + fr) * SGW + C0 + 4 * fq; bf16* yrow = YB + (tok0 + 16 * w + fr) * (AW + SGW) + AW + C0 + 4 * fq;
        v2u uw[8];
#pragma unroll
        for (int c = 0; c < 8; ++c) uw[c] = *(const GAS v2u*)(urow + 16 * c);
        const float bias = bsp[g * 128 + 16 * w + fr];
        if (i + 1 < per) {
#pragma unroll
            for (int it = 0; it < 4; ++it) raw[it] = *(const GAS v4u*)(VB + (tok0 + (F.tid >> 4) + 32 * it) * SGW + C0 + 128 + 8 * ch); }
        f32x4 acc[8];
#pragma unroll
        for (int c = 0; c < 8; ++c) acc[c] = (f32x4){0.f, 0.f, 0.f, 0.f};
#pragma unroll
        for (int s = 0; s < 4; ++s) { if (s < nsteps) {
#pragma unroll
            for (int c = 0; c < 8; ++c) { const s16x4 lo = vtr(vb + (32 * s) * ATT_KSTR + 32 * c), hi = vtr(vb + (32 * s + 4) * ATT_KSTR + 32 * c);
                const bf16x8 vf = __builtin_shufflevector(lo, hi, 0, 1, 2, 3, 4, 5, 6, 7);
                acc[c] = __builtin_amdgcn_mfma_f32_16x16x32_bf16(vf, wf[s], acc[c], 0, 0, 0); } } }
#pragma unroll
        for (int c = 0; c < 8; ++c) { v2u o;
            o.x = cvtpk(bflo(uw[c].x) * (acc[c][0] + bias), bfhi(uw[c].x) * (acc[c][1] + bias)); o.y = cvtpk(bflo(uw[c].y) * (acc[c][2] + bias), bfhi(uw[c].y) * (acc[c][3] + bias));
            *(GAS v2u*)(yrow + 16 * c) = o; }
        __syncthreads();
    }
}

struct ConvJob { const float* W; bf16* WT; int K, N, row_off, ldk, koff, item; };
__device__ __forceinline__ void conv_load(f32x4 (&v)[16], const ConvJob& j, int lane) {
    const int nblk = j.N >> 6, kb = j.item / nblk, nb = j.item - kb * nblk;
    const float* src = j.W + (size_t)(64 * kb + (lane >> 4)) * j.N + 64 * nb + 4 * (lane & 15); const size_t st = (size_t)4 * j.N;
#pragma unroll
    for (int i = 0; i < 16; ++i) v[i] = *(const GAS f32x4*)(src + i * st);
}
__device__ __forceinline__ unsigned cvt2(float lo, float hi) { typedef float f2_t __attribute__((ext_vector_type(2))); typedef __bf16 b2_t __attribute__((ext_vector_type(2))); const f2_t v = {lo, hi}; return __builtin_bit_cast(unsigned, __builtin_convertvector(v, b2_t)); }
__device__ __forceinline__ void conv_to_lds(const f32x4 (&v)[16], LAS unsigned char* scr, int lane) {
#pragma unroll
    for (int i = 0; i < 16; ++i) { v2u o; o.x = cvt2(v[i].x, v[i].y); o.y = cvt2(v[i].z, v[i].w); *(LAS v2u*)(scr + ((lane >> 4) + 4 * i) * 144 + 8 * (lane & 15)) = o; }
}
__device__ __forceinline__ void conv_store(const ConvJob& j, const LAS unsigned char* scr, int lane) {
    const int nblk = j.N >> 6, kb = j.item / nblk, nb = j.item - kb * nblk, i16 = lane & 15, fq = lane >> 4;
    const LAS unsigned char* rb = scr + (8 * fq + (i16 >> 2)) * 144 + 8 * (i16 & 3);
    bf16* dst = j.WT + (size_t)(j.row_off + 64 * nb + i16) * j.ldk + j.koff + 64 * kb + 8 * fq;
#pragma unroll
    for (int jj = 0; jj < 8; ++jj) { const int nb16 = jj & 3, kh = jj >> 2;
        const s16x4 lo = vtr(rb + (32 * kh) * 144 + 32 * nb16), hi = vtr(rb + (32 * kh + 4) * 144 + 32 * nb16);
        const bf16x8 o = __builtin_shufflevector(lo, hi, 0, 1, 2, 3, 4, 5, 6, 7);
        *(GAS bf16x8*)(dst + (size_t)(16 * nb16) * j.ldk + 32 * kh) = o; }
}
#define CONV_STREAM(LO_, HI_, GW_, NGW_, DECODE_) do { \
        LAS unsigned char* scr_ = F.lds + RING_OFF + F.wave * 16384; f32x4 cv_[16]; ConvJob cur_, nxt_; int it_ = (LO_) + (GW_); bool have_ = it_ < (HI_); \
        if (have_) { DECODE_(it_, cur_); conv_load(cv_, cur_, F.lane); } \
        while (have_) { \
            conv_to_lds(cv_, scr_, F.lane); \
            const int itn_ = it_ + (NGW_); const bool more_ = itn_ < (HI_); \
            if (more_) { DECODE_(itn_, nxt_); conv_load(cv_, nxt_, F.lane); } \
            asm volatile("s_waitcnt lgkmcnt(0)" ::: "memory"); \
            conv_store(cur_, scr_, F.lane); \
            asm volatile("s_waitcnt lgkmcnt(0)" ::: "memory"); \
            cur_ = nxt_; it_ = itn_; have_ = more_; } \
    } while (0)

struct Args { const float* in[26]; float* out; unsigned char* ws; int ph_lo, ph_hi, li, pad; };
constexpr float ROPE_INV[16] = {1.0f, 0.44036659598350525f, 0.1939227432012558f, 0.08539710193872452f, 0.03760603070259094f, 0.01656043902039528f, 0.007292664609849453f, 0.0032114458736032248f,
    0.0014142135623842478f, 0.000622772378847003f, 0.00027424818836152554f, 0.00012076973507646471f, 5.318296098266728e-05f, 2.34199997066753e-05f, 1.0313386155758053e-05f, 4.541670477919979e-06f};

__global__ void __launch_bounds__(NWAVES * 64, 2) skel_fwd(Args args) {
    extern __shared__ __attribute__((aligned(16))) unsigned char lds[];
    Frame F;
    F.lds = (LAS unsigned char*)lds;
    F.MISC = (volatile LAS unsigned*)(F.lds + MISC_OFF);
    F.tid = threadIdx.x; F.lane = F.tid & 63; F.wave = __builtin_amdgcn_readfirstlane(F.tid >> 6);
    F.G = gridDim.x; { const int bx = blockIdx.x; F.vcu = (F.G % 8 == 0) ? (bx % 8) * (F.G / 8) + bx / 8 : bx; }
    unsigned char* ws = args.ws; F.ws = ws;
    F.ctl = (gu32*)(ws + WS_CTL);
    const float* x = args.in[0]; const float* mem = args.in[1]; const int* positions = (const int*)args.in[2]; const float* mix_pre_g = args.in[3]; const float* w_in = args.in[4];
    const float* sgu_ln_g = args.in[5]; const float* sgu_ln_b = args.in[6]; const float* w_spatial = args.in[7]; const float* b_spatial = args.in[8];
    const float* w_branch_a = args.in[9]; const float* w_branch_b = args.in[10]; const float* w_gate = args.in[11]; const float* b_gate = args.in[12]; const float* w_out = args.in[13];
    const float* mix_post_g = args.in[14]; const float* xa_pre_g = args.in[15]; const float* mem_norm_g = args.in[16];
    const float* w_xq = args.in[17]; const float* w_xk = args.in[18]; const float* w_xv = args.in[19]; const float* w_xo = args.in[20];
    const float* xa_post_g = args.in[21]; const float* mlp_pre_g = args.in[22]; const float* w_up = args.in[23]; const float* w_down = args.in[24]; const float* mlp_post_g = args.in[25];
    float* out = args.out;
    float* ROPE = (float*)(ws + WS_ROPE); float* LNST = (float*)(ws + WS_LNST); float* SSQ = (float*)(ws + WS_SSQ); float* LSE = (float*)(ws + WS_LSE);
    bf16* WSP = (bf16*)(ws + WS_WSP); bf16* WING = (bf16*)(ws + WS_WING); bf16* WAB = (bf16*)(ws + WS_WA); bf16* WOUT = (bf16*)(ws + WS_WOUT);
    bf16* WXQ = (bf16*)(ws + WS_WXQ); bf16* WKV = (bf16*)(ws + WS_WKV); bf16* WXO = (bf16*)(ws + WS_WXO); bf16* WUP = (bf16*)(ws + WS_WUP); bf16* WDN = (bf16*)(ws + WS_WDN);
    bf16* H = (bf16*)(ws + WS_H); bf16* Qb = (bf16*)(ws + WS_Q); bf16* Kb = (bf16*)(ws + WS_K); bf16* Vb = (bf16*)(ws + WS_V); bf16* Ub = (bf16*)(ws + WS_U); bf16* VBb = (bf16*)(ws + WS_VB);
    bf16* Gb = (bf16*)(ws + WS_G); bf16* MRG = (bf16*)(ws + WS_MRG); bf16* OG = (bf16*)(ws + WS_OG); bf16* KVX = (bf16*)(ws + WS_KVX); bf16* MB = (bf16*)(ws + WS_MB);
    bf16* T = (bf16*)(ws + WS_T); bf16* QX = (bf16*)(ws + WS_QX); bf16* OX = (bf16*)(ws + WS_OX); bf16* Ab = (bf16*)(ws + WS_A); bf16* T3 = (bf16*)(ws + WS_T3); bf16* XB = (bf16*)(ws + WS_XB); bf16* YAB = (bf16*)(ws + WS_YAB); constexpr int YABW = AW + SGW;

    for (int u = F.tid; u < (LDS_BYTES - MISC_OFF) / 4; u += NWAVES * 64) ((LAS unsigned*)(F.lds + MISC_OFF))[u] = 0u;
    __syncthreads();
#if MK_PER_PHASE
#define GRID_BAR() do { } while (0)
#else
    XcdBarrier bar = xcd_barrier_post((unsigned*)(F.ctl + CW_BAR) + args.li * XCD_BAR_WORDS, F.MISC + 8);
#define GRID_BAR() xcd_barrier(bar)
#endif
    const int lo = args.ph_lo, hi = args.ph_hi;
#define IN(k) (lo <= (k) && (k) < hi)
#define BOTH(k) (IN(k) && IN((k) + 1))
    const int gw = F.vcu * NWAVES + F.wave, NGW = F.G * NWAVES, bx = (int)blockIdx.x;
    const int gtid = bx * (NWAVES * 64) + F.tid, NGT = F.G * NWAVES * 64;
    constexpr int I_UP = 64 * (DFF / 64), I_DN = (DFF / 64) * (DM / 64), P7_BUSY = 144, CONV_PER_WAVE = 18;
    const int conv_early = (F.G > P7_BUSY) ? (((F.G - P7_BUSY) * NWAVES * CONV_PER_WAVE < I_UP + I_DN) ? (F.G - P7_BUSY) * NWAVES * CONV_PER_WAVE : I_UP + I_DN) : 0;

    if (IN(0)) {
        constexpr int I_IN = 64 * (INW / 64), I_G = 64 * (GW / 64), I_A = 16 * 64, I_B = 32 * 64, I_O = 64 * 64, I_XQ = 64 * 8, I_XO = 8 * 64;
        constexpr int NITEMS = I_IN + I_G + I_A + I_B + I_O + 3 * I_XQ + I_XO;
#define P0_DECODE(r_, J) do { int r = (r_); \
            if (r < I_IN) { J = ConvJob{w_in, WING, DM, INW, 0, DM, 0, r}; break; } r -= I_IN; \
            if (r < I_G) { J = ConvJob{w_gate, WING, DM, GW, INW, DM, 0, r}; break; } r -= I_G; \
            if (r < I_A) { J = ConvJob{w_branch_a, WAB, AW, DM, 0, AW + SGW, 0, r}; break; } r -= I_A; \
            if (r < I_B) { J = ConvJob{w_branch_b, WAB, SGW, DM, 0, AW + SGW, AW, r}; break; } r -= I_B; \
            if (r < I_O) { J = ConvJob{w_out, WOUT, DM, DM, 0, DM, 0, r}; break; } r -= I_O; \
            if (r < I_XQ) { J = ConvJob{w_xq, WXQ, DM, XAW, 0, DM, 0, r}; break; } r -= I_XQ; \
            if (r < I_XQ) { J = ConvJob{w_xk, WKV, DM, XAW, 0, DM, 0, r}; break; } r -= I_XQ; \
            if (r < I_XQ) { J = ConvJob{w_xv, WKV, DM, XAW, XAW, DM, 0, r}; break; } r -= I_XQ; \
            J = ConvJob{w_xo, WXO, XAW, DM, 0, XAW, 0, r}; } while (0)
        CONV_STREAM(0, NITEMS, gw, NGW, P0_DECODE);
#undef P0_DECODE
        for (int m = gw; m < M; m += NGW) rms_row_to_bf16(x + (size_t)m * DM, mix_pre_g, H + (size_t)m * DM, F.lane);
        for (int m = gw; m < MROWS; m += NGW) rms_row_to_bf16(mem + (size_t)m * DM, mem_norm_g, MB + (size_t)m * DM, F.lane);
        for (int i = gtid; i < M * 16; i += NGT) { const int tok = i >> 4, k = i & 15; const float ang = (float)positions[tok] * ROPE_INV[k]; float sn, cs; sincos_d(ang, sn, cs);
            ROPE[(size_t)tok * 32 + k] = cs; ROPE[(size_t)tok * 32 + 16 + k] = sn; }
        for (int i = gtid; i < 16 * 128 * 128; i += NGT) { const int jj = i & 127, ii = (i >> 7) & 127; WSP[i] = (bf16)(jj <= ii ? f2bf(w_spatial[i]) : 0u); }
        if (BOTH(0)) GRID_BAR();
    }
    if (IN(1)) {
        pg8::Gemm g{H, WING, M, NPROJ, DM}; pg8::StaticOrder S; S.init(M, NPROJ, F.G, bx);
        pg8::EpiProj E{Qb, Kb, Vb, Ub, VBb, Gb, ROPE, b_gate, LNST};
        pg8::gemm_phase<pg8::EpiProj, pg8::StaticOrder, PG8_ALIGN, PG8_SP2>(F.lds + RING_OFF, g, S, E);
        if (BOTH(1)) GRID_BAR();
    }
    if (IN(2)) {
        for (int i = F.tid; i < 16 * ATT_KSTR / 4; i += NWAVES * 64) ((LAS unsigned*)(F.lds + ATT_V_OFF + 256 * ATT_KSTR))[i] = 0u;
        __syncthreads();
        self_attn_stream(F, Qb, Kb, Vb, OG, LSE);
        { const int per = (2048 % F.G == 0) ? 2048 / F.G : 0;
          if (per == 1 || per == 2 || per == 4 || per == 8 || per == 16) sgu_stream(F, per, Ub, YAB, VBb, LNST, sgu_ln_g, sgu_ln_b, WSP, b_spatial);
          else for (int idx = bx; idx < 2048; idx += F.G) sgu_unit(F, idx, Ub, YAB, VBb, LNST, sgu_ln_g, sgu_ln_b, WSP, b_spatial); }
        if (BOTH(2)) GRID_BAR();
    }
    if (IN(3)) {
        for (int i = gtid; i < M * 8 * 16; i += NGT) { const int ch = i & 15, hh = (i >> 4) & 7; const size_t tok = (size_t)(i >> 7);
            const float l0 = LSE[tok * 8 + hh], l1 = LSE[((size_t)M + tok) * 8 + hh], l2 = LSE[((size_t)2 * M + tok) * 8 + hh];
            const float mx = fmaxf(l0, fmaxf(l1, l2)); float e0 = __expf(l0 - mx), e1 = __expf(l1 - mx), e2 = __expf(l2 - mx); const float inv = 1.0f / (e0 + e1 + e2); e0 *= inv; e1 *= inv; e2 *= inv;
            const size_t o = tok * AW + hh * 128 + ch * 8;
            const v4u a = *(const GAS v4u*)(OG + o), b = *(const GAS v4u*)(OG + (size_t)M * AW + o), c = *(const GAS v4u*)(OG + (size_t)2 * M * AW + o); v4u y;
            y.x = pk2(e0 * bflo(a.x) + e1 * bflo(b.x) + e2 * bflo(c.x), e0 * bfhi(a.x) + e1 * bfhi(b.x) + e2 * bfhi(c.x));
            y.y = pk2(e0 * bflo(a.y) + e1 * bflo(b.y) + e2 * bflo(c.y), e0 * bfhi(a.y) + e1 * bfhi(b.y) + e2 * bfhi(c.y));
            y.z = pk2(e0 * bflo(a.z) + e1 * bflo(b.z) + e2 * bflo(c.z), e0 * bfhi(a.z) + e1 * bfhi(b.z) + e2 * bfhi(c.z));
            y.w = pk2(e0 * bflo(a.w) + e1 * bflo(b.w) + e2 * bflo(c.w), e0 * bfhi(a.w) + e1 * bfhi(b.w) + e2 * bfhi(c.w));
            *(GAS v4u*)(YAB + tok * YABW + hh * 128 + ch * 8) = y; }
        if (BOTH(3)) GRID_BAR();
    }
    if (IN(4)) {
        pg8::Gemm g{YAB, WAB, M, DM, YABW}; pg8::StaticOrder S; S.init(M, DM, F.G, bx); pg8::EpiMerge E{Gb, MRG, AW / pg8::BK};
        pg8::gemm_phase<pg8::EpiMerge, pg8::StaticOrder, PG8_ALIGN, PG8_SP2>(F.lds + RING_OFF, g, S, E);
        if (BOTH(4)) GRID_BAR();
    }
    if (IN(5)) {
        pg8::Gemm g{MRG, WOUT, M, DM, DM}; pg8::StaticOrder S; S.init(M, DM, F.G, bx); pg8::EpiNorm E{T, DM, SSQ};
        pg8::gemm_phase<pg8::EpiNorm, pg8::StaticOrder, PG8_ALIGN, PG8_SP2>(F.lds + RING_OFF, g, S, E);
        if (BOTH(5)) GRID_BAR();
    }
    if (IN(6)) {
        for (int m = gw; m < M; m += NGW) row_norm_res<false, true>(x + (size_t)m * DM, T + (size_t)m * DM, SSQ + (size_t)m * 64, mix_post_g, xa_pre_g, XB + (size_t)m * DM, H + (size_t)m * DM, F.lane);
#define P6_DECODE(r_, J) do { const int r = (r_); if (r < I_UP) J = ConvJob{w_up, WUP, DM, DFF, 0, DM, 0, r}; else J = ConvJob{w_down, WDN, DFF, DM, 0, DFF, 0, r - I_UP}; } while (0)
        CONV_STREAM(conv_early, I_UP + I_DN, gw, NGW, P6_DECODE);
        if (BOTH(6)) GRID_BAR();
    }
    if (IN(7)) {
        if (bx < 128) { pg8::Gemm g{H, WXQ, M, XAW, DM}; pg8::SmallOrder S; S.init(M, XAW, 0, bx); pg8::EpiPlain E{QX, XAW};
            pg8::gemm_phase<pg8::EpiPlain, pg8::SmallOrder, false, PG8_SP2>(F.lds + RING_OFF, g, S, E); }
        else if (bx < P7_BUSY) { pg8::Gemm g{MB, WKV, MROWS, 2 * XAW, DM}; pg8::SmallOrder S; S.init(MROWS, 2 * XAW, 128, bx); pg8::EpiPlain E{KVX, 2 * XAW};
            pg8::gemm_phase<pg8::EpiPlain, pg8::SmallOrder, false, PG8_SP2>(F.lds + RING_OFF, g, S, E); }
        else { const int cgw = (bx - P7_BUSY) * NWAVES + F.wave, cngw = (F.G - P7_BUSY) * NWAVES;
            CONV_STREAM(0, conv_early, cgw, cngw, P6_DECODE); }
#undef P6_DECODE
        if (BOTH(7)) GRID_BAR();
    }
    if (IN(8)) {
        cross_attn_stream(F, QX, KVX, OX);
        if (BOTH(8)) GRID_BAR();
    }
    if (IN(9)) {
        pg8::Gemm g{OX, WXO, M, DM, XAW}; pg8::StaticOrder S; S.init(M, DM, F.G, bx); pg8::EpiNorm E{T, DM, SSQ};
        pg8::gemm_phase<pg8::EpiNorm, pg8::StaticOrder, PG8_ALIGN, PG8_SP2>(F.lds + RING_OFF, g, S, E);
        if (BOTH(9)) GRID_BAR();
    }
    if (IN(10)) {
        for (int m = gw; m < M; m += NGW) row_norm_res<true, true>(XB + (size_t)m * DM, T + (size_t)m * DM, SSQ + (size_t)m * 64, xa_post_g, mlp_pre_g, XB + (size_t)m * DM, H + (size_t)m * DM, F.lane);
        if (BOTH(10)) GRID_BAR();
    }
    if (IN(11)) {
        pg8::Gemm g{H, WUP, M, DFF, DM}; pg8::StaticOrder S; S.init(M, DFF, F.G, bx); pg8::EpiRelu2 E{Ab, DFF};
        pg8::gemm_phase<pg8::EpiRelu2, pg8::StaticOrder, PG8_ALIGN, PG8_SP2>(F.lds + RING_OFF, g, S, E);
        if (BOTH(11)) GRID_BAR();
    }
    if (IN(12)) {
        pg8::Gemm g{Ab, WDN, M, DM, DFF}; pg8::StaticOrder S; S.init(M, DM, F.G, bx); pg8::EpiNorm E{T3, DM, SSQ};
        pg8::gemm_phase<pg8::EpiNorm, pg8::StaticOrder, PG8_ALIGN, PG8_SP2>(F.lds + RING_OFF, g, S, E);
        if (BOTH(12)) GRID_BAR();
    }
    if (IN(13)) {
        for (int m = gw; m < M; m += NGW) row_norm_res<true, false>(XB + (size_t)m * DM, T3 + (size_t)m * DM, SSQ + (size_t)m * 64, mlp_post_g, nullptr, out + (size_t)m * DM, nullptr, F.lane);
    }
#undef IN
#undef BOTH
}

extern "C" void kernel_launch(void* const* d_in, const int* in_sizes, int n_in, void* d_out, int out_size, void* d_ws, size_t ws_size, hipStream_t stream) {
    static int grid = 0;
    if (grid == 0) {
        if (n_in != 26 || in_sizes[0] != M * DM || out_size != M * DM || ws_size < WS_END) { fprintf(stderr, "kernel_launch: unexpected shapes (n_in %d, in0 %d, out %d, ws %zu < %zu?); nothing launched\n", n_in, n_in > 0 ? in_sizes[0] : -1, out_size, ws_size, (size_t)WS_END); grid = -1; return; }
        int dev = 0, cus = 0, per_cu = 0;
        if (hipGetDevice(&dev) != hipSuccess || hipDeviceGetAttribute(&cus, hipDeviceAttributeMultiprocessorCount, dev) != hipSuccess) { grid = -1; return; }
        if (hipFuncSetAttribute((const void*)skel_fwd, hipFuncAttributeMaxDynamicSharedMemorySize, LDS_BYTES) != hipSuccess) { fprintf(stderr, "kernel_launch: hipFuncSetAttribute failed\n"); grid = -1; return; }
        if (hipOccupancyMaxActiveBlocksPerMultiprocessor(&per_cu, (const void*)skel_fwd, NWAVES * 64, LDS_BYTES) != hipSuccess || per_cu < 1)
            fprintf(stderr, "kernel_launch: note: occupancy query reports %d workgroups per CU\n", per_cu);
        (void)hipGetLastError();
        grid = cus;
    }
    if (grid < 0) return;
    if (hipMemsetAsync((char*)d_ws + WS_CTL, 0, CTL_ZERO_BYTES, stream) != hipSuccess) return;
    Args a{};
    for (int i = 0; i < 26; ++i) a.in[i] = (const float*)d_in[i];
    a.out = (float*)d_out; a.ws = (unsigned char*)d_ws;
#if MK_PER_PHASE
    for (int li = 0; li < N_PHASES; ++li) { a.ph_lo = li; a.ph_hi = li + 1; a.li = li;
        hipLaunchKernelGGL(skel_fwd, dim3(grid), dim3(NWAVES * 64), LDS_BYTES, stream, a); }
#else
#if defined(PROBE_DUP)
    a.ph_lo = 0; a.ph_hi = PROBE_DUP + 1; a.li = 0;
    hipLaunchKernelGGL(skel_fwd, dim3(grid), dim3(NWAVES * 64), LDS_BYTES, stream, a);
    a.ph_lo = PROBE_DUP; a.ph_hi = N_PHASES; a.li = 1;
    hipLaunchKernelGGL(skel_fwd, dim3(grid), dim3(NWAVES * 64), LDS_BYTES, stream, a);
#else
    a.ph_lo = 0; a.ph_hi = N_PHASES; a.li = 0;
    hipLaunchKernelGGL(skel_fwd, dim3(grid), dim3(NWAVES * 64), LDS_BYTES, stream, a);
#endif
#endif
    const hipError_t le = hipPeekAtLastError();
    if (le != hipSuccess) fprintf(stderr, "kernel_launch: launch failed: %s\n", hipGetErrorName(le));
}
```

```cpp
#include <hip/hip_runtime.h>
#include <cstdio>
#include <cstdint>
namespace pg8 {
#define PG8_LAS __attribute__((address_space(3)))
typedef unsigned short bf16_t;
typedef short bf16x8 __attribute__((ext_vector_type(8)));
typedef float f32x4 __attribute__((ext_vector_type(4)));
typedef unsigned u32x4 __attribute__((ext_vector_type(4)));
constexpr int BM = 256, BK = 64, HALF = 128, HTB = HALF * BK * 2  , STAGE_BYTES = 8 * HTB, NXCD = 8, WGM = 8;

__host__ __device__ __forceinline__ int lds_byte(int r, int c) { const int st = (r >> 4) * 2 + (c >> 5), rr = r & 15, cc = c & 31, ob = rr * 64 + cc * 2; return st * 1024 + (ob ^ (((ob >> 9) & 1) << 5)); }
__host__ __device__ __forceinline__ void stage_rc(int b, int& R, int& C) { const int st = b / 1024, sb = b % 1024, swz = sb ^ (((sb >> 9) & 1) << 5); R = (st >> 1) * 16 + swz / 64; C = (st & 1) * 32 + (swz % 64) / 2; }
__host__ __device__ __forceinline__ int perm32(int rho) { const int n = rho >> 4, i = rho & 15; return 8 * (i >> 2) + 4 * n + (i & 3); }

struct Unit { int pm, pn; };
struct Gemm { const bf16_t* A; const bf16_t* Bt; int M, N, K; };

struct StaticOrder {
    int nM, nN, nwg, G, c;
    __host__ __device__ void init(int M, int N, int G_, int c_) { nM = M / BM; nN = N / BM; nwg = nM * nN; G = G_; c = c_; }
    __host__ __device__ bool next(int i, Unit& u) const {
        const long L = (long)i * G + c; if (L >= nwg) return false;
        int wgid = (int)L; { const int q = nwg / NXCD, r = nwg % NXCD, xcd = wgid % NXCD, off = wgid / NXCD; wgid = (xcd < r ? xcd * (q + 1) : r * (q + 1) + (xcd - r) * q) + off; }
        const int nig = WGM * nN, gid = wgid / nig, fm = gid * WGM, gsz = (nM - fm) < WGM ? (nM - fm) : WGM;
        u.pm = fm + ((wgid % nig) % gsz); u.pn = (wgid % nig) / gsz; return true;
    }
    __device__ __forceinline__ void a_ready(const Unit&) const {}
    __device__ __forceinline__ void done(const Unit&) const {}
};

__device__ __forceinline__ unsigned cvt_pk_bf16(float lo, float hi) { unsigned r; asm volatile("s_nop 0\n\tv_cvt_pk_bf16_f32 %0, %1, %2" : "=v"(r) : "v"(lo), "v"(hi)); return r; }
typedef float f32x2 __attribute__((ext_vector_type(2)));
__device__ __forceinline__ u32x4 pack8(const f32x4 a, const f32x4 b) { u32x4 w; w.x = cvt_pk_bf16(a[0], a[1]); w.y = cvt_pk_bf16(a[2], a[3]); w.z = cvt_pk_bf16(b[0], b[1]); w.w = cvt_pk_bf16(b[2], b[3]); return w; }
__device__ __forceinline__ float bf_lo(unsigned w) { return __uint_as_float(w << 16); }
__device__ __forceinline__ float bf_hi(unsigned w) { return __uint_as_float(w & 0xffff0000u); }
__device__ __forceinline__ void unpack8(const u32x4 w, f32x4& a, f32x4& b) { a = (f32x4){bf_lo(w.x), bf_hi(w.x), bf_lo(w.y), bf_hi(w.y)}; b = (f32x4){bf_lo(w.z), bf_hi(w.z), bf_lo(w.w), bf_hi(w.w)}; }
__device__ __forceinline__ float gelu_tanh(float x) { const float u = x * (0.7978845608028654f + 0.035677408136300125f * x * x);
    const float e = __builtin_amdgcn_exp2f(-2.885390081777927f * u); return x * __builtin_amdgcn_rcpf(1.0f + e); }
__device__ __forceinline__ float sigmoid_f(float z) { return __builtin_amdgcn_rcpf(1.0f + __builtin_amdgcn_exp2f(-1.4426950408889634f * z)); }
__device__ __forceinline__ f32x4 gelu4(f32x4 v) { return (f32x4){gelu_tanh(v[0]), gelu_tanh(v[1]), gelu_tanh(v[2]), gelu_tanh(v[3])}; }
__device__ __forceinline__ f32x4 sigm4(f32x4 v) { return (f32x4){sigmoid_f(v[0]), sigmoid_f(v[1]), sigmoid_f(v[2]), sigmoid_f(v[3])}; }
__device__ __forceinline__ float hsum4(f32x4 v) { return (v[0] + v[1]) + (v[2] + v[3]); }

struct EpiPlain {
    static constexpr bool PERM = true, AFTER_DRAIN = false, HAS_MID = false;
    bf16_t* O; int ldc;
    __device__ __forceinline__ void operator()(const f32x4 (&acc)[2][2][4][2], const Unit& u, int wr, int wc, int fr, int fq) const {
        const int row0 = u.pm * BM + wr * 64 + fr, col0 = u.pn * BM + wc * 32 + 8 * fq;
#pragma unroll
        for (int ai = 0; ai < 2; ++ai)
#pragma unroll
            for (int m = 0; m < 4; ++m) { bf16_t* rowp = O + (size_t)(row0 + ai * HALF + m * 16) * ldc + col0;
#pragma unroll
                for (int bj = 0; bj < 2; ++bj) *(u32x4*)(rowp + bj * HALF) = pack8(acc[ai][bj][m][0], acc[ai][bj][m][1]); }
    }
};
struct EpiRelu2 {
    static constexpr bool PERM = true, AFTER_DRAIN = false, HAS_MID = false;
    bf16_t* O; int ldc;
    __device__ __forceinline__ void operator()(const f32x4 (&acc)[2][2][4][2], const Unit& u, int wr, int wc, int fr, int fq) const {
        const int row0 = u.pm * BM + wr * 64 + fr, col0 = u.pn * BM + wc * 32 + 8 * fq;
#pragma unroll
        for (int ai = 0; ai < 2; ++ai)
#pragma unroll
            for (int m = 0; m < 4; ++m) { bf16_t* rowp = O + (size_t)(row0 + ai * HALF + m * 16) * ldc + col0;
#pragma unroll
                for (int bj = 0; bj < 2; ++bj) { f32x4 v0 = acc[ai][bj][m][0], v1 = acc[ai][bj][m][1];
                    v0 = __builtin_elementwise_max(v0, (f32x4){0.f, 0.f, 0.f, 0.f}); v1 = __builtin_elementwise_max(v1, (f32x4){0.f, 0.f, 0.f, 0.f});
                    *(u32x4*)(rowp + bj * HALF) = pack8(v0 * v0, v1 * v1); } }
    }
};
struct EpiNorm {
    static constexpr bool PERM = true, AFTER_DRAIN = false, HAS_MID = false;
    bf16_t* O; int ldc; float* ssq;
    __device__ __forceinline__ void operator()(const f32x4 (&acc)[2][2][4][2], const Unit& u, int wr, int wc, int fr, int fq) const {
        const int row0 = u.pm * BM + wr * 64 + fr, col0 = u.pn * BM + wc * 32 + 8 * fq;
#pragma unroll
        for (int ai = 0; ai < 2; ++ai)
#pragma unroll
            for (int m = 0; m < 4; ++m) { const int row = row0 + ai * HALF + m * 16; bf16_t* rowp = O + (size_t)row * ldc + col0; float q = 0.f;
#pragma unroll
                for (int bj = 0; bj < 2; ++bj) { const f32x4 v0 = acc[ai][bj][m][0], v1 = acc[ai][bj][m][1]; q += hsum4(v0 * v0) + hsum4(v1 * v1);
                    *(u32x4*)(rowp + bj * HALF) = pack8(v0, v1); }
                q += __shfl_xor(q, 16); q += __shfl_xor(q, 32);
                if (fq == 0) ssq[(size_t)row * 64 + u.pn * 4 + wc] = q; }
    }
};
struct EpiMerge {
    static constexpr bool PERM = true, AFTER_DRAIN = false, HAS_MID = true;
    const bf16_t* G; bf16_t* MG; int tmid;
    __device__ __forceinline__ void mid(f32x4 (&acc)[2][2][4][2], const Unit& u, int wr, int wc, int fr, int fq) const {
        const int row0 = u.pm * BM + wr * 64 + fr, col0 = u.pn * BM + wc * 32 + 8 * fq;
        size_t off0 = (size_t)row0 * 8192 + col0; asm volatile("" : "+v"(off0));
#pragma unroll
        for (int ai = 0; ai < 2; ++ai)
#pragma unroll
            for (int m = 0; m < 4; ++m) { const bf16_t* gp = G + off0 + (size_t)(ai * HALF + m * 16) * 8192;
#pragma unroll
                for (int bj = 0; bj < 2; ++bj) { f32x4 a0, a1, b0, b1; unpack8(*(const u32x4*)(gp + bj * HALF), a0, a1); unpack8(*(const u32x4*)(gp + 4096 + bj * HALF), b0, b1);
#pragma unroll
                    for (int e = 0; e < 4; ++e) { a0[e] *= __builtin_amdgcn_rcpf(fmaxf(b0[e], 1e-20f)); a1[e] *= __builtin_amdgcn_rcpf(fmaxf(b1[e], 1e-20f)); }
                    acc[ai][bj][m][0] *= a0; acc[ai][bj][m][1] *= a1; }
                asm volatile("" ::: "memory"); }
    }
    __device__ __forceinline__ void operator()(const f32x4 (&acc)[2][2][4][2], const Unit& u, int wr, int wc, int fr, int fq) const {
        const int row0 = u.pm * BM + wr * 64 + fr, col0 = u.pn * BM + wc * 32 + 8 * fq;
#pragma unroll
        for (int ai = 0; ai < 2; ++ai)
#pragma unroll
            for (int m = 0; m < 4; ++m) { const size_t row = (size_t)(row0 + ai * HALF + m * 16);
#pragma unroll
                for (int bj = 0; bj < 2; ++bj) { f32x4 b0, b1; unpack8(*(const u32x4*)(G + row * 8192 + 4096 + col0 + bj * HALF), b0, b1);
                    b0 = __builtin_elementwise_max(b0, (f32x4){1e-20f, 1e-20f, 1e-20f, 1e-20f}); b1 = __builtin_elementwise_max(b1, (f32x4){1e-20f, 1e-20f, 1e-20f, 1e-20f});
                    *(u32x4*)(MG + row * 4096 + col0 + bj * HALF) = pack8(acc[ai][bj][m][0] * b0, acc[ai][bj][m][1] * b1); } }
    }
};
struct EpiProj {
    static constexpr bool PERM = true, AFTER_DRAIN = false, HAS_MID = false;
    bf16_t *Q, *K, *V, *U, *VB, *G; const float* rope; const float* bgate; float* lnstat;
    __device__ __forceinline__ void operator()(const f32x4 (&acc)[2][2][4][2], const Unit& u, int wr, int wc, int fr, int fq) const {
        const int pn = u.pn, row0 = u.pm * BM + wr * 64 + fr, lc0 = wc * 32 + 8 * fq;
        if (pn < 24) {
            bf16_t* base = pn < 12 ? Q : K; const int colt = (pn < 12 ? pn : pn - 12) * BM + lc0; const float sgn = (fq & 2) ? 1.f : -1.f;
#pragma unroll
            for (int ai = 0; ai < 2; ++ai)
#pragma unroll
                for (int m = 0; m < 4; ++m) { const size_t row = (size_t)(row0 + ai * HALF + m * 16); bf16_t* rowp = base + row * 3072 + colt;
                    f32x4 c0 = {0.f, 0.f, 0.f, 0.f}, c1 = c0, s0 = c0, s1 = c0;
                    if (wc == 0) { const float* rp = rope + row * 32 + 8 * (fq & 1); c0 = *(const f32x4*)rp; c1 = *(const f32x4*)(rp + 4); s0 = *(const f32x4*)(rp + 16); s1 = *(const f32x4*)(rp + 20); }
#pragma unroll
                    for (int bj = 0; bj < 2; ++bj) { f32x4 v0 = acc[ai][bj][m][0], v1 = acc[ai][bj][m][1];
                        if (wc == 0) { f32x4 p0, p1;
#pragma unroll
                            for (int e = 0; e < 4; ++e) { p0[e] = __shfl_xor(v0[e], 32); p1[e] = __shfl_xor(v1[e], 32); }
                            v0 = v0 * c0 + (p0 * s0) * sgn; v1 = v1 * c1 + (p1 * s1) * sgn; }
                        *(u32x4*)(rowp + bj * HALF) = pack8(v0, v1); } }
        } else if (pn < 36) {
            const int colt = (pn - 24) * BM + lc0;
#pragma unroll
            for (int ai = 0; ai < 2; ++ai)
#pragma unroll
                for (int m = 0; m < 4; ++m) { bf16_t* rowp = V + (size_t)(row0 + ai * HALF + m * 16) * 3072 + colt;
#pragma unroll
                    for (int bj = 0; bj < 2; ++bj) *(u32x4*)(rowp + bj * HALF) = pack8(acc[ai][bj][m][0], acc[ai][bj][m][1]); }
        } else if (pn < 44) {
            const int colt = (pn - 36) * BM + lc0;
#pragma unroll
            for (int ai = 0; ai < 2; ++ai)
#pragma unroll
                for (int m = 0; m < 4; ++m) { bf16_t* rowp = U + (size_t)(row0 + ai * HALF + m * 16) * 2048 + colt;
#pragma unroll
                    for (int bj = 0; bj < 2; ++bj) *(u32x4*)(rowp + bj * HALF) = pack8(gelu4(acc[ai][bj][m][0]), gelu4(acc[ai][bj][m][1])); }
        } else if (pn < 52) {
            const int colt = (pn - 44) * BM + lc0;
#pragma unroll
            for (int ai = 0; ai < 2; ++ai)
#pragma unroll
                for (int m = 0; m < 4; ++m) { const size_t row = (size_t)(row0 + ai * HALF + m * 16); bf16_t* rowp = VB + row * 2048 + colt; float s = 0.f, q = 0.f;
#pragma unroll
                    for (int bj = 0; bj < 2; ++bj) { const f32x4 v0 = gelu4(acc[ai][bj][m][0]), v1 = gelu4(acc[ai][bj][m][1]);
                        s += hsum4(v0) + hsum4(v1); q += hsum4(v0 * v0) + hsum4(v1 * v1); *(u32x4*)(rowp + bj * HALF) = pack8(v0, v1); }
                    s += __shfl_xor(s, 16); s += __shfl_xor(s, 32); q += __shfl_xor(q, 16); q += __shfl_xor(q, 32);
                    if (fq == 0) *(f32x2*)(lnstat + (row * 32 + (pn - 44) * 4 + wc) * 2) = (f32x2){s, q}; }
        } else {
            const int colt = (pn - 52) * BM + lc0;
            f32x4 bv[2][2];
#pragma unroll
            for (int bj = 0; bj < 2; ++bj) { bv[bj][0] = *(const f32x4*)(bgate + colt + bj * HALF); bv[bj][1] = *(const f32x4*)(bgate + colt + bj * HALF + 4); }
#pragma unroll
            for (int ai = 0; ai < 2; ++ai)
#pragma unroll
                for (int m = 0; m < 4; ++m) { bf16_t* rowp = G + (size_t)(row0 + ai * HALF + m * 16) * 8192 + colt;
#pragma unroll
                    for (int bj = 0; bj < 2; ++bj) *(u32x4*)(rowp + bj * HALF) = pack8(sigm4(acc[ai][bj][m][0] + bv[bj][0]), sigm4(acc[ai][bj][m][1] + bv[bj][1])); }
        }
    }
};
struct SmallOrder {
    int nN, nwg, c;
    __device__ void init(int M, int N, int first, int bx) { nN = N / BM; nwg = (M / BM) * nN; c = bx - first; }
    __device__ bool next(int i, Unit& u) const { if (i != 0 || c < 0 || c >= nwg) return false; u.pm = c / nN; u.pn = c % nN; return true; }
    __device__ __forceinline__ void a_ready(const Unit&) const {}
    __device__ __forceinline__ void done(const Unit&) const {}
};
template <class Epi, class Sched, bool ALIGN_EPI = false, bool SP2 = false>
__device__ __forceinline__ void gemm_phase(PG8_LAS unsigned char* lds, const Gemm g, const Sched& S, const Epi& E) {
    const int tid = threadIdx.x, wid = __builtin_amdgcn_readfirstlane(tid >> 6), lane = tid & 63, wr = wid >> 2, wc = wid & 3, fr = lane & 15, fq = lane >> 4;
    const int K = g.K, nt = K / BK;
    unsigned voffA[2], voffB[2];
#pragma unroll
    for (int i = 0; i < 2; ++i) { int R, C; stage_rc(tid * 16 + i * 8192, R, C); const int Rb = Epi::PERM ? ((R & ~31) + perm32(R & 31)) : R;
        voffA[i] = (unsigned)(R * K + C) * 2u; voffB[i] = (unsigned)(Rb * K + C) * 2u; }
    const size_t kstep = (size_t)(BK * 2);
    const size_t hstep = (size_t)HALF * K * 2;
    const size_t tstep = 2 * hstep;
    const unsigned ldsw = (unsigned)wid * 1024u;
    const int aoff = lds_byte(wr * 64 + fr, fq * 8), boff = lds_byte(wc * 32 + fr, fq * 8);
#define PG8_SA(b, h) (((b) * 2 + (h)) * HTB)
#define PG8_SB(b, h) ((4 + (b) * 2 + (h)) * HTB)
#define PG8_STAGE(bufoff, gbase, voff) do { _Pragma("unroll") for (int _i = 0; _i < 2; ++_i) \
        __builtin_amdgcn_global_load_lds((const unsigned*)((const char*)(gbase) + (voff)[_i]), (PG8_LAS unsigned*)(lds + (bufoff) + ldsw + _i * 8192), 16, 0, 0); } while (0)
#define PG8_LDA(dst, b, h) do { _Pragma("unroll") for (int m = 0; m < 4; ++m) _Pragma("unroll") for (int k = 0; k < 2; ++k) dst[m][k] = *(const PG8_LAS bf16x8*)(lds + PG8_SA(b, h) + aoff + m * 2048 + k * 1024); } while (0)
#define PG8_LDB(dst, b, h) do { _Pragma("unroll") for (int n = 0; n < 2; ++n) _Pragma("unroll") for (int k = 0; k < 2; ++k) dst[n][k] = *(const PG8_LAS bf16x8*)(lds + PG8_SB(b, h) + boff + n * 2048 + k * 1024); } while (0)
#define PG8_MMA(ai, bj, At, Bt) do { __builtin_amdgcn_s_setprio(1); _Pragma("unroll") for (int m = 0; m < 4; ++m) _Pragma("unroll") for (int n = 0; n < 2; ++n) _Pragma("unroll") for (int k = 0; k < 2; ++k) \
        acc[ai][bj][m][n] = __builtin_amdgcn_mfma_f32_16x16x32_bf16(Bt[n][k], At[m][k], acc[ai][bj][m][n], 0, 0, 0); __builtin_amdgcn_s_setprio(0); } while (0)
#define PG8_WAIT_V(n) asm volatile("s_waitcnt vmcnt(" #n ")" ::: "memory")
#define PG8_WAIT_L(n) asm volatile("s_waitcnt lgkmcnt(" #n ")" ::: "memory")
#define PG8_BAR __builtin_amdgcn_s_barrier()
#define PG8_SCHED __builtin_amdgcn_sched_barrier(0)
    Unit cur, nxt; int ui = 0;
    if (!S.next(0, cur)) return;
    f32x4 acc[2][2][4][2];
#pragma unroll
    for (int a = 0; a < 2; ++a)
#pragma unroll
        for (int b = 0; b < 2; ++b)
#pragma unroll
            for (int m = 0; m < 4; ++m)
#pragma unroll
                for (int n = 0; n < 2; ++n) acc[a][b][m][n] = (f32x4){0.f, 0.f, 0.f, 0.f};
    bf16x8 At[4][2], B0[2][2], B1[2][2];
    const char* cA = (const char*)g.A + (size_t)cur.pm * tstep; const char* cB = (const char*)g.Bt + (size_t)cur.pn * tstep;
    S.a_ready(cur);
    if constexpr (SP2) {
        PG8_STAGE(PG8_SB(0, 0), cB, voffB); PG8_STAGE(PG8_SB(0, 1), cB + hstep, voffB); PG8_STAGE(PG8_SA(0, 0), cA, voffA); PG8_STAGE(PG8_SA(0, 1), cA + hstep, voffA);
        if (wr == 1) PG8_BAR;
        PG8_WAIT_V(2); PG8_BAR;
        PG8_STAGE(PG8_SB(1, 0), cB + kstep, voffB); PG8_STAGE(PG8_SA(1, 0), cA + kstep, voffA); PG8_STAGE(PG8_SB(1, 1), cB + hstep + kstep, voffB);
        PG8_WAIT_V(6); PG8_BAR;
    } else {
        PG8_STAGE(PG8_SB(0, 0), cB, voffB); PG8_STAGE(PG8_SA(0, 0), cA, voffA); PG8_STAGE(PG8_SB(0, 1), cB + hstep, voffB); PG8_STAGE(PG8_SA(0, 1), cA + hstep, voffA);
        if (wr == 1) PG8_BAR;
        PG8_WAIT_V(4); PG8_BAR;
        PG8_STAGE(PG8_SB(1, 0), cB + kstep, voffB); PG8_STAGE(PG8_SA(1, 0), cA + kstep, voffA); PG8_STAGE(PG8_SB(1, 1), cB + hstep + kstep, voffB);
        PG8_WAIT_V(6); PG8_BAR;
    }
    for (;;) {
        const bool has_next = S.next(ui + 1, nxt);
        const char* nA = has_next ? (const char*)g.A + (size_t)nxt.pm * tstep : cA; const char* nB = has_next ? (const char*)g.Bt + (size_t)nxt.pn * tstep : cB;
#define PG8_KITER(t) do { \
            const bool last = ((t) == nt - 2); \
            const char* a1 = cA + (size_t)((t) + 1) * kstep; \
            const char* a2 = last ? nA : cA + (size_t)((t) + 2) * kstep; const char* b2 = last ? nB : cB + (size_t)((t) + 2) * kstep; \
            const char* a3 = a2 + kstep; const char* b3 = b2 + kstep; \
            if (last && has_next) S.a_ready(nxt); \
            PG8_LDB(B0, 0, 0); PG8_LDB(B1, 0, 1); PG8_SCHED; PG8_LDA(At, 0, 0); PG8_STAGE(PG8_SA(1, 1), a1 + hstep, voffA); \
            PG8_WAIT_V(8); PG8_WAIT_L(0); PG8_BAR; PG8_MMA(0, 0, At, B0); PG8_MMA(0, 1, At, B1); PG8_BAR; PG8_SCHED; \
            PG8_LDA(At, 0, 1); PG8_STAGE(PG8_SB(0, 0), b2, voffB); PG8_STAGE(PG8_SB(0, 1), b2 + hstep, voffB); PG8_STAGE(PG8_SA(0, 0), a2, voffA); \
            PG8_WAIT_V(8); PG8_WAIT_L(0); PG8_BAR; PG8_MMA(1, 0, At, B0); PG8_MMA(1, 1, At, B1); PG8_BAR; PG8_SCHED; \
            PG8_LDB(B0, 1, 0); PG8_LDB(B1, 1, 1); PG8_SCHED; PG8_LDA(At, 1, 0); PG8_STAGE(PG8_SA(0, 1), a2 + hstep, voffA); \
            PG8_WAIT_V(8); PG8_WAIT_L(0); PG8_BAR; PG8_MMA(0, 0, At, B0); PG8_MMA(0, 1, At, B1); PG8_BAR; PG8_SCHED; \
            PG8_LDA(At, 1, 1); PG8_STAGE(PG8_SB(1, 0), b3, voffB); PG8_STAGE(PG8_SB(1, 1), b3 + hstep, voffB); PG8_STAGE(PG8_SA(1, 0), a3, voffA); \
            PG8_WAIT_V(8); PG8_WAIT_L(0); PG8_BAR; PG8_MMA(1, 0, At, B0); PG8_MMA(1, 1, At, B1); PG8_BAR; PG8_SCHED; \
        } while (0)
        static_assert(SP2, "this copy of the body keeps only the two-super-phase K-loop");
        if constexpr (Epi::HAS_MID) {
            const int tm = E.tmid;
            for (int t = 0; t < tm; t += 2) PG8_KITER(t);
            E.mid(acc, cur, wr, wc, fr, fq);
            for (int t = tm; t < nt; t += 2) PG8_KITER(t);
        } else {
            for (int t = 0; t < nt; t += 2) PG8_KITER(t);
        }
#undef PG8_KITER
        if constexpr (ALIGN_EPI) { if (wr == 0) PG8_BAR; }
        if constexpr (!Epi::AFTER_DRAIN) { E(acc, cur, wr, wc, fr, fq); S.done(cur); }
        if (!has_next) break;
#pragma unroll
        for (int a = 0; a < 2; ++a)
#pragma unroll
            for (int b = 0; b < 2; ++b)
#pragma unroll
                for (int m = 0; m < 4; ++m)
#pragma unroll
                    for (int n = 0; n < 2; ++n) acc[a][b][m][n] = (f32x4){0.f, 0.f, 0.f, 0.f};
        cur = nxt; cA = nA; cB = nB; ++ui;
        if constexpr (ALIGN_EPI) { if (wr == 1) PG8_BAR; }
    }
    PG8_WAIT_V(0);
    if constexpr (!ALIGN_EPI) { if (wr == 0) PG8_BAR; }
    PG8_BAR;
    if constexpr (Epi::AFTER_DRAIN) { E.fused(acc, cur, wr, wc, fr, fq, lds, wid, lane); S.done(cur); }
#undef PG8_SA
#undef PG8_SB
#undef PG8_STAGE
#undef PG8_LDA
#undef PG8_LDB
#undef PG8_MMA
#undef PG8_WAIT_V
#undef PG8_WAIT_L
#undef PG8_BAR
#undef PG8_SCHED
}
}
#ifndef PG8_SP2
#define PG8_SP2 true
#endif
#ifndef PG8_ALIGN
#define PG8_ALIGN true
#endif
constexpr int NWAVES = 8;
#ifndef MK_PER_PHASE
#define MK_PER_PHASE 0
#endif
constexpr int N_PHASES = 14;

constexpr int BATCH = 4, SEQ = 4096, DM = 4096, M = BATCH * SEQ;
constexpr int AW = 1024, QKVW = 3072, SGW = 2048, INW = 13312, GW = 8192, NPROJ = INW + GW;
constexpr int XAW = 512, NMEM = 256, MROWS = BATCH * NMEM, DFF = 16384;
constexpr float EPS = 1e-6f;

constexpr size_t MiB = 1u << 20;
constexpr size_t WS_CTL = 0, CTL_ZERO_BYTES = 1 * MiB;
constexpr size_t WS_ROPE = 1 * MiB;
constexpr size_t WS_LNST = 3 * MiB;
constexpr size_t WS_SSQ = 7 * MiB;
constexpr size_t WS_LSE = 11 * MiB;
constexpr size_t WS_WSP = 13 * MiB;
constexpr size_t WS_WING = 16 * MiB;
constexpr size_t WS_WA = 184 * MiB;
constexpr size_t WS_WOUT = 208 * MiB;
constexpr size_t WS_WXQ = 240 * MiB;
constexpr size_t WS_WKV = 244 * MiB;
constexpr size_t WS_WXO = 252 * MiB;
constexpr size_t WS_H = 256 * MiB;
constexpr size_t WS_Q = 384 * MiB, WS_K = 480 * MiB, WS_V = 576 * MiB;
constexpr size_t WS_U = 672 * MiB, WS_VB = 736 * MiB;
constexpr size_t WS_G = 800 * MiB;
constexpr size_t WS_MRG = 1056 * MiB;
constexpr size_t WS_OG = 1056 * MiB;
constexpr size_t WS_KVX = 1216 * MiB;
constexpr size_t WS_MB = 1218 * MiB;
constexpr size_t WS_T = 384 * MiB;
constexpr size_t WS_QX = 512 * MiB, WS_OX = 528 * MiB;
constexpr size_t WS_A = 384 * MiB;
constexpr size_t WS_WUP = 896 * MiB;
constexpr size_t WS_WDN = 1024 * MiB;
constexpr size_t WS_YAB = 16 * MiB;
constexpr size_t WS_T3 = 256 * MiB;
constexpr size_t WS_XB = 16 * MiB;
constexpr size_t WS_END = 1226 * MiB;
constexpr int CW_TMO = 0, CW_CODE = 1, CW_BAR = 4096, CW_TICKET = 16384;

constexpr int RING_OFF = 0, RING_BYTES = 131072;
constexpr int ATT_KSTR = 272;
constexpr int ATT_K_OFF = 0, ATT_V_OFF = 256 * ATT_KSTR, ATT_END = ATT_V_OFF + 272 * ATT_KSTR;
constexpr int MISC_OFF = 144384, LDS_BYTES = 147456;
static_assert(ATT_END <= MISC_OFF && MISC_OFF + 128 <= LDS_BYTES, "LDS map");

#define GAS __attribute__((address_space(1)))
#define LAS __attribute__((address_space(3)))
typedef unsigned short bf16;
typedef unsigned v4u __attribute__((ext_vector_type(4)));
typedef unsigned v2u __attribute__((ext_vector_type(2)));
typedef float f32x4 __attribute__((ext_vector_type(4)));
typedef float f32x2 __attribute__((ext_vector_type(2)));
typedef short bf16x8 __attribute__((ext_vector_type(8)));
typedef short s16x4 __attribute__((ext_vector_type(4)));
typedef GAS unsigned gu32;
#define RLX_AGENT __ATOMIC_RELAXED, __HIP_MEMORY_SCOPE_AGENT
#define LDS_WAIT() asm volatile("s_waitcnt lgkmcnt(0)" ::: "memory")
#define VM_WAIT() asm volatile("s_waitcnt vmcnt(0)" ::: "memory")
__device__ __forceinline__ unsigned f2bf(float f) { unsigned u = __builtin_bit_cast(unsigned, f); return (u + 0x7fffu + ((u >> 16) & 1u)) >> 16; }
__device__ __forceinline__ unsigned pk2(float lo, float hi) { return f2bf(lo) | (f2bf(hi) << 16); }
__device__ __forceinline__ float bflo(unsigned w) { return __uint_as_float(w << 16); }
__device__ __forceinline__ float bfhi(unsigned w) { return __uint_as_float(w & 0xffff0000u); }

#define XB_TMO      128
#define XB_XCNT(j)  (256  + 64 * (j))
#define XB_XSUB(j)  (1280 + 64 * (j))
#define XB_XGEN(j)  (2304 + 64 * (j))
#define XB_TOP      3328
#define XB_TOPGEN   3392
#define XCD_BAR_WORDS 3456
#define XB_SPIN_CAP (1u << 18)

__device__ __forceinline__ unsigned xb_ld(unsigned* p)              { return __hip_atomic_load(p, __ATOMIC_RELAXED, __HIP_MEMORY_SCOPE_AGENT); }
__device__ __forceinline__ unsigned xb_add(unsigned* p, unsigned v) { return __hip_atomic_fetch_add(p, v, __ATOMIC_RELAXED, __HIP_MEMORY_SCOPE_AGENT); }
__device__ __forceinline__ unsigned xb_xcc_id() { return (unsigned)__builtin_amdgcn_s_getreg((3 << 11) | 20) & 0xFu; }
#define XB_SPIN(cond, bar) do { unsigned _sp = 0; while (cond) { __builtin_amdgcn_s_sleep(1); \
    if ((++_sp & 255u) == 0u) { if (xb_ld(&(bar)[XB_TMO])) break; if (_sp > XB_SPIN_CAP) { atomicAdd(&(bar)[XB_TMO], 1u); break; } } } } while (0)

struct XcdBarrier {
    unsigned* bar; unsigned x;
    volatile LAS unsigned* st;
};

__device__ __forceinline__ XcdBarrier xcd_barrier_post(unsigned* bar, volatile LAS unsigned* st) {
    XcdBarrier b; b.bar = bar; b.x = xb_xcc_id(); b.st = st;
    if (threadIdx.x == 0) (void)xb_add(&bar[XB_XCNT(b.x)], 1u);
    return b;
}
__device__ __forceinline__ void xcd_barrier_complete(unsigned* bar, unsigned x, unsigned& nloc, unsigned& nx) {
    const unsigned G = gridDim.x * gridDim.y * gridDim.z;
    unsigned sum, cnt, mine, sp = 0u;
    for (;;) {
        sum = 0u; cnt = 0u; mine = 0u;
#pragma unroll
        for (unsigned j = 0; j < 16; ++j) { const unsigned c = xb_ld(&bar[XB_XCNT(j)]); sum += c; cnt += (c > 0u) ? 1u : 0u; mine = (j == x) ? c : mine; }
        if (sum == G) break;
        __builtin_amdgcn_s_sleep(1);
        if ((++sp & 255u) == 0u) { if (xb_ld(&bar[XB_TMO])) break; if (sp > XB_SPIN_CAP) { atomicAdd(&bar[XB_TMO], 1u); break; } }
    }
    nloc = mine > 0u ? mine : 1u; nx = cnt > 0u ? cnt : 1u;
}

__device__ __forceinline__ void xcd_barrier(const XcdBarrier& b) {
    asm volatile("s_waitcnt vmcnt(0)" ::: "memory");
    __syncthreads();
    if (threadIdx.x == 0) {
        unsigned* bar = b.bar;
        __builtin_amdgcn_s_waitcnt(0);
        unsigned nloc = b.st[0], nx = b.st[1];
        if (nloc == 0u) { xcd_barrier_complete(bar, b.x, nloc, nx); b.st[0] = nloc; b.st[1] = nx; }
        const unsigned old = xb_add(&bar[XB_XSUB(b.x)], 1u);
        const unsigned gen = old / nloc;
        if (old + 1u == (gen + 1u) * nloc) {
            __builtin_amdgcn_fence(__ATOMIC_RELEASE, "agent");
            asm volatile("s_waitcnt vmcnt(0)" ::: "memory");
            const unsigned og = xb_add(&bar[XB_TOP], 1u);
            const unsigned tg = og / nx;
            if (og + 1u == (tg + 1u) * nx) xb_add(&bar[XB_TOPGEN], 1u);
            else XB_SPIN(xb_ld(&bar[XB_TOPGEN]) == tg, bar);
            __builtin_amdgcn_fence(__ATOMIC_ACQUIRE, "agent");
            xb_add(&bar[XB_XGEN(b.x)], 1u);
            asm volatile("s_waitcnt vmcnt(0)" ::: "memory");
        } else {
            XB_SPIN(xb_ld(&bar[XB_XGEN(b.x)]) == gen, bar);
            __builtin_amdgcn_fence(__ATOMIC_ACQUIRE, "agent");
            asm volatile("s_waitcnt vmcnt(0)" ::: "memory");
        }
    }
    __syncthreads();
}

struct Frame {
    LAS unsigned char* lds;
    volatile LAS unsigned* MISC;
    gu32* ctl;
    int tid, lane, wave;
    int vcu, G;
    unsigned char* ws;
};
__device__ __forceinline__ float wave_sum(float v) {
#pragma unroll
    for (int o = 1; o < 64; o <<= 1) v += __shfl_xor(v, o);
    return v;
}
__device__ __forceinline__ void p0_transpose_item(const float* W, int K, int N, bf16* WT, int row_off, LAS float* scr, int item, int lane, int ldk = 0, int koff = 0) {
    if (ldk == 0) ldk = K;
    const int nblk = N / 32, kb = item / nblk, nb = item % nblk, k0 = 64 * kb, n0 = 32 * nb;
#pragma unroll 8
    for (int i = 0; i < 32; ++i) { const int kk = 2 * i + (lane >> 5); scr[kk * 33 + (lane & 31)] = W[(size_t)(k0 + kk) * N + n0 + (lane & 31)]; }
    LDS_WAIT(); asm volatile("" ::: "memory");
    const int c = lane & 7;
#pragma unroll
    for (int j = 0; j < 4; ++j) { const int n = (lane >> 3) + 8 * j; const LAS float* s = scr + (8 * c) * 33 + n;
        v4u o; o.x = pk2(s[0 * 33], s[1 * 33]); o.y = pk2(s[2 * 33], s[3 * 33]); o.z = pk2(s[4 * 33], s[5 * 33]); o.w = pk2(s[6 * 33], s[7 * 33]);
        *(GAS v4u*)(WT + (size_t)(row_off + n0 + n) * ldk + koff + k0 + 8 * c) = o; }
    LDS_WAIT(); asm volatile("" ::: "memory");
}
__device__ __forceinline__ void rms_row_to_bf16(const float* xrow, const float* g, bf16* orow, int lane) {
    const GAS f32x4* xr = (const GAS f32x4*)xrow + lane; const GAS f32x4* gr = (const GAS f32x4*)g + lane;
    f32x4 v[16]; float s = 0.f;
#pragma unroll
    for (int j = 0; j < 16; ++j) { v[j] = xr[64 * j]; s += (v[j].x * v[j].x + v[j].y * v[j].y) + (v[j].z * v[j].z + v[j].w * v[j].w); }
    const float r = 1.0f / sqrtf(wave_sum(s) * (1.f / 4096.f) + EPS);
    GAS v2u* o8 = (GAS v2u*)orow + lane;
#pragma unroll
    for (int j = 0; j < 16; ++j) { const f32x4 gg = gr[64 * j]; v2u o; o.x = pk2(v[j].x * r * gg.x, v[j].y * r * gg.y); o.y = pk2(v[j].z * r * gg.z, v[j].w * r * gg.w); o8[64 * j] = o; }
}
template <bool XIB, bool XOB>
__device__ __forceinline__ void row_norm_res(const void* xin, const bf16* trow, const float* ssq, const float* gpost, const float* gpre, void* xout, bf16* hout, int lane) {
    const float r1 = 1.0f / sqrtf(wave_sum(ssq[lane]) * (1.f / 4096.f) + EPS);
    const GAS v2u* tr = (const GAS v2u*)trow + lane; const GAS f32x4* gp = (const GAS f32x4*)gpost + lane;
    f32x4 v[16]; float s = 0.f;
#pragma unroll
    for (int j = 0; j < 16; ++j) { f32x4 xv;
        if (XIB) { const v2u xw = ((const GAS v2u*)xin + lane)[64 * j]; xv = (f32x4){bflo(xw.x), bfhi(xw.x), bflo(xw.y), bfhi(xw.y)}; } else xv = ((const GAS f32x4*)xin + lane)[64 * j];
        const v2u tw = tr[64 * j]; const f32x4 gg = gp[64 * j];
        f32x4 o; o.x = xv.x + bflo(tw.x) * r1 * gg.x; o.y = xv.y + bfhi(tw.x) * r1 * gg.y; o.z = xv.z + bflo(tw.y) * r1 * gg.z; o.w = xv.w + bfhi(tw.y) * r1 * gg.w;
        v[j] = o; s += (o.x * o.x + o.y * o.y) + (o.z * o.z + o.w * o.w);
        if (XOB) { v2u ow; ow.x = pk2(o.x, o.y); ow.y = pk2(o.z, o.w); ((GAS v2u*)xout + lane)[64 * j] = ow; } else ((GAS f32x4*)xout + lane)[64 * j] = o; }
    if (hout) {
        const float r2 = 1.0f / sqrtf(wave_sum(s) * (1.f / 4096.f) + EPS);
        const GAS f32x4* gq = (const GAS f32x4*)gpre + lane; GAS v2u* o8 = (GAS v2u*)hout + lane;
#pragma unroll
        for (int j = 0; j < 16; ++j) { const f32x4 gg = gq[64 * j]; v2u o; o.x = pk2(v[j].x * r2 * gg.x, v[j].y * r2 * gg.y); o.y = pk2(v[j].z * r2 * gg.z, v[j].w * r2 * gg.w); o8[64 * j] = o; }
    }
}
__device__ __forceinline__ void sincos_d(float angf, float& sn, float& cs) {
    const double a = (double)angf; const double n = __builtin_rint(a * 0.6366197723675814);
    double r = __builtin_fma(-n, 1.5707963267948966, a); r = __builtin_fma(-n, 6.123233995736766e-17, r);
    const double r2 = r * r;
    double sp = 1.0 / 6227020800.0; sp = sp * r2 - 1.0 / 39916800.0; sp = sp * r2 + 1.0 / 362880.0; sp = sp * r2 - 1.0 / 5040.0; sp = sp * r2 + 1.0 / 120.0; sp = sp * r2 - 1.0 / 6.0; sp = sp * r2 + 1.0; sp = sp * r;
    double cp = -1.0 / 87178291200.0; cp = cp * r2 + 1.0 / 479001600.0; cp = cp * r2 - 1.0 / 3628800.0; cp = cp * r2 + 1.0 / 40320.0; cp = cp * r2 - 1.0 / 720.0; cp = cp * r2 + 1.0 / 24.0; cp = cp * r2 - 0.5; cp = cp * r2 + 1.0;
    const int q = (int)n & 3;
    const double s = (q == 0) ? sp : (q == 1) ? cp : (q == 2) ? -sp : -cp;
    const double c = (q == 0) ? cp : (q == 1) ? -sp : (q == 2) ? -cp : sp;
    sn = (float)s; cs = (float)c;
}

typedef short v4i16_t __attribute__((ext_vector_type(4)));
__device__ __forceinline__ s16x4 vtr(const LAS unsigned char* p) { return __builtin_bit_cast(s16x4, __builtin_amdgcn_ds_read_tr16_b64_v4i16((LAS v4i16_t*)p)); }
__device__ __forceinline__ unsigned cvtpk(float lo, float hi) { unsigned r; asm volatile("s_nop 0\n\tv_cvt_pk_bf16_f32 %0, %1, %2\n\ts_nop 1" : "=v"(r) : "v"(lo), "v"(hi)); return r; }
constexpr float ATT_C2 = 0.08838834764831845f * 1.4426950408889634f;
constexpr float ATT_SCALE = 0.08838834764831845f;

template <int NR>
__device__ __forceinline__ void att_issue(v4u (&st)[NR / 32], const bf16* src, size_t gstride, int tid) {
#pragma unroll
    for (int it = 0; it < NR / 32; ++it) st[it] = *(const GAS v4u*)(src + (size_t)((tid >> 4) + 32 * it) * gstride + (tid & 15) * 8);
}
template <int NR>
__device__ __forceinline__ void att_write(const v4u (&st)[NR / 32], LAS unsigned char* img, int lrow0, int tid) {
#pragma unroll
    for (int it = 0; it < NR / 32; ++it) *(LAS v4u*)(img + (lrow0 + (tid >> 4) + 32 * it) * ATT_KSTR + (tid & 15) * 16) = st[it];
}
__device__ __forceinline__ void att_q(bf16x8 (&qf)[4], const bf16* qrow, int lane) {
#pragma unroll
    for (int s = 0; s < 4; ++s) qf[s] = *(const GAS bf16x8*)(qrow + 32 * s + 8 * (lane >> 4));
}
template <int NT, bool BAND>
__device__ __forceinline__ void att_core(const LAS unsigned char* Kimg, const LAS unsigned char* Vimg, int krow0, int kmin, int rot  ,
                                         const bf16x8 (&qf)[4]  , bf16* orow  , float* lse_out  , int lane) {
    const int fr = lane & 15, fq = lane >> 4;
    f32x4 sc[NT];
    const LAS unsigned char* kb = Kimg + fr * ATT_KSTR + 16 * fq;
#pragma unroll
    for (int T = 0; T < NT; ++T) { sc[T] = (f32x4){0.f, 0.f, 0.f, 0.f}; const int trow = (krow0 + rot + 16 * T) & 255;
#pragma unroll
        for (int s = 0; s < 4; ++s) { const bf16x8 kf = *(const LAS bf16x8*)(kb + trow * ATT_KSTR + 64 * s);
            sc[T] = __builtin_amdgcn_mfma_f32_16x16x32_bf16(kf, qf[s], sc[T], 0, 0, 0); } }
    const float NEG = -__builtin_inff();
    if (BAND) {
#pragma unroll
        for (int r = 0; r < 4; ++r) { if (4 * fq + r < fr) sc[0][r] = NEG; if (4 * fq + r > fr) sc[NT - 1][r] = NEG; }
        if (kmin > 0) {
#pragma unroll
            for (int T = 0; T < NT; ++T)
#pragma unroll
                for (int r = 0; r < 4; ++r) if (krow0 + 16 * T + 4 * fq + r < kmin) sc[T][r] = NEG;
        }
    }
    float mx = sc[0][0];
#pragma unroll
    for (int T = 0; T < NT; ++T)
#pragma unroll
        for (int r = 0; r < 4; ++r) mx = fmaxf(mx, sc[T][r]);
    mx = fmaxf(mx, __shfl_xor(mx, 16)); mx = fmaxf(mx, __shfl_xor(mx, 32));
    const float mL = mx * ATT_C2; float l = 0.f;
#pragma unroll
    for (int T = 0; T < NT; ++T)
#pragma unroll
        for (int r = 0; r < 4; ++r) { const float p = __builtin_amdgcn_exp2f(sc[T][r] * ATT_C2 - mL); sc[T][r] = p; l += p; }
    l += __shfl_xor(l, 16); l += __shfl_xor(l, 32);
    constexpr int NKS = (NT + 1) / 2;
    f32x4 oa[8];
#pragma unroll
    for (int c = 0; c < 8; ++c) oa[c] = (f32x4){0.f, 0.f, 0.f, 0.f};
    const LAS unsigned char* vb = Vimg + (4 * fq + (fr >> 2)) * ATT_KSTR + 8 * (fr & 3);
#pragma unroll
    for (int ks = 0; ks < NKS; ++ks) { const int vr0 = (krow0 + rot + 32 * ks) & 255, vr1 = (krow0 + rot + 32 * ks + 16) & 255;
        v4u pw; pw.x = cvtpk(sc[2 * ks][0], sc[2 * ks][1]); pw.y = cvtpk(sc[2 * ks][2], sc[2 * ks][3]);
        if (2 * ks + 1 < NT) { pw.z = cvtpk(sc[2 * ks + 1 < NT ? 2 * ks + 1 : 0][0], sc[2 * ks + 1 < NT ? 2 * ks + 1 : 0][1]); pw.w = cvtpk(sc[2 * ks + 1 < NT ? 2 * ks + 1 : 0][2], sc[2 * ks + 1 < NT ? 2 * ks + 1 : 0][3]); }
        else { pw.z = 0u; pw.w = 0u; }
        const bf16x8 pf = __builtin_bit_cast(bf16x8, pw);
#pragma unroll
        for (int c = 0; c < 8; ++c) { const s16x4 lo = vtr(vb + vr0 * ATT_KSTR + 32 * c), hi = vtr(vb + vr1 * ATT_KSTR + 32 * c);
            const bf16x8 vf = __builtin_shufflevector(lo, hi, 0, 1, 2, 3, 4, 5, 6, 7);
            oa[c] = __builtin_amdgcn_mfma_f32_16x16x32_bf16(vf, pf, oa[c], 0, 0, 0); }
    }
    const float rl = 1.0f / l;
#pragma unroll
    for (int c = 0; c < 8; ++c) { v2u o; o.x = cvtpk(oa[c][0] * rl, oa[c][1] * rl); o.y = cvtpk(oa[c][2] * rl, oa[c][3] * rl); *(GAS v2u*)(orow + 16 * c + 4 * fq) = o; }
    if (lse_out && fq == 0) *lse_out = mx * ATT_SCALE + __logf(l);
}
struct SaUnit { int g, d, qb, h; size_t tok0, col; };
__device__ __forceinline__ SaUnit sa_unit(int i, int per, int G, int bx) {
    int c, h;
    if (per > 0) { c = (bx >> 3) * per + i; h = bx & 7; } else { const int idx = bx + i * G; c = idx >> 3; h = idx & 7; }
    SaUnit u; u.g = c >> 7; const int cc = c & 127, sh = 2 * u.g, nblk = 32 >> sh; u.d = 1 << sh;
    u.qb = cc % nblk; const int t1 = cc / nblk, r = t1 % u.d, b = t1 / u.d; u.h = h;
    u.tok0 = (size_t)b * SEQ + r; u.col = (size_t)u.g * 1024 + h * 128; return u;
}
__device__ __forceinline__ void sa_issue(v4u (&stK)[8], v4u (&stV)[8], const bf16* K, const bf16* V, const SaUnit& u, bool shared, int tid) {
    const size_t gs = (size_t)u.d * QKVW; const int pb = 128 * (u.qb - 1) + (tid >> 4); const int fix = u.qb == 0 ? 128 : 0;
    const size_t base = u.tok0 * QKVW + u.col + (tid & 15) * 8;
    if (!shared) {
#pragma unroll
        for (int it = 0; it < 4; ++it) { const size_t off = base + (size_t)(pb + 32 * it + fix) * gs; stK[it] = *(const GAS v4u*)(K + off); stV[it] = *(const GAS v4u*)(V + off); } }
#pragma unroll
    for (int it = 4; it < 8; ++it) { const size_t off = base + (size_t)(pb + 32 * it) * gs; stK[it] = *(const GAS v4u*)(K + off); stV[it] = *(const GAS v4u*)(V + off); }
}
__device__ __forceinline__ void sa_write(const v4u (&stK)[8], const v4u (&stV)[8], LAS unsigned char* Kimg, LAS unsigned char* Vimg, bool shared, int rot, int tid) {
    if (!shared) {
#pragma unroll
        for (int it = 0; it < 4; ++it) { const int o = ((((tid >> 4) + 32 * it) + rot) & 255) * ATT_KSTR + (tid & 15) * 16; *(LAS v4u*)(Kimg + o) = stK[it]; *(LAS v4u*)(Vimg + o) = stV[it]; } }
#pragma unroll
    for (int it = 4; it < 8; ++it) { const int o = ((((tid >> 4) + 32 * it) + rot) & 255) * ATT_KSTR + (tid & 15) * 16; *(LAS v4u*)(Kimg + o) = stK[it]; *(LAS v4u*)(Vimg + o) = stV[it]; }
}
__device__ __forceinline__ void self_attn_stream(Frame& F, const bf16* Q, const bf16* K, const bf16* V, bf16* OG, float* LSE) {
    LAS unsigned char* Kimg = F.lds + ATT_K_OFF; LAS unsigned char* Vimg = F.lds + ATT_V_OFF;
    const int bx = (int)blockIdx.x, G = F.G, per = (G % 8 == 0 && 3072 % G == 0) ? 3072 / G : 0, n = per ? per : (3072 - bx + G - 1) / G;
    if (n <= 0) return;
    v4u stK[8], stV[8]; SaUnit u = sa_unit(0, per, G, bx); bool shared = false; int rot = 0;
    size_t tok = u.tok0 + (size_t)(128 * u.qb + 16 * F.wave + (F.lane & 15)) * u.d;
    bf16x8 qn[4]; att_q(qn, Q + tok * QKVW + u.col, F.lane);
    sa_issue(stK, stV, K, V, u, false, F.tid);
    for (int i = 0; i < n; ++i) {
        sa_write(stK, stV, Kimg, Vimg, shared, rot, F.tid);
        __syncthreads();
        bf16x8 qf[4];
#pragma unroll
        for (int s = 0; s < 4; ++s) qf[s] = qn[s];
        const int kmin = u.qb == 0 ? 128 : 0, crot = rot; bf16* orow = OG + ((size_t)u.g * M + tok) * AW + u.h * 128; float* lse = LSE + ((size_t)u.g * M + tok) * 8 + u.h;
        const bool more = i + 1 < n;
        if (more) { const SaUnit nu = sa_unit(i + 1, per, G, bx);
            shared = (nu.g == u.g) && (nu.tok0 == u.tok0) && (nu.h == u.h) && (nu.qb == u.qb + 1);
            rot = shared ? (rot ^ 128) : 0; u = nu;
            tok = u.tok0 + (size_t)(128 * u.qb + 16 * F.wave + (F.lane & 15)) * u.d;
            sa_issue(stK, stV, K, V, u, shared, F.tid); att_q(qn, Q + tok * QKVW + u.col, F.lane); }
        att_core<9, true>(Kimg, Vimg, 16 * F.wave, kmin, crot, qf, orow, lse, F.lane);
        __syncthreads();
    }
}
__device__ __forceinline__ void cross_attn_stream(Frame& F, const bf16* QX, const bf16* KVX, bf16* OX) {
    LAS unsigned char* Kimg = F.lds + ATT_K_OFF; LAS unsigned char* Vimg = F.lds + ATT_V_OFF;
    const int per = (512 % F.G == 0) ? 512 / F.G : 0;
    const int n = per ? per : (512 - (int)blockIdx.x + F.G - 1) / F.G; int loaded = -1;
    for (int i = 0; i < n; ++i) { const int idx = per ? (int)blockIdx.x * per + i : (int)blockIdx.x + i * F.G; if (idx >= 512) break;
        const int qblk = idx & 31, bh = idx >> 5, h = bh & 3, b = bh >> 2;
        if (bh != loaded) { if (loaded >= 0) __syncthreads();
            const size_t off = (size_t)b * NMEM * 1024 + h * 128;
            v4u stK[8], stV[8]; att_issue<256>(stK, KVX + off, 1024, F.tid); att_issue<256>(stV, KVX + off + 512, 1024, F.tid);
            att_write<256>(stK, Kimg, 0, F.tid); att_write<256>(stV, Vimg, 0, F.tid);
            __syncthreads(); loaded = bh; }
        const size_t tok = (size_t)b * SEQ + 128 * qblk + 16 * F.wave + (F.lane & 15);
        bf16x8 qf[4]; att_q(qf, QX + tok * XAW + h * 128, F.lane);
        att_core<16, false>(Kimg, Vimg, 0, 0, 0, qf, OX + tok * XAW + h * 128, nullptr, F.lane);
    }
    __syncthreads();
}
__device__ __forceinline__ void sgu_unit(Frame& F, int idx, const bf16* U, bf16* YB, const bf16* VB, const float* lnstat, const float* lng, const float* lnb, const bf16* WSP, const float* bsp) {
    const int g = idx & 15, cn = idx >> 4, C0 = g * 128; const size_t tok0 = (size_t)cn * 128;
    LAS unsigned char* img = F.lds; LAS f32x2* stat = (LAS f32x2*)(F.lds + 40960);
    if (F.tid < 128) { const float* sp = lnstat + (tok0 + F.tid) * 64; float s = 0.f, q = 0.f;
#pragma unroll
        for (int k = 0; k < 16; ++k) { const f32x4 v = *(const GAS f32x4*)(sp + 4 * k); s += v.x + v.z; q += v.y + v.w; }
        const float mu = s * (1.f / 2048.f), var = q * (1.f / 2048.f) - mu * mu; stat[F.tid] = (f32x2){mu, 1.0f / sqrtf(var + EPS)}; }
    __syncthreads();
    { const int ch = F.tid & 15; const float* gp = lng + C0 + 8 * ch; const float* bp = lnb + C0 + 8 * ch;
      const f32x4 g0 = *(const GAS f32x4*)gp, g1 = *(const GAS f32x4*)(gp + 4), b0 = *(const GAS f32x4*)bp, b1 = *(const GAS f32x4*)(bp + 4);
      v4u raw[4];
#pragma unroll
      for (int it = 0; it < 4; ++it) raw[it] = *(const GAS v4u*)(VB + (tok0 + (F.tid >> 4) + 32 * it) * SGW + C0 + 8 * ch);
#pragma unroll
      for (int it = 0; it < 4; ++it) { const int j = (F.tid >> 4) + 32 * it; const f32x2 st = stat[j]; const v4u w = raw[it]; v4u o;
          o.x = cvtpk((bflo(w.x) - st.x) * st.y * g0.x + b0.x, (bfhi(w.x) - st.x) * st.y * g0.y + b0.y); o.y = cvtpk((bflo(w.y) - st.x) * st.y * g0.z + b0.z, (bfhi(w.y) - st.x) * st.y * g0.w + b0.w);
          o.z = cvtpk((bflo(w.z) - st.x) * st.y * g1.x + b1.x, (bfhi(w.z) - st.x) * st.y * g1.y + b1.y); o.w = cvtpk((bflo(w.w) - st.x) * st.y * g1.z + b1.z, (bfhi(w.w) - st.x) * st.y * g1.w + b1.w);
          *(LAS v4u*)(img + j * ATT_KSTR + ch * 16) = o; } }
    __syncthreads();
    const int fr = F.lane & 15, fq = F.lane >> 4, w = F.wave, nsteps = (w >> 1) + 1;
    f32x4 acc[8];
#pragma unroll
    for (int c = 0; c < 8; ++c) acc[c] = (f32x4){0.f, 0.f, 0.f, 0.f};
    const bf16* wrow = WSP + ((size_t)g * 128 + 16 * w + fr) * 128 + 8 * fq;
    const LAS unsigned char* vb = img + (8 * fq + (fr >> 2)) * ATT_KSTR + 8 * (fr & 3);
    for (int s = 0; s < nsteps; ++s) { const bf16x8 wf = *(const GAS bf16x8*)(wrow + 32 * s);
#pragma unroll
        for (int c = 0; c < 8; ++c) { const s16x4 lo = vtr(vb + (32 * s) * ATT_KSTR + 32 * c), hi = vtr(vb + (32 * s + 4) * ATT_KSTR + 32 * c);
            const bf16x8 vf = __builtin_shufflevector(lo, hi, 0, 1, 2, 3, 4, 5, 6, 7);
            acc[c] = __builtin_amdgcn_mfma_f32_16x16x32_bf16(vf, wf, acc[c], 0, 0, 0); } }
    const float bias = bsp[g * 128 + 16 * w + fr];
    const bf16* urow = U + (tok0 + 16 * w + fr) * SGW + C0 + 4 * fq; bf16* yrow = YB + (tok0 + 16 * w + fr) * (AW + SGW) + AW + C0 + 4 * fq;
#pragma unroll
    for (int c = 0; c < 8; ++c) { const v2u uw = *(const GAS v2u*)(urow + 16 * c); v2u o;
        o.x = cvtpk(bflo(uw.x) * (acc[c][0] + bias), bfhi(uw.x) * (acc[c][1] + bias)); o.y = cvtpk(bflo(uw.y) * (acc[c][2] + bias), bfhi(uw.y) * (acc[c][3] + bias));
        *(GAS v2u*)(yrow + 16 * c) = o; }
    __syncthreads();
}

__device__ __forceinline__ void sgu_stream(Frame& F, int per, const bf16* U, bf16* YB, const bf16* VB, const float* lnstat, const float* lng, const float* lnb, const bf16* WSP, const float* bsp) {
    const int idx0 = (int)blockIdx.x * per, cn = idx0 >> 4, g0 = idx0 & 15; const size_t tok0 = (size_t)cn * 128;
    LAS unsigned char* img = F.lds; LAS f32x2* stat = (LAS f32x2*)(F.lds + 40960);
    if (F.tid < 128) { const float* sp = lnstat + (tok0 + F.tid) * 64; float s = 0.f, q = 0.f;
#pragma unroll
        for (int k = 0; k < 16; ++k) { const f32x4 v = *(const GAS f32x4*)(sp + 4 * k); s += v.x + v.z; q += v.y + v.w; }
        const float mu = s * (1.f / 2048.f), var = q * (1.f / 2048.f) - mu * mu; stat[F.tid] = (f32x2){mu, 1.0f / sqrtf(var + EPS)}; }
    const int ch = F.tid & 15, fr = F.lane & 15, fq = F.lane >> 4, w = F.wave, nsteps = (w >> 1) + 1;
    v4u raw[4];
#pragma unroll
    for (int it = 0; it < 4; ++it) raw[it] = *(const GAS v4u*)(VB + (tok0 + (F.tid >> 4) + 32 * it) * SGW + g0 * 128 + 8 * ch);
    __syncthreads();
    const LAS unsigned char* vb = img + (8 * fq + (fr >> 2)) * ATT_KSTR + 8 * (fr & 3);
    for (int i = 0; i < per; ++i) { const int g = g0 + i, C0 = g * 128;
        { const float* gp = lng + C0 + 8 * ch; const float* bp = lnb + C0 + 8 * ch;
          const f32x4 ga = *(const GAS f32x4*)gp, gb = *(const GAS f32x4*)(gp + 4), ba = *(const GAS f32x4*)bp, bb = *(const GAS f32x4*)(bp + 4);
#pragma unroll
          for (int it = 0; it < 4; ++it) { const int j = (F.tid >> 4) + 32 * it; const f32x2 st = stat[j]; const v4u wv = raw[it]; v4u o;
              o.x = cvtpk((bflo(wv.x) - st.x) * st.y * ga.x + ba.x, (bfhi(wv.x) - st.x) * st.y * ga.y + ba.y); o.y = cvtpk((bflo(wv.y) - st.x) * st.y * ga.z + ba.z, (bfhi(wv.y) - st.x) * st.y * ga.w + ba.w);
              o.z = cvtpk((bflo(wv.z) - st.x) * st.y * gb.x + bb.x, (bfhi(wv.z) - st.x) * st.y * gb.y + bb.y); o.w = cvtpk((bflo(wv.w) - st.x) * st.y * gb.z + bb.z, (bfhi(wv.w) - st.x) * st.y * gb.w + bb.w);
              *(LAS v4u*)(img + j * ATT_KSTR + ch * 16) = o; } }
        __syncthreads();
        const bf16* wrow = WSP + ((size_t)g * 128 + 16 * w + fr) * 128 + 8 * fq;
        bf16x8 wf[4];
#pragma unroll
        for (int s = 0; s < 4; ++s) wf[s] = *(const GAS bf16x8*)(wrow + 32 * (s < nsteps ? s : 0));
        const bf16* urow = U + (tok0 + 16 * w + fr) * SGW + C0 + 4 * fq; bf16* yrow = YB + (tok0 + 16 * w + fr) * (AW + SGW) + AW + C0 + 4 * fq;
        v2u uw[8];
#pragma unroll
        for (int c = 0; c < 8; ++c) uw[c] = *(const GAS v2u*)(urow + 16 * c);
        const float bias = bsp[g * 128 + 16 * w + fr];
        if (i + 1 < per) {
#pragma unroll
            for (int it = 0; it < 4; ++it) raw[it] = *(const GAS v4u*)(VB + (tok0 + (F.tid >> 4) + 32 * it) * SGW + C0 + 128 + 8 * ch); }
        f32x4 acc[8];
#pragma unroll
        for (int c = 0; c < 8; ++c) acc[c] = (f32x4){0.f, 0.f, 0.f, 0.f};
#pragma unroll
        for (int s = 0; s < 4; ++s) { if (s < nsteps) {
#pragma unroll
            for (int c = 0; c < 8; ++c) { const s16x4 lo = vtr(vb + (32 * s) * ATT_KSTR + 32 * c), hi = vtr(vb + (32 * s + 4) * ATT_KSTR + 32 * c);
                const bf16x8 vf = __builtin_shufflevector(lo, hi, 0, 1, 2, 3, 4, 5, 6, 7);
                acc[c] = __builtin_amdgcn_mfma_f32_16x16x32_bf16(vf, wf[s], acc[c], 0, 0, 0); } } }
#pragma unroll
        for (int c = 0; c < 8; ++c) { v2u o;
            o.x = cvtpk(bflo(uw[c].x) * (acc[c][0] + bias), bfhi(uw[c].x) * (acc[c][1] + bias)); o.y = cvtpk(bflo(uw[c].y) * (acc[c][2] + bias), bfhi(uw[c].y) * (acc[c][3] + bias));
            *(GAS v2u*)(yrow + 16 * c) = o; }
        __syncthreads();
    }
}

struct ConvJob { const float* W; bf16* WT; int K, N, row_off, ldk, koff, item; };
__device__ __forceinline__ void conv_load(f32x4 (&v)[16], const ConvJob& j, int lane) {
    const int nblk = j.N >> 6, kb = j.item / nblk, nb = j.item - kb * nblk;
    const float* src = j.W + (size_t)(64 * kb + (lane >> 4)) * j.N + 64 * nb + 4 * (lane & 15); const size_t st = (size_t)4 * j.N;
#pragma unroll
    for (int i = 0; i < 16; ++i) v[i] = *(const GAS f32x4*)(src + i * st);
}
__device__ __forceinline__ unsigned cvt2(float lo, float hi) { typedef float f2_t __attribute__((ext_vector_type(2))); typedef __bf16 b2_t __attribute__((ext_vector_type(2))); const f2_t v = {lo, hi}; return __builtin_bit_cast(unsigned, __builtin_convertvector(v, b2_t)); }
__device__ __forceinline__ void conv_to_lds(const f32x4 (&v)[16], LAS unsigned char* scr, int lane) {
#pragma unroll
    for (int i = 0; i < 16; ++i) { v2u o; o.x = cvt2(v[i].x, v[i].y); o.y = cvt2(v[i].z, v[i].w); *(LAS v2u*)(scr + ((lane >> 4) + 4 * i) * 144 + 8 * (lane & 15)) = o; }
}
__device__ __forceinline__ void conv_store(const ConvJob& j, const LAS unsigned char* scr, int lane) {
    const int nblk = j.N >> 6, kb = j.item / nblk, nb = j.item - kb * nblk, i16 = lane & 15, fq = lane >> 4;
    const LAS unsigned char* rb = scr + (8 * fq + (i16 >> 2)) * 144 + 8 * (i16 & 3);
    bf16* dst = j.WT + (size_t)(j.row_off + 64 * nb + i16) * j.ldk + j.koff + 64 * kb + 8 * fq;
#pragma unroll
    for (int jj = 0; jj < 8; ++jj) { const int nb16 = jj & 3, kh = jj >> 2;
        const s16x4 lo = vtr(rb + (32 * kh) * 144 + 32 * nb16), hi = vtr(rb + (32 * kh + 4) * 144 + 32 * nb16);
        const bf16x8 o = __builtin_shufflevector(lo, hi, 0, 1, 2, 3, 4, 5, 6, 7);
        *(GAS bf16x8*)(dst + (size_t)(16 * nb16) * j.ldk + 32 * kh) = o; }
}
#define CONV_STREAM(LO_, HI_, CTR_, DECODE_) do { \
        LAS unsigned char* scr_ = F.lds + RING_OFF + F.wave * 16384; volatile LAS unsigned* tkL_ = (volatile LAS unsigned*)(F.lds + MISC_OFF + 64); \
        f32x4 cv_[16]; ConvJob cur_, nxt_; unsigned tv_ = 0u; int rnd_ = 0; \
        if (F.tid == 0) { tkL_[0] = __hip_atomic_fetch_add((CTR_), 1u, __ATOMIC_RELAXED, __HIP_MEMORY_SCOPE_AGENT); tkL_[1] = __hip_atomic_fetch_add((CTR_), 1u, __ATOMIC_RELAXED, __HIP_MEMORY_SCOPE_AGENT); } \
        __syncthreads(); \
        int tc_ = (int)tkL_[0], tn_ = (int)tkL_[1]; \
        __syncthreads(); \
        int it_ = (LO_) + 8 * tc_ + F.wave; bool have_ = it_ < (HI_); \
        if (have_) { DECODE_(it_, cur_); conv_load(cv_, cur_, F.lane); } \
        while ((LO_) + 8 * tc_ < (HI_)) { \
            if (F.tid == 0) tv_ = __hip_atomic_fetch_add((CTR_), 1u, __ATOMIC_RELAXED, __HIP_MEMORY_SCOPE_AGENT); \
            if (have_) conv_to_lds(cv_, scr_, F.lane); \
            const int itn_ = (LO_) + 8 * tn_ + F.wave; const bool more_ = itn_ < (HI_); \
            if (more_) { DECODE_(itn_, nxt_); conv_load(cv_, nxt_, F.lane); } \
            if (have_) { asm volatile("s_waitcnt lgkmcnt(0)" ::: "memory"); conv_store(cur_, scr_, F.lane); asm volatile("s_waitcnt lgkmcnt(0)" ::: "memory"); } \
            if (F.tid == 0) tkL_[rnd_ & 1] = tv_; \
            __syncthreads(); \
            tc_ = tn_; tn_ = (int)tkL_[rnd_ & 1]; cur_ = nxt_; have_ = more_; ++rnd_; } \
        __syncthreads(); \
    } while (0)

struct Args { const float* in[26]; float* out; unsigned char* ws; int ph_lo, ph_hi, li, pad; };
constexpr float ROPE_INV[16] = {1.0f, 0.44036659598350525f, 0.1939227432012558f, 0.08539710193872452f, 0.03760603070259094f, 0.01656043902039528f, 0.007292664609849453f, 0.0032114458736032248f,
    0.0014142135623842478f, 0.000622772378847003f, 0.00027424818836152554f, 0.00012076973507646471f, 5.318296098266728e-05f, 2.34199997066753e-05f, 1.0313386155758053e-05f, 4.541670477919979e-06f};

__global__ void __launch_bounds__(NWAVES * 64, 2) skel_fwd(Args args) {
    extern __shared__ __attribute__((aligned(16))) unsigned char lds[];
    Frame F;
    F.lds = (LAS unsigned char*)lds;
    F.MISC = (volatile LAS unsigned*)(F.lds + MISC_OFF);
    F.tid = threadIdx.x; F.lane = F.tid & 63; F.wave = __builtin_amdgcn_readfirstlane(F.tid >> 6);
    F.G = gridDim.x; { const int bx = blockIdx.x; F.vcu = (F.G % 8 == 0) ? (bx % 8) * (F.G / 8) + bx / 8 : bx; }
    unsigned char* ws = args.ws; F.ws = ws;
    F.ctl = (gu32*)(ws + WS_CTL);
    const float* x = args.in[0]; const float* mem = args.in[1]; const int* positions = (const int*)args.in[2]; const float* mix_pre_g = args.in[3]; const float* w_in = args.in[4];
    const float* sgu_ln_g = args.in[5]; const float* sgu_ln_b = args.in[6]; const float* w_spatial = args.in[7]; const float* b_spatial = args.in[8];
    const float* w_branch_a = args.in[9]; const float* w_branch_b = args.in[10]; const float* w_gate = args.in[11]; const float* b_gate = args.in[12]; const float* w_out = args.in[13];
    const float* mix_post_g = args.in[14]; const float* xa_pre_g = args.in[15]; const float* mem_norm_g = args.in[16];
    const float* w_xq = args.in[17]; const float* w_xk = args.in[18]; const float* w_xv = args.in[19]; const float* w_xo = args.in[20];
    const float* xa_post_g = args.in[21]; const float* mlp_pre_g = args.in[22]; const float* w_up = args.in[23]; const float* w_down = args.in[24]; const float* mlp_post_g = args.in[25];
    float* out = args.out;
    float* ROPE = (float*)(ws + WS_ROPE); float* LNST = (float*)(ws + WS_LNST); float* SSQ = (float*)(ws + WS_SSQ); float* LSE = (float*)(ws + WS_LSE);
    bf16* WSP = (bf16*)(ws + WS_WSP); bf16* WING = (bf16*)(ws + WS_WING); bf16* WAB = (bf16*)(ws + WS_WA); bf16* WOUT = (bf16*)(ws + WS_WOUT);
    bf16* WXQ = (bf16*)(ws + WS_WXQ); bf16* WKV = (bf16*)(ws + WS_WKV); bf16* WXO = (bf16*)(ws + WS_WXO); bf16* WUP = (bf16*)(ws + WS_WUP); bf16* WDN = (bf16*)(ws + WS_WDN);
    bf16* H = (bf16*)(ws + WS_H); bf16* Qb = (bf16*)(ws + WS_Q); bf16* Kb = (bf16*)(ws + WS_K); bf16* Vb = (bf16*)(ws + WS_V); bf16* Ub = (bf16*)(ws + WS_U); bf16* VBb = (bf16*)(ws + WS_VB);
    bf16* Gb = (bf16*)(ws + WS_G); bf16* MRG = (bf16*)(ws + WS_MRG); bf16* OG = (bf16*)(ws + WS_OG); bf16* KVX = (bf16*)(ws + WS_KVX); bf16* MB = (bf16*)(ws + WS_MB);
    bf16* T = (bf16*)(ws + WS_T); bf16* QX = (bf16*)(ws + WS_QX); bf16* OX = (bf16*)(ws + WS_OX); bf16* Ab = (bf16*)(ws + WS_A); bf16* T3 = (bf16*)(ws + WS_T3); bf16* XB = (bf16*)(ws + WS_XB); bf16* YAB = (bf16*)(ws + WS_YAB); constexpr int YABW = AW + SGW;

    for (int u = F.tid; u < (LDS_BYTES - MISC_OFF) / 4; u += NWAVES * 64) ((LAS unsigned*)(F.lds + MISC_OFF))[u] = 0u;
    __syncthreads();
#if MK_PER_PHASE
#define GRID_BAR() do { } while (0)
#else
    XcdBarrier bar = xcd_barrier_post((unsigned*)(F.ctl + CW_BAR) + args.li * XCD_BAR_WORDS, F.MISC + 8);
#define GRID_BAR() xcd_barrier(bar)
#endif
    const int lo = args.ph_lo, hi = args.ph_hi;
#define IN(k) (lo <= (k) && (k) < hi)
#define BOTH(k) (IN(k) && IN((k) + 1))
    const int gw = F.vcu * NWAVES + F.wave, NGW = F.G * NWAVES, bx = (int)blockIdx.x;
    const int gtid = bx * (NWAVES * 64) + F.tid, NGT = F.G * NWAVES * 64;
    constexpr int I_UP = 64 * (DFF / 64), I_DN = (DFF / 64) * (DM / 64), P7_BUSY = 144, CONV_PER_WAVE = 18;
    const int conv_early = (F.G > P7_BUSY) ? (((F.G - P7_BUSY) * NWAVES * CONV_PER_WAVE < I_UP + I_DN) ? (F.G - P7_BUSY) * NWAVES * CONV_PER_WAVE : I_UP + I_DN) : 0;

    if (IN(0)) {
        constexpr int I_IN = 64 * (INW / 64), I_G = 64 * (GW / 64), I_A = 16 * 64, I_B = 32 * 64, I_O = 64 * 64, I_XQ = 64 * 8, I_XO = 8 * 64;
        constexpr int NITEMS = I_IN + I_G + I_A + I_B + I_O + 3 * I_XQ + I_XO;
#define P0_DECODE(r_, J) do { int r = (r_); \
            if (r < I_IN) { J = ConvJob{w_in, WING, DM, INW, 0, DM, 0, r}; break; } r -= I_IN; \
            if (r < I_G) { J = ConvJob{w_gate, WING, DM, GW, INW, DM, 0, r}; break; } r -= I_G; \
            if (r < I_A) { J = ConvJob{w_branch_a, WAB, AW, DM, 0, AW + SGW, 0, r}; break; } r -= I_A; \
            if (r < I_B) { J = ConvJob{w_branch_b, WAB, SGW, DM, 0, AW + SGW, AW, r}; break; } r -= I_B; \
            if (r < I_O) { J = ConvJob{w_out, WOUT, DM, DM, 0, DM, 0, r}; break; } r -= I_O; \
            if (r < I_XQ) { J = ConvJob{w_xq, WXQ, DM, XAW, 0, DM, 0, r}; break; } r -= I_XQ; \
            if (r < I_XQ) { J = ConvJob{w_xk, WKV, DM, XAW, 0, DM, 0, r}; break; } r -= I_XQ; \
            if (r < I_XQ) { J = ConvJob{w_xv, WKV, DM, XAW, XAW, DM, 0, r}; break; } r -= I_XQ; \
            J = ConvJob{w_xo, WXO, XAW, DM, 0, XAW, 0, r}; } while (0)
        for (int m = gw; m < M; m += NGW) rms_row_to_bf16(x + (size_t)m * DM, mix_pre_g, H + (size_t)m * DM, F.lane);
        for (int m = gw; m < MROWS; m += NGW) rms_row_to_bf16(mem + (size_t)m * DM, mem_norm_g, MB + (size_t)m * DM, F.lane);
        __syncthreads();
        CONV_STREAM(0, NITEMS, F.ctl + CW_TICKET, P0_DECODE);
#undef P0_DECODE
        for (int i = gtid; i < M * 16; i += NGT) { const int tok = i >> 4, k = i & 15; const float ang = (float)positions[tok] * ROPE_INV[k]; float sn, cs; sincos_d(ang, sn, cs);
            ROPE[(size_t)tok * 32 + k] = cs; ROPE[(size_t)tok * 32 + 16 + k] = sn; }
        for (int i = gtid; i < 16 * 128 * 128; i += NGT) { const int jj = i & 127, ii = (i >> 7) & 127; WSP[i] = (bf16)(jj <= ii ? f2bf(w_spatial[i]) : 0u); }
        if (BOTH(0)) GRID_BAR();
    }
    if (IN(1)) {
        pg8::Gemm g{H, WING, M, NPROJ, DM}; pg8::StaticOrder S; S.init(M, NPROJ, F.G, bx);
        pg8::EpiProj E{Qb, Kb, Vb, Ub, VBb, Gb, ROPE, b_gate, LNST};
        pg8::gemm_phase<pg8::EpiProj, pg8::StaticOrder, PG8_ALIGN, PG8_SP2>(F.lds + RING_OFF, g, S, E);
        if (BOTH(1)) GRID_BAR();
    }
    if (IN(2)) {
        for (int i = F.tid; i < 16 * ATT_KSTR / 4; i += NWAVES * 64) ((LAS unsigned*)(F.lds + ATT_V_OFF + 256 * ATT_KSTR))[i] = 0u;
        __syncthreads();
        self_attn_stream(F, Qb, Kb, Vb, OG, LSE);
        { const int per = (2048 % F.G == 0) ? 2048 / F.G : 0;
          if (per == 1 || per == 2 || per == 4 || per == 8 || per == 16) sgu_stream(F, per, Ub, YAB, VBb, LNST, sgu_ln_g, sgu_ln_b, WSP, b_spatial);
          else for (int idx = bx; idx < 2048; idx += F.G) sgu_unit(F, idx, Ub, YAB, VBb, LNST, sgu_ln_g, sgu_ln_b, WSP, b_spatial); }
        if (BOTH(2)) GRID_BAR();
    }
    if (IN(3)) {
        for (int i = gtid; i < M * 8 * 16; i += NGT) { const int ch = i & 15, hh = (i >> 4) & 7; const size_t tok = (size_t)(i >> 7);
            const float l0 = LSE[tok * 8 + hh], l1 = LSE[((size_t)M + tok) * 8 + hh], l2 = LSE[((size_t)2 * M + tok) * 8 + hh];
            const float mx = fmaxf(l0, fmaxf(l1, l2)); float e0 = __expf(l0 - mx), e1 = __expf(l1 - mx), e2 = __expf(l2 - mx); const float inv = 1.0f / (e0 + e1 + e2); e0 *= inv; e1 *= inv; e2 *= inv;
            const size_t o = tok * AW + hh * 128 + ch * 8;
            const v4u a = *(const GAS v4u*)(OG + o), b = *(const GAS v4u*)(OG + (size_t)M * AW + o), c = *(const GAS v4u*)(OG + (size_t)2 * M * AW + o); v4u y;
            y.x = pk2(e0 * bflo(a.x) + e1 * bflo(b.x) + e2 * bflo(c.x), e0 * bfhi(a.x) + e1 * bfhi(b.x) + e2 * bfhi(c.x));
            y.y = pk2(e0 * bflo(a.y) + e1 * bflo(b.y) + e2 * bflo(c.y), e0 * bfhi(a.y) + e1 * bfhi(b.y) + e2 * bfhi(c.y));
            y.z = pk2(e0 * bflo(a.z) + e1 * bflo(b.z) + e2 * bflo(c.z), e0 * bfhi(a.z) + e1 * bfhi(b.z) + e2 * bfhi(c.z));
            y.w = pk2(e0 * bflo(a.w) + e1 * bflo(b.w) + e2 * bflo(c.w), e0 * bfhi(a.w) + e1 * bfhi(b.w) + e2 * bfhi(c.w));
            *(GAS v4u*)(YAB + tok * YABW + hh * 128 + ch * 8) = y; }
        if (BOTH(3)) GRID_BAR();
    }
    if (IN(4)) {
        pg8::Gemm g{YAB, WAB, M, DM, YABW}; pg8::StaticOrder S; S.init(M, DM, F.G, bx); pg8::EpiMerge E{Gb, MRG, AW / pg8::BK};
        pg8::gemm_phase<pg8::EpiMerge, pg8::StaticOrder, PG8_ALIGN, PG8_SP2>(F.lds + RING_OFF, g, S, E);
        if (BOTH(4)) GRID_BAR();
    }
    if (IN(5)) {
        pg8::Gemm g{MRG, WOUT, M, DM, DM}; pg8::StaticOrder S; S.init(M, DM, F.G, bx); pg8::EpiNorm E{T, DM, SSQ};
        pg8::gemm_phase<pg8::EpiNorm, pg8::StaticOrder, PG8_ALIGN, PG8_SP2>(F.lds + RING_OFF, g, S, E);
        if (BOTH(5)) GRID_BAR();
    }
    if (IN(6)) {
        for (int m = gw; m < M; m += NGW) row_norm_res<false, true>(x + (size_t)m * DM, T + (size_t)m * DM, SSQ + (size_t)m * 64, mix_post_g, xa_pre_g, XB + (size_t)m * DM, H + (size_t)m * DM, F.lane);
#define P6_DECODE(r_, J) do { const int r = (r_); if (r < I_UP) J = ConvJob{w_up, WUP, DM, DFF, 0, DM, 0, r}; else J = ConvJob{w_down, WDN, DFF, DM, 0, DFF, 0, r - I_UP}; } while (0)
        __syncthreads();
        CONV_STREAM(conv_early, I_UP + I_DN, F.ctl + CW_TICKET + 64, P6_DECODE);
        if (BOTH(6)) GRID_BAR();
    }
    if (IN(7)) {
        if (bx < 128) { pg8::Gemm g{H, WXQ, M, XAW, DM}; pg8::SmallOrder S; S.init(M, XAW, 0, bx); pg8::EpiPlain E{QX, XAW};
            pg8::gemm_phase<pg8::EpiPlain, pg8::SmallOrder, false, PG8_SP2>(F.lds + RING_OFF, g, S, E); }
        else if (bx < P7_BUSY) { pg8::Gemm g{MB, WKV, MROWS, 2 * XAW, DM}; pg8::SmallOrder S; S.init(MROWS, 2 * XAW, 128, bx); pg8::EpiPlain E{KVX, 2 * XAW};
            pg8::gemm_phase<pg8::EpiPlain, pg8::SmallOrder, false, PG8_SP2>(F.lds + RING_OFF, g, S, E); }
        else { CONV_STREAM(0, conv_early, F.ctl + CW_TICKET + 128, P6_DECODE); }
#undef P6_DECODE
        if (BOTH(7)) GRID_BAR();
    }
    if (IN(8)) {
        cross_attn_stream(F, QX, KVX, OX);
        if (BOTH(8)) GRID_BAR();
    }
    if (IN(9)) {
        pg8::Gemm g{OX, WXO, M, DM, XAW}; pg8::StaticOrder S; S.init(M, DM, F.G, bx); pg8::EpiNorm E{T, DM, SSQ};
        pg8::gemm_phase<pg8::EpiNorm, pg8::StaticOrder, PG8_ALIGN, PG8_SP2>(F.lds + RING_OFF, g, S, E);
        if (BOTH(9)) GRID_BAR();
    }
    if (IN(10)) {
        for (int m = gw; m < M; m += NGW) row_norm_res<true, true>(XB + (size_t)m * DM, T + (size_t)m * DM, SSQ + (size_t)m * 64, xa_post_g, mlp_pre_g, XB + (size_t)m * DM, H + (size_t)m * DM, F.lane);
        if (BOTH(10)) GRID_BAR();
    }
    if (IN(11)) {
        pg8::Gemm g{H, WUP, M, DFF, DM}; pg8::StaticOrder S; S.init(M, DFF, F.G, bx); pg8::EpiRelu2 E{Ab, DFF};
        pg8::gemm_phase<pg8::EpiRelu2, pg8::StaticOrder, PG8_ALIGN, PG8_SP2>(F.lds + RING_OFF, g, S, E);
        if (BOTH(11)) GRID_BAR();
    }
    if (IN(12)) {
        pg8::Gemm g{Ab, WDN, M, DM, DFF}; pg8::StaticOrder S; S.init(M, DM, F.G, bx); pg8::EpiNorm E{T3, DM, SSQ};
        pg8::gemm_phase<pg8::EpiNorm, pg8::StaticOrder, PG8_ALIGN, PG8_SP2>(F.lds + RING_OFF, g, S, E);
        if (BOTH(12)) GRID_BAR();
    }
    if (IN(13)) {
        for (int m = gw; m < M; m += NGW) row_norm_res<true, false>(XB + (size_t)m * DM, T3 + (size_t)m * DM, SSQ + (size_t)m * 64, mlp_post_g, nullptr, out + (size_t)m * DM, nullptr, F.lane);
    }
#undef IN
#undef BOTH
}

extern "C" void kernel_launch(void* const* d_in, const int* in_sizes, int n_in, void* d_out, int out_size, void* d_ws, size_t ws_size, hipStream_t stream) {
    static int grid = 0;
    if (grid == 0) {
        if (n_in != 26 || in_sizes[0] != M * DM || out_size != M * DM || ws_size < WS_END) { fprintf(stderr, "kernel_launch: unexpected shapes (n_in %d, in0 %d, out %d, ws %zu < %zu?); nothing launched\n", n_in, n_in > 0 ? in_sizes[0] : -1, out_size, ws_size, (size_t)WS_END); grid = -1; return; }
        int dev = 0, cus = 0, per_cu = 0;
        if (hipGetDevice(&dev) != hipSuccess || hipDeviceGetAttribute(&cus, hipDeviceAttributeMultiprocessorCount, dev) != hipSuccess) { grid = -1; return; }
        if (hipFuncSetAttribute((const void*)skel_fwd, hipFuncAttributeMaxDynamicSharedMemorySize, LDS_BYTES) != hipSuccess) { fprintf(stderr, "kernel_launch: hipFuncSetAttribute failed\n"); grid = -1; return; }
        if (hipOccupancyMaxActiveBlocksPerMultiprocessor(&per_cu, (const void*)skel_fwd, NWAVES * 64, LDS_BYTES) != hipSuccess || per_cu < 1)
            fprintf(stderr, "kernel_launch: note: occupancy query reports %d workgroups per CU\n", per_cu);
        (void)hipGetLastError();
        grid = cus;
    }
    if (grid < 0) return;
    if (hipMemsetAsync((char*)d_ws + WS_CTL, 0, CTL_ZERO_BYTES, stream) != hipSuccess) return;
    Args a{};
    for (int i = 0; i < 26; ++i) a.in[i] = (const float*)d_in[i];
    a.out = (float*)d_out; a.ws = (unsigned char*)d_ws;
#if MK_PER_PHASE
    for (int li = 0; li < N_PHASES; ++li) { a.ph_lo = li; a.ph_hi = li + 1; a.li = li;
        hipLaunchKernelGGL(skel_fwd, dim3(grid), dim3(NWAVES * 64), LDS_BYTES, stream, a); }
#else
#if defined(PROBE_DUP)
    a.ph_lo = 0; a.ph_hi = PROBE_DUP + 1; a.li = 0;
    hipLaunchKernelGGL(skel_fwd, dim3(grid), dim3(NWAVES * 64), LDS_BYTES, stream, a);
    a.ph_lo = PROBE_DUP; a.ph_hi = N_PHASES; a.li = 1;
    hipLaunchKernelGGL(skel_fwd, dim3(grid), dim3(NWAVES * 64), LDS_BYTES, stream, a);
#else
    a.ph_lo = 0; a.ph_hi = N_PHASES; a.li = 0;
    hipLaunchKernelGGL(skel_fwd, dim3(grid), dim3(NWAVES * 64), LDS_BYTES, stream, a);
#endif
#endif
    const hipError_t le = hipPeekAtLastError();
    if (le != hipSuccess) fprintf(stderr, "kernel_launch: launch failed: %s\n", hipGetErrorName(le));
}
```

```cpp
#include <hip/hip_runtime.h>
#include <cstdio>
#include <cstdint>
namespace pg8 {
#define PG8_LAS __attribute__((address_space(3)))
typedef unsigned short bf16_t;
typedef short bf16x8 __attribute__((ext_vector_type(8)));
typedef float f32x4 __attribute__((ext_vector_type(4)));
typedef unsigned u32x4 __attribute__((ext_vector_type(4)));
constexpr int BM = 256, BK = 64, HALF = 128, HTB = HALF * BK * 2  , STAGE_BYTES = 8 * HTB, NXCD = 8, WGM = 8;

__host__ __device__ __forceinline__ int lds_byte(int r, int c) { const int st = (r >> 4) * 2 + (c >> 5), rr = r & 15, cc = c & 31, ob = rr * 64 + cc * 2; return st * 1024 + (ob ^ (((ob >> 9) & 1) << 5)); }
__host__ __device__ __forceinline__ void stage_rc(int b, int& R, int& C) { const int st = b / 1024, sb = b % 1024, swz = sb ^ (((sb >> 9) & 1) << 5); R = (st >> 1) * 16 + swz / 64; C = (st & 1) * 32 + (swz % 64) / 2; }
__host__ __device__ __forceinline__ int perm32(int rho) { const int n = rho >> 4, i = rho & 15; return 8 * (i >> 2) + 4 * n + (i & 3); }

struct Unit { int pm, pn; };
struct Gemm { const bf16_t* A; const bf16_t* Bt; int M, N, K; };

struct StaticOrder {
    int nM, nN, nwg, G, c;
    __host__ __device__ void init(int M, int N, int G_, int c_) { nM = M / BM; nN = N / BM; nwg = nM * nN; G = G_; c = c_; }
    __host__ __device__ bool next(int i, Unit& u) const {
        const long L = (long)i * G + c; if (L >= nwg) return false;
        int wgid = (int)L; { const int q = nwg / NXCD, r = nwg % NXCD, xcd = wgid % NXCD, off = wgid / NXCD; wgid = (xcd < r ? xcd * (q + 1) : r * (q + 1) + (xcd - r) * q) + off; }
        const int nig = WGM * nN, gid = wgid / nig, fm = gid * WGM, gsz = (nM - fm) < WGM ? (nM - fm) : WGM;
        u.pm = fm + ((wgid % nig) % gsz); u.pn = (wgid % nig) / gsz; return true;
    }
    __device__ __forceinline__ void a_ready(const Unit&) const {}
    __device__ __forceinline__ void done(const Unit&) const {}
};

__device__ __forceinline__ unsigned cvt_pk_bf16(float lo, float hi) { unsigned r; asm volatile("s_nop 0\n\tv_cvt_pk_bf16_f32 %0, %1, %2" : "=v"(r) : "v"(lo), "v"(hi)); return r; }
typedef float f32x2 __attribute__((ext_vector_type(2)));
__device__ __forceinline__ u32x4 pack8(const f32x4 a, const f32x4 b) { u32x4 w; w.x = cvt_pk_bf16(a[0], a[1]); w.y = cvt_pk_bf16(a[2], a[3]); w.z = cvt_pk_bf16(b[0], b[1]); w.w = cvt_pk_bf16(b[2], b[3]); return w; }
__device__ __forceinline__ float bf_lo(unsigned w) { return __uint_as_float(w << 16); }
__device__ __forceinline__ float bf_hi(unsigned w) { return __uint_as_float(w & 0xffff0000u); }
__device__ __forceinline__ void unpack8(const u32x4 w, f32x4& a, f32x4& b) { a = (f32x4){bf_lo(w.x), bf_hi(w.x), bf_lo(w.y), bf_hi(w.y)}; b = (f32x4){bf_lo(w.z), bf_hi(w.z), bf_lo(w.w), bf_hi(w.w)}; }
__device__ __forceinline__ float gelu_tanh(float x) { const float u = x * (0.7978845608028654f + 0.035677408136300125f * x * x);
    const float e = __builtin_amdgcn_exp2f(-2.885390081777927f * u); return x * __builtin_amdgcn_rcpf(1.0f + e); }
__device__ __forceinline__ float sigmoid_f(float z) { return __builtin_amdgcn_rcpf(1.0f + __builtin_amdgcn_exp2f(-1.4426950408889634f * z)); }
__device__ __forceinline__ f32x4 gelu4(f32x4 v) { return (f32x4){gelu_tanh(v[0]), gelu_tanh(v[1]), gelu_tanh(v[2]), gelu_tanh(v[3])}; }
__device__ __forceinline__ f32x4 sigm4(f32x4 v) { return (f32x4){sigmoid_f(v[0]), sigmoid_f(v[1]), sigmoid_f(v[2]), sigmoid_f(v[3])}; }
__device__ __forceinline__ float hsum4(f32x4 v) { return (v[0] + v[1]) + (v[2] + v[3]); }

struct EpiPlain {
    static constexpr bool PERM = true, AFTER_DRAIN = false, HAS_MID = false;
    bf16_t* O; int ldc;
    __device__ __forceinline__ void operator()(const f32x4 (&acc)[2][2][4][2], const Unit& u, int wr, int wc, int fr, int fq) const {
        const int row0 = u.pm * BM + wr * 64 + fr, col0 = u.pn * BM + wc * 32 + 8 * fq;
#pragma unroll
        for (int ai = 0; ai < 2; ++ai)
#pragma unroll
            for (int m = 0; m < 4; ++m) { bf16_t* rowp = O + (size_t)(row0 + ai * HALF + m * 16) * ldc + col0;
#pragma unroll
                for (int bj = 0; bj < 2; ++bj) *(u32x4*)(rowp + bj * HALF) = pack8(acc[ai][bj][m][0], acc[ai][bj][m][1]); }
    }
};
struct EpiRelu2 {
    static constexpr bool PERM = true, AFTER_DRAIN = false, HAS_MID = false;
    bf16_t* O; int ldc;
    __device__ __forceinline__ void operator()(const f32x4 (&acc)[2][2][4][2], const Unit& u, int wr, int wc, int fr, int fq) const {
        const int row0 = u.pm * BM + wr * 64 + fr, col0 = u.pn * BM + wc * 32 + 8 * fq;
#pragma unroll
        for (int ai = 0; ai < 2; ++ai)
#pragma unroll
            for (int m = 0; m < 4; ++m) { bf16_t* rowp = O + (size_t)(row0 + ai * HALF + m * 16) * ldc + col0;
#pragma unroll
                for (int bj = 0; bj < 2; ++bj) { f32x4 v0 = acc[ai][bj][m][0], v1 = acc[ai][bj][m][1];
                    v0 = __builtin_elementwise_max(v0, (f32x4){0.f, 0.f, 0.f, 0.f}); v1 = __builtin_elementwise_max(v1, (f32x4){0.f, 0.f, 0.f, 0.f});
                    *(u32x4*)(rowp + bj * HALF) = pack8(v0 * v0, v1 * v1); } }
    }
};
struct EpiNorm {
    static constexpr bool PERM = true, AFTER_DRAIN = false, HAS_MID = false;
    bf16_t* O; int ldc; float* ssq;
    __device__ __forceinline__ void operator()(const f32x4 (&acc)[2][2][4][2], const Unit& u, int wr, int wc, int fr, int fq) const {
        const int row0 = u.pm * BM + wr * 64 + fr, col0 = u.pn * BM + wc * 32 + 8 * fq;
#pragma unroll
        for (int ai = 0; ai < 2; ++ai)
#pragma unroll
            for (int m = 0; m < 4; ++m) { const int row = row0 + ai * HALF + m * 16; bf16_t* rowp = O + (size_t)row * ldc + col0; float q = 0.f;
#pragma unroll
                for (int bj = 0; bj < 2; ++bj) { const f32x4 v0 = acc[ai][bj][m][0], v1 = acc[ai][bj][m][1]; q += hsum4(v0 * v0) + hsum4(v1 * v1);
                    *(u32x4*)(rowp + bj * HALF) = pack8(v0, v1); }
                q += __shfl_xor(q, 16); q += __shfl_xor(q, 32);
                if (fq == 0) ssq[(size_t)row * 64 + u.pn * 4 + wc] = q; }
    }
};
struct EpiMerge {
    static constexpr bool PERM = true, AFTER_DRAIN = false, HAS_MID = true;
    const bf16_t* G; bf16_t* MG; int tmid;
    __device__ __forceinline__ void mid(f32x4 (&acc)[2][2][4][2], const Unit& u, int wr, int wc, int fr, int fq) const {
        const int row0 = u.pm * BM + wr * 64 + fr, col0 = u.pn * BM + wc * 32 + 8 * fq;
        size_t off0 = (size_t)row0 * 8192 + col0; asm volatile("" : "+v"(off0));
#pragma unroll
        for (int ai = 0; ai < 2; ++ai)
#pragma unroll
            for (int m = 0; m < 4; ++m) { const bf16_t* gp = G + off0 + (size_t)(ai * HALF + m * 16) * 8192;
#pragma unroll
                for (int bj = 0; bj < 2; ++bj) { f32x4 a0, a1, b0, b1; unpack8(*(const u32x4*)(gp + bj * HALF), a0, a1); unpack8(*(const u32x4*)(gp + 4096 + bj * HALF), b0, b1);
#pragma unroll
                    for (int e = 0; e < 4; ++e) { a0[e] *= __builtin_amdgcn_rcpf(fmaxf(b0[e], 1e-20f)); a1[e] *= __builtin_amdgcn_rcpf(fmaxf(b1[e], 1e-20f)); }
                    acc[ai][bj][m][0] *= a0; acc[ai][bj][m][1] *= a1; }
                asm volatile("" ::: "memory"); }
    }
    __device__ __forceinline__ void operator()(const f32x4 (&acc)[2][2][4][2], const Unit& u, int wr, int wc, int fr, int fq) const {
        const int row0 = u.pm * BM + wr * 64 + fr, col0 = u.pn * BM + wc * 32 + 8 * fq;
#pragma unroll
        for (int ai = 0; ai < 2; ++ai)
#pragma unroll
            for (int m = 0; m < 4; ++m) { const size_t row = (size_t)(row0 + ai * HALF + m * 16);
#pragma unroll
                for (int bj = 0; bj < 2; ++bj) { f32x4 b0, b1; unpack8(*(const u32x4*)(G + row * 8192 + 4096 + col0 + bj * HALF), b0, b1);
                    b0 = __builtin_elementwise_max(b0, (f32x4){1e-20f, 1e-20f, 1e-20f, 1e-20f}); b1 = __builtin_elementwise_max(b1, (f32x4){1e-20f, 1e-20f, 1e-20f, 1e-20f});
                    *(u32x4*)(MG + row * 4096 + col0 + bj * HALF) = pack8(acc[ai][bj][m][0] * b0, acc[ai][bj][m][1] * b1); } }
    }
};
struct EpiProj {
    static constexpr bool PERM = true, AFTER_DRAIN = false, HAS_MID = false;
    bf16_t *Q, *K, *V, *U, *VB, *G; const float* rope; const float* bgate; float* lnstat;
    __device__ __forceinline__ void operator()(const f32x4 (&acc)[2][2][4][2], const Unit& u, int wr, int wc, int fr, int fq) const {
        const int pn = u.pn, row0 = u.pm * BM + wr * 64 + fr, lc0 = wc * 32 + 8 * fq;
        if (pn < 24) {
            bf16_t* base = pn < 12 ? Q : K; const int colt = (pn < 12 ? pn : pn - 12) * BM + lc0; const float sgn = (fq & 2) ? 1.f : -1.f;
#pragma unroll
            for (int ai = 0; ai < 2; ++ai)
#pragma unroll
                for (int m = 0; m < 4; ++m) { const size_t row = (size_t)(row0 + ai * HALF + m * 16); bf16_t* rowp = base + row * 3072 + colt;
                    f32x4 c0 = {0.f, 0.f, 0.f, 0.f}, c1 = c0, s0 = c0, s1 = c0;
                    if (wc == 0) { const float* rp = rope + row * 32 + 8 * (fq & 1); c0 = *(const f32x4*)rp; c1 = *(const f32x4*)(rp + 4); s0 = *(const f32x4*)(rp + 16); s1 = *(const f32x4*)(rp + 20); }
#pragma unroll
                    for (int bj = 0; bj < 2; ++bj) { f32x4 v0 = acc[ai][bj][m][0], v1 = acc[ai][bj][m][1];
                        if (wc == 0) { f32x4 p0, p1;
#pragma unroll
                            for (int e = 0; e < 4; ++e) { p0[e] = __shfl_xor(v0[e], 32); p1[e] = __shfl_xor(v1[e], 32); }
                            v0 = v0 * c0 + (p0 * s0) * sgn; v1 = v1 * c1 + (p1 * s1) * sgn; }
                        *(u32x4*)(rowp + bj * HALF) = pack8(v0, v1); } }
        } else if (pn < 36) {
            const int colt = (pn - 24) * BM + lc0;
#pragma unroll
            for (int ai = 0; ai < 2; ++ai)
#pragma unroll
                for (int m = 0; m < 4; ++m) { bf16_t* rowp = V + (size_t)(row0 + ai * HALF + m * 16) * 3072 + colt;
#pragma unroll
                    for (int bj = 0; bj < 2; ++bj) *(u32x4*)(rowp + bj * HALF) = pack8(acc[ai][bj][m][0], acc[ai][bj][m][1]); }
        } else if (pn < 44) {
            const int colt = (pn - 36) * BM + lc0;
#pragma unroll
            for (int ai = 0; ai < 2; ++ai)
#pragma unroll
                for (int m = 0; m < 4; ++m) { bf16_t* rowp = U + (size_t)(row0 + ai * HALF + m * 16) * 2048 + colt;
#pragma unroll
                    for (int bj = 0; bj < 2; ++bj) *(u32x4*)(rowp + bj * HALF) = pack8(gelu4(acc[ai][bj][m][0]), gelu4(acc[ai][bj][m][1])); }
        } else if (pn < 52) {
            const int colt = (pn - 44) * BM + lc0;
#pragma unroll
            for (int ai = 0; ai < 2; ++ai)
#pragma unroll
                for (int m = 0; m < 4; ++m) { const size_t row = (size_t)(row0 + ai * HALF + m * 16); bf16_t* rowp = VB + row * 2048 + colt; float s = 0.f, q = 0.f;
#pragma unroll
                    for (int bj = 0; bj < 2; ++bj) { const f32x4 v0 = gelu4(acc[ai][bj][m][0]), v1 = gelu4(acc[ai][bj][m][1]);
                        s += hsum4(v0) + hsum4(v1); q += hsum4(v0 * v0) + hsum4(v1 * v1); *(u32x4*)(rowp + bj * HALF) = pack8(v0, v1); }
                    s += __shfl_xor(s, 16); s += __shfl_xor(s, 32); q += __shfl_xor(q, 16); q += __shfl_xor(q, 32);
                    if (fq == 0) *(f32x2*)(lnstat + (row * 32 + (pn - 44) * 4 + wc) * 2) = (f32x2){s, q}; }
        } else {
            const int colt = (pn - 52) * BM + lc0;
            f32x4 bv[2][2];
#pragma unroll
            for (int bj = 0; bj < 2; ++bj) { bv[bj][0] = *(const f32x4*)(bgate + colt + bj * HALF); bv[bj][1] = *(const f32x4*)(bgate + colt + bj * HALF + 4); }
#pragma unroll
            for (int ai = 0; ai < 2; ++ai)
#pragma unroll
                for (int m = 0; m < 4; ++m) { bf16_t* rowp = G + (size_t)(row0 + ai * HALF + m * 16) * 8192 + colt;
#pragma unroll
                    for (int bj = 0; bj < 2; ++bj) *(u32x4*)(rowp + bj * HALF) = pack8(sigm4(acc[ai][bj][m][0] + bv[bj][0]), sigm4(acc[ai][bj][m][1] + bv[bj][1])); }
        }
    }
};
struct SmallOrder {
    int nN, nwg, c;
    __device__ void init(int M, int N, int first, int bx) { nN = N / BM; nwg = (M / BM) * nN; c = bx - first; }
    __device__ bool next(int i, Unit& u) const { if (i != 0 || c < 0 || c >= nwg) return false; u.pm = c / nN; u.pn = c % nN; return true; }
    __device__ __forceinline__ void a_ready(const Unit&) const {}
    __device__ __forceinline__ void done(const Unit&) const {}
};
template <class Epi, class Sched, bool ALIGN_EPI = false, bool SP2 = false>
__device__ __forceinline__ void gemm_phase(PG8_LAS unsigned char* lds, const Gemm g, const Sched& S, const Epi& E) {
    const int tid = threadIdx.x, wid = __builtin_amdgcn_readfirstlane(tid >> 6), lane = tid & 63, wr = wid >> 2, wc = wid & 3, fr = lane & 15, fq = lane >> 4;
    const int K = g.K, nt = K / BK;
    unsigned voffA[2], voffB[2];
#pragma unroll
    for (int i = 0; i < 2; ++i) { int R, C; stage_rc(tid * 16 + i * 8192, R, C); const int Rb = Epi::PERM ? ((R & ~31) + perm32(R & 31)) : R;
        voffA[i] = (unsigned)(R * K + C) * 2u; voffB[i] = (unsigned)(Rb * K + C) * 2u; }
    const size_t kstep = (size_t)(BK * 2);
    const size_t hstep = (size_t)HALF * K * 2;
    const size_t tstep = 2 * hstep;
    const unsigned ldsw = (unsigned)wid * 1024u;
    const int aoff = lds_byte(wr * 64 + fr, fq * 8), boff = lds_byte(wc * 32 + fr, fq * 8);
#define PG8_SA(b, h) (((b) * 2 + (h)) * HTB)
#define PG8_SB(b, h) ((4 + (b) * 2 + (h)) * HTB)
#define PG8_STAGE(bufoff, gbase, voff) do { _Pragma("unroll") for (int _i = 0; _i < 2; ++_i) \
        __builtin_amdgcn_global_load_lds((const unsigned*)((const char*)(gbase) + (voff)[_i]), (PG8_LAS unsigned*)(lds + (bufoff) + ldsw + _i * 8192), 16, 0, 0); } while (0)
#define PG8_LDA(dst, b, h) do { _Pragma("unroll") for (int m = 0; m < 4; ++m) _Pragma("unroll") for (int k = 0; k < 2; ++k) dst[m][k] = *(const PG8_LAS bf16x8*)(lds + PG8_SA(b, h) + aoff + m * 2048 + k * 1024); } while (0)
#define PG8_LDB(dst, b, h) do { _Pragma("unroll") for (int n = 0; n < 2; ++n) _Pragma("unroll") for (int k = 0; k < 2; ++k) dst[n][k] = *(const PG8_LAS bf16x8*)(lds + PG8_SB(b, h) + boff + n * 2048 + k * 1024); } while (0)
#define PG8_MMA(ai, bj, At, Bt) do { __builtin_amdgcn_s_setprio(1); _Pragma("unroll") for (int m = 0; m < 4; ++m) _Pragma("unroll") for (int n = 0; n < 2; ++n) _Pragma("unroll") for (int k = 0; k < 2; ++k) \
        acc[ai][bj][m][n] = __builtin_amdgcn_mfma_f32_16x16x32_bf16(Bt[n][k], At[m][k], acc[ai][bj][m][n], 0, 0, 0); __builtin_amdgcn_s_setprio(0); } while (0)
#define PG8_WAIT_V(n) asm volatile("s_waitcnt vmcnt(" #n ")" ::: "memory")
#define PG8_WAIT_L(n) asm volatile("s_waitcnt lgkmcnt(" #n ")" ::: "memory")
#define PG8_BAR __builtin_amdgcn_s_barrier()
#define PG8_SCHED __builtin_amdgcn_sched_barrier(0)
    Unit cur, nxt; int ui = 0;
    if (!S.next(0, cur)) return;
    f32x4 acc[2][2][4][2];
#pragma unroll
    for (int a = 0; a < 2; ++a)
#pragma unroll
        for (int b = 0; b < 2; ++b)
#pragma unroll
            for (int m = 0; m < 4; ++m)
#pragma unroll
                for (int n = 0; n < 2; ++n) acc[a][b][m][n] = (f32x4){0.f, 0.f, 0.f, 0.f};
    bf16x8 At[4][2], B0[2][2], B1[2][2];
    const char* cA = (const char*)g.A + (size_t)cur.pm * tstep; const char* cB = (const char*)g.Bt + (size_t)cur.pn * tstep;
    S.a_ready(cur);
    if constexpr (SP2) {
        PG8_STAGE(PG8_SB(0, 0), cB, voffB); PG8_STAGE(PG8_SB(0, 1), cB + hstep, voffB); PG8_STAGE(PG8_SA(0, 0), cA, voffA); PG8_STAGE(PG8_SA(0, 1), cA + hstep, voffA);
        if (wr == 1) PG8_BAR;
        PG8_WAIT_V(2); PG8_BAR;
        PG8_STAGE(PG8_SB(1, 0), cB + kstep, voffB); PG8_STAGE(PG8_SA(1, 0), cA + kstep, voffA); PG8_STAGE(PG8_SB(1, 1), cB + hstep + kstep, voffB);
        PG8_WAIT_V(6); PG8_BAR;
    } else {
        PG8_STAGE(PG8_SB(0, 0), cB, voffB); PG8_STAGE(PG8_SA(0, 0), cA, voffA); PG8_STAGE(PG8_SB(0, 1), cB + hstep, voffB); PG8_STAGE(PG8_SA(0, 1), cA + hstep, voffA);
        if (wr == 1) PG8_BAR;
        PG8_WAIT_V(4); PG8_BAR;
        PG8_STAGE(PG8_SB(1, 0), cB + kstep, voffB); PG8_STAGE(PG8_SA(1, 0), cA + kstep, voffA); PG8_STAGE(PG8_SB(1, 1), cB + hstep + kstep, voffB);
        PG8_WAIT_V(6); PG8_BAR;
    }
    for (;;) {
        const bool has_next = S.next(ui + 1, nxt);
        const char* nA = has_next ? (const char*)g.A + (size_t)nxt.pm * tstep : cA; const char* nB = has_next ? (const char*)g.Bt + (size_t)nxt.pn * tstep : cB;
#define PG8_KITER(t) do { \
            const bool last = ((t) == nt - 2); \
            const char* a1 = cA + (size_t)((t) + 1) * kstep; \
            const char* a2 = last ? nA : cA + (size_t)((t) + 2) * kstep; const char* b2 = last ? nB : cB + (size_t)((t) + 2) * kstep; \
            const char* a3 = a2 + kstep; const char* b3 = b2 + kstep; \
            if (last && has_next) S.a_ready(nxt); \
            PG8_LDB(B0, 0, 0); PG8_LDB(B1, 0, 1); PG8_SCHED; PG8_LDA(At, 0, 0); PG8_STAGE(PG8_SA(1, 1), a1 + hstep, voffA); \
            PG8_WAIT_V(8); PG8_WAIT_L(0); PG8_BAR; PG8_MMA(0, 0, At, B0); PG8_MMA(0, 1, At, B1); PG8_BAR; PG8_SCHED; \
            PG8_LDA(At, 0, 1); PG8_STAGE(PG8_SB(0, 0), b2, voffB); PG8_STAGE(PG8_SB(0, 1), b2 + hstep, voffB); PG8_STAGE(PG8_SA(0, 0), a2, voffA); \
            PG8_WAIT_V(8); PG8_WAIT_L(0); PG8_BAR; PG8_MMA(1, 0, At, B0); PG8_MMA(1, 1, At, B1); PG8_BAR; PG8_SCHED; \
            PG8_LDB(B0, 1, 0); PG8_LDB(B1, 1, 1); PG8_SCHED; PG8_LDA(At, 1, 0); PG8_STAGE(PG8_SA(0, 1), a2 + hstep, voffA); \
            PG8_WAIT_V(8); PG8_WAIT_L(0); PG8_BAR; PG8_MMA(0, 0, At, B0); PG8_MMA(0, 1, At, B1); PG8_BAR; PG8_SCHED; \
            PG8_LDA(At, 1, 1); PG8_STAGE(PG8_SB(1, 0), b3, voffB); PG8_STAGE(PG8_SB(1, 1), b3 + hstep, voffB); PG8_STAGE(PG8_SA(1, 0), a3, voffA); \
            PG8_WAIT_V(8); PG8_WAIT_L(0); PG8_BAR; PG8_MMA(1, 0, At, B0); PG8_MMA(1, 1, At, B1); PG8_BAR; PG8_SCHED; \
        } while (0)
        static_assert(SP2, "this copy of the body keeps only the two-super-phase K-loop");
        if constexpr (Epi::HAS_MID) {
            const int tm = E.tmid;
            for (int t = 0; t < tm; t += 2) PG8_KITER(t);
            E.mid(acc, cur, wr, wc, fr, fq);
            for (int t = tm; t < nt; t += 2) PG8_KITER(t);
        } else {
            for (int t = 0; t < nt; t += 2) PG8_KITER(t);
        }
#undef PG8_KITER
        if constexpr (ALIGN_EPI) { if (wr == 0) PG8_BAR; }
        if constexpr (!Epi::AFTER_DRAIN) { E(acc, cur, wr, wc, fr, fq); S.done(cur); }
        if (!has_next) break;
#pragma unroll
        for (int a = 0; a < 2; ++a)
#pragma unroll
            for (int b = 0; b < 2; ++b)
#pragma unroll
                for (int m = 0; m < 4; ++m)
#pragma unroll
                    for (int n = 0; n < 2; ++n) acc[a][b][m][n] = (f32x4){0.f, 0.f, 0.f, 0.f};
        cur = nxt; cA = nA; cB = nB; ++ui;
        if constexpr (ALIGN_EPI) { if (wr == 1) PG8_BAR; }
    }
    PG8_WAIT_V(0);
    if constexpr (!ALIGN_EPI) { if (wr == 0) PG8_BAR; }
    PG8_BAR;
    if constexpr (Epi::AFTER_DRAIN) { E.fused(acc, cur, wr, wc, fr, fq, lds, wid, lane); S.done(cur); }
#undef PG8_SA
#undef PG8_SB
#undef PG8_STAGE
#undef PG8_LDA
#undef PG8_LDB
#undef PG8_MMA
#undef PG8_WAIT_V
#undef PG8_WAIT_L
#undef PG8_BAR
#undef PG8_SCHED
}
}
#ifndef PG8_SP2
#define PG8_SP2 true
#endif
#ifndef PG8_ALIGN
#define PG8_ALIGN true
#endif
constexpr int NWAVES = 8;
#ifndef MK_PER_PHASE
#define MK_PER_PHASE 0
#endif
constexpr int N_PHASES = 14;

constexpr int BATCH = 4, SEQ = 4096, DM = 4096, M = BATCH * SEQ;
constexpr int AW = 1024, QKVW = 3072, SGW = 2048, INW = 13312, GW = 8192, NPROJ = INW + GW;
constexpr int XAW = 512, NMEM = 256, MROWS = BATCH * NMEM, DFF = 16384;
constexpr float EPS = 1e-6f;

constexpr size_t MiB = 1u << 20;
constexpr size_t WS_CTL = 0, CTL_ZERO_BYTES = 1 * MiB;
constexpr size_t WS_ROPE = 1 * MiB;
constexpr size_t WS_LNST = 3 * MiB;
constexpr size_t WS_SSQ = 7 * MiB;
constexpr size_t WS_LSE = 11 * MiB;
constexpr size_t WS_WSP = 13 * MiB;
constexpr size_t WS_WING = 16 * MiB;
constexpr size_t WS_WA = 184 * MiB;
constexpr size_t WS_WOUT = 208 * MiB;
constexpr size_t WS_WXQ = 240 * MiB;
constexpr size_t WS_WKV = 244 * MiB;
constexpr size_t WS_WXO = 252 * MiB;
constexpr size_t WS_H = 256 * MiB;
constexpr size_t WS_Q = 384 * MiB, WS_K = 480 * MiB, WS_V = 576 * MiB;
constexpr size_t WS_U = 672 * MiB, WS_VB = 736 * MiB;
constexpr size_t WS_G = 800 * MiB;
constexpr size_t WS_MRG = 1056 * MiB;
constexpr size_t WS_OG = 1056 * MiB;
constexpr size_t WS_KVX = 1216 * MiB;
constexpr size_t WS_MB = 1218 * MiB;
constexpr size_t WS_T = 384 * MiB;
constexpr size_t WS_QX = 512 * MiB, WS_OX = 528 * MiB;
constexpr size_t WS_A = 384 * MiB;
constexpr size_t WS_WUP = 896 * MiB;
constexpr size_t WS_WDN = 1024 * MiB;
constexpr size_t WS_YAB = 16 * MiB;
constexpr size_t WS_T3 = 256 * MiB;
constexpr size_t WS_XB = 16 * MiB;
constexpr size_t WS_END = 1226 * MiB;
constexpr int CW_TMO = 0, CW_CODE = 1, CW_BAR = 4096, CW_TICKET = 16384;

constexpr int RING_OFF = 0, RING_BYTES = 131072;
constexpr int ATT_KSTR = 272;
constexpr int ATT_K_OFF = 0, ATT_V_OFF = 256 * ATT_KSTR, ATT_END = ATT_V_OFF + 272 * ATT_KSTR;
constexpr int MISC_OFF = 144384, LDS_BYTES = 147456;
static_assert(ATT_END <= MISC_OFF && MISC_OFF + 128 <= LDS_BYTES, "LDS map");

#define GAS __attribute__((address_space(1)))
#define LAS __attribute__((address_space(3)))
typedef unsigned short bf16;
typedef unsigned v4u __attribute__((ext_vector_type(4)));
typedef unsigned v2u __attribute__((ext_vector_type(2)));
typedef float f32x4 __attribute__((ext_vector_type(4)));
typedef float f32x2 __attribute__((ext_vector_type(2)));
typedef short bf16x8 __attribute__((ext_vector_type(8)));
typedef short s16x4 __attribute__((ext_vector_type(4)));
typedef GAS unsigned gu32;
#define RLX_AGENT __ATOMIC_RELAXED, __HIP_MEMORY_SCOPE_AGENT
#define LDS_WAIT() asm volatile("s_waitcnt lgkmcnt(0)" ::: "memory")
#define VM_WAIT() asm volatile("s_waitcnt vmcnt(0)" ::: "memory")
__device__ __forceinline__ unsigned f2bf(float f) { unsigned u = __builtin_bit_cast(unsigned, f); return (u + 0x7fffu + ((u >> 16) & 1u)) >> 16; }
__device__ __forceinline__ unsigned pk2(float lo, float hi) { return f2bf(lo) | (f2bf(hi) << 16); }
__device__ __forceinline__ float bflo(unsigned w) { return __uint_as_float(w << 16); }
__device__ __forceinline__ float bfhi(unsigned w) { return __uint_as_float(w & 0xffff0000u); }

#define XB_TMO      128
#define XB_XCNT(j)  (256  + 64 * (j))
#define XB_XSUB(j)  (1280 + 64 * (j))
#define XB_XGEN(j)  (2304 + 64 * (j))
#define XB_TOP      3328
#define XB_TOPGEN   3392
#define XCD_BAR_WORDS 3456
#define XB_SPIN_CAP (1u << 18)

__device__ __forceinline__ unsigned xb_ld(unsigned* p)              { return __hip_atomic_load(p, __ATOMIC_RELAXED, __HIP_MEMORY_SCOPE_AGENT); }
__device__ __forceinline__ unsigned xb_add(unsigned* p, unsigned v) { return __hip_atomic_fetch_add(p, v, __ATOMIC_RELAXED, __HIP_MEMORY_SCOPE_AGENT); }
__device__ __forceinline__ unsigned xb_xcc_id() { return (unsigned)__builtin_amdgcn_s_getreg((3 << 11) | 20) & 0xFu; }
#define XB_SPIN(cond, bar) do { unsigned _sp = 0; while (cond) { __builtin_amdgcn_s_sleep(1); \
    if ((++_sp & 255u) == 0u) { if (xb_ld(&(bar)[XB_TMO])) break; if (_sp > XB_SPIN_CAP) { atomicAdd(&(bar)[XB_TMO], 1u); break; } } } } while (0)

struct XcdBarrier {
    unsigned* bar; unsigned x;
    volatile LAS unsigned* st;
};

__device__ __forceinline__ XcdBarrier xcd_barrier_post(unsigned* bar, volatile LAS unsigned* st) {
    XcdBarrier b; b.bar = bar; b.x = xb_xcc_id(); b.st = st;
    if (threadIdx.x == 0) (void)xb_add(&bar[XB_XCNT(b.x)], 1u);
    return b;
}
__device__ __forceinline__ void xcd_barrier_complete(unsigned* bar, unsigned x, unsigned& nloc, unsigned& nx) {
    const unsigned G = gridDim.x * gridDim.y * gridDim.z;
    unsigned sum, cnt, mine, sp = 0u;
    for (;;) {
        sum = 0u; cnt = 0u; mine = 0u;
#pragma unroll
        for (unsigned j = 0; j < 16; ++j) { const unsigned c = xb_ld(&bar[XB_XCNT(j)]); sum += c; cnt += (c > 0u) ? 1u : 0u; mine = (j == x) ? c : mine; }
        if (sum == G) break;
        __builtin_amdgcn_s_sleep(1);
        if ((++sp & 255u) == 0u) { if (xb_ld(&bar[XB_TMO])) break; if (sp > XB_SPIN_CAP) { atomicAdd(&bar[XB_TMO], 1u); break; } }
    }
    nloc = mine > 0u ? mine : 1u; nx = cnt > 0u ? cnt : 1u;
}

__device__ __forceinline__ void xcd_barrier(const XcdBarrier& b) {
    asm volatile("s_waitcnt vmcnt(0)" ::: "memory");
    __syncthreads();
    if (threadIdx.x == 0) {
        unsigned* bar = b.bar;
        __builtin_amdgcn_s_waitcnt(0);
        unsigned nloc = b.st[0], nx = b.st[1];
        if (nloc == 0u) { xcd_barrier_complete(bar, b.x, nloc, nx); b.st[0] = nloc; b.st[1] = nx; }
        const unsigned old = xb_add(&bar[XB_XSUB(b.x)], 1u);
        const unsigned gen = old / nloc;
        if (old + 1u == (gen + 1u) * nloc) {
            __builtin_amdgcn_fence(__ATOMIC_RELEASE, "agent");
            asm volatile("s_waitcnt vmcnt(0)" ::: "memory");
            const unsigned og = xb_add(&bar[XB_TOP], 1u);
            const unsigned tg = og / nx;
            if (og + 1u == (tg + 1u) * nx) xb_add(&bar[XB_TOPGEN], 1u);
            else XB_SPIN(xb_ld(&bar[XB_TOPGEN]) == tg, bar);
            __builtin_amdgcn_fence(__ATOMIC_ACQUIRE, "agent");
            xb_add(&bar[XB_XGEN(b.x)], 1u);
            asm volatile("s_waitcnt vmcnt(0)" ::: "memory");
        } else {
            XB_SPIN(xb_ld(&bar[XB_XGEN(b.x)]) == gen, bar);
            __builtin_amdgcn_fence(__ATOMIC_ACQUIRE, "agent");
            asm volatile("s_waitcnt vmcnt(0)" ::: "memory");
        }
    }
    __syncthreads();
}

struct Frame {
    LAS unsigned char* lds;
    volatile LAS unsigned* MISC;
    gu32* ctl;
    int tid, lane, wave;
    int vcu, G;
    unsigned char* ws;
};
__device__ __forceinline__ float wave_sum(float v) {
#pragma unroll
    for (int o = 1; o < 64; o <<= 1) v += __shfl_xor(v, o);
    return v;
}
__device__ __forceinline__ void p0_transpose_item(const float* W, int K, int N, bf16* WT, int row_off, LAS float* scr, int item, int lane, int ldk = 0, int koff = 0) {
    if (ldk == 0) ldk = K;
    const int nblk = N / 32, kb = item / nblk, nb = item % nblk, k0 = 64 * kb, n0 = 32 * nb;
#pragma unroll 8
    for (int i = 0; i < 32; ++i) { const int kk = 2 * i + (lane >> 5); scr[kk * 33 + (lane & 31)] = W[(size_t)(k0 + kk) * N + n0 + (lane & 31)]; }
    LDS_WAIT(); asm volatile("" ::: "memory");
    const int c = lane & 7;
#pragma unroll
    for (int j = 0; j < 4; ++j) { const int n = (lane >> 3) + 8 * j; const LAS float* s = scr + (8 * c) * 33 + n;
        v4u o; o.x = pk2(s[0 * 33], s[1 * 33]); o.y = pk2(s[2 * 33], s[3 * 33]); o.z = pk2(s[4 * 33], s[5 * 33]); o.w = pk2(s[6 * 33], s[7 * 33]);
        *(GAS v4u*)(WT + (size_t)(row_off + n0 + n) * ldk + koff + k0 + 8 * c) = o; }
    LDS_WAIT(); asm volatile("" ::: "memory");
}
__device__ __forceinline__ void rms_row_to_bf16(const float* xrow, const float* g, bf16* orow, int lane) {
    const GAS f32x4* xr = (const GAS f32x4*)xrow + lane; const GAS f32x4* gr = (const GAS f32x4*)g + lane;
    f32x4 v[16]; float s = 0.f;
#pragma unroll
    for (int j = 0; j < 16; ++j) { v[j] = xr[64 * j]; s += (v[j].x * v[j].x + v[j].y * v[j].y) + (v[j].z * v[j].z + v[j].w * v[j].w); }
    const float r = 1.0f / sqrtf(wave_sum(s) * (1.f / 4096.f) + EPS);
    GAS v2u* o8 = (GAS v2u*)orow + lane;
#pragma unroll
    for (int j = 0; j < 16; ++j) { const f32x4 gg = gr[64 * j]; v2u o; o.x = pk2(v[j].x * r * gg.x, v[j].y * r * gg.y); o.y = pk2(v[j].z * r * gg.z, v[j].w * r * gg.w); o8[64 * j] = o; }
}
template <bool XIB, bool XOB>
__device__ __forceinline__ void row_norm_res(const void* xin, const bf16* trow, const float* ssq, const float* gpost, const float* gpre, void* xout, bf16* hout, int lane) {
    const float r1 = 1.0f / sqrtf(wave_sum(ssq[lane]) * (1.f / 4096.f) + EPS);
    const GAS v2u* tr = (const GAS v2u*)trow + lane; const GAS f32x4* gp = (const GAS f32x4*)gpost + lane;
    f32x4 v[16]; float s = 0.f;
#pragma unroll
    for (int j = 0; j < 16; ++j) { f32x4 xv;
        if (XIB) { const v2u xw = ((const GAS v2u*)xin + lane)[64 * j]; xv = (f32x4){bflo(xw.x), bfhi(xw.x), bflo(xw.y), bfhi(xw.y)}; } else xv = ((const GAS f32x4*)xin + lane)[64 * j];
        const v2u tw = tr[64 * j]; const f32x4 gg = gp[64 * j];
        f32x4 o; o.x = xv.x + bflo(tw.x) * r1 * gg.x; o.y = xv.y + bfhi(tw.x) * r1 * gg.y; o.z = xv.z + bflo(tw.y) * r1 * gg.z; o.w = xv.w + bfhi(tw.y) * r1 * gg.w;
        v[j] = o; s += (o.x * o.x + o.y * o.y) + (o.z * o.z + o.w * o.w);
        if (XOB) { v2u ow; ow.x = pk2(o.x, o.y); ow.y = pk2(o.z, o.w); ((GAS v2u*)xout + lane)[64 * j] = ow; } else ((GAS f32x4*)xout + lane)[64 * j] = o; }
    if (hout) {
        const float r2 = 1.0f / sqrtf(wave_sum(s) * (1.f / 4096.f) + EPS);
        const GAS f32x4* gq = (const GAS f32x4*)gpre + lane; GAS v2u* o8 = (GAS v2u*)hout + lane;
#pragma unroll
        for (int j = 0; j < 16; ++j) { const f32x4 gg = gq[64 * j]; v2u o; o.x = pk2(v[j].x * r2 * gg.x, v[j].y * r2 * gg.y); o.y = pk2(v[j].z * r2 * gg.z, v[j].w * r2 * gg.w); o8[64 * j] = o; }
    }
}
__device__ __forceinline__ unsigned cvt2(float lo, float hi) { typedef float f2_t __attribute__((ext_vector_type(2))); typedef __bf16 b2_t __attribute__((ext_vector_type(2))); const f2_t v = {lo, hi}; return __builtin_bit_cast(unsigned, __builtin_convertvector(v, b2_t)); }
template <bool XIB, bool XOB, bool HOUT>
__device__ __forceinline__ void row_phase(Frame& F, const void* xin, const bf16* T, const float* SSQ, const float* gpost, const float* gpre, void* xout, bf16* H, int gw, int NGW) {
    LAS float* gl = (LAS float*)F.lds;
    for (int i = F.tid; i < 1024; i += NWAVES * 64) { *(LAS f32x4*)(gl + 4 * i) = *(const GAS f32x4*)(gpost + 4 * i); if (HOUT) *(LAS f32x4*)(gl + 4096 + 4 * i) = *(const GAS f32x4*)(gpre + 4 * i); }
    __syncthreads();
    v4u xb[8]; f32x4 xf[16]; v4u tb[8]; float sq = 0.f;
#define ROW_ISSUE(m_) do { int mo_ = (m_); asm volatile("" : "+s"(mo_));     \
        const size_t ro_ = (size_t)mo_ * DM + 8 * F.lane; \
        _Pragma("unroll") for (int j = 0; j < 8; ++j) { \
            if constexpr (XIB) xb[j] = *(const GAS v4u*)((const bf16*)xin + ro_ + 512 * j);     \
            tb[j] = *(const GAS v4u*)(T + ro_ + 512 * j); } \
        sq = SSQ[(size_t)(m_) * 64 + F.lane]; } while (0)
    int m = gw; if (m < M) ROW_ISSUE(m);
    for (; m < M; m += NGW) {
        if constexpr (!XIB) { int mx = m; asm volatile("" : "+s"(mx)); const float* xr = (const float*)xin + (size_t)mx * DM + 8 * F.lane;
#pragma unroll
            for (int j = 0; j < 8; ++j) { xf[2 * j] = *(const GAS f32x4*)(xr + 512 * j); xf[2 * j + 1] = *(const GAS f32x4*)(xr + 512 * j + 4); } }
        const float r1 = 1.0f / sqrtf(wave_sum(sq) * (1.f / 4096.f) + EPS);
        f32x4 v[16]; float s = 0.f;
#pragma unroll
        for (int j = 0; j < 8; ++j) { f32x4 x0, x1;
            if constexpr (XIB) { const v4u w = xb[j]; x0 = (f32x4){bflo(w.x), bfhi(w.x), bflo(w.y), bfhi(w.y)}; x1 = (f32x4){bflo(w.z), bfhi(w.z), bflo(w.w), bfhi(w.w)}; } else { x0 = xf[2 * j]; x1 = xf[2 * j + 1]; }
            const v4u tw = tb[j]; const f32x4 t0 = (f32x4){bflo(tw.x), bfhi(tw.x), bflo(tw.y), bfhi(tw.y)}, t1 = (f32x4){bflo(tw.z), bfhi(tw.z), bflo(tw.w), bfhi(tw.w)};
            const f32x4 g0 = *(const LAS f32x4*)(gl + 8 * F.lane + 512 * j), g1 = *(const LAS f32x4*)(gl + 8 * F.lane + 512 * j + 4);
            const f32x4 o0 = x0 + t0 * r1 * g0, o1 = x1 + t1 * r1 * g1; v[2 * j] = o0; v[2 * j + 1] = o1;
            s += ((o0.x * o0.x + o0.y * o0.y) + (o0.z * o0.z + o0.w * o0.w)) + ((o1.x * o1.x + o1.y * o1.y) + (o1.z * o1.z + o1.w * o1.w)); }
        int ms = m; asm volatile("" : "+s"(ms)); const size_t ro = (size_t)ms * DM + 8 * F.lane;
        if (m + NGW < M) ROW_ISSUE(m + NGW);
#pragma unroll
        for (int j = 0; j < 8; ++j) {
            if constexpr (XOB) { v4u o; o.x = cvt2(v[2 * j].x, v[2 * j].y); o.y = cvt2(v[2 * j].z, v[2 * j].w); o.z = cvt2(v[2 * j + 1].x, v[2 * j + 1].y); o.w = cvt2(v[2 * j + 1].z, v[2 * j + 1].w); *(GAS v4u*)((bf16*)xout + ro + 512 * j) = o; }
            else { *(GAS f32x4*)((float*)xout + ro + 512 * j) = v[2 * j]; *(GAS f32x4*)((float*)xout + ro + 512 * j + 4) = v[2 * j + 1]; } }
        if constexpr (HOUT) {
            const float r2 = 1.0f / sqrtf(wave_sum(s) * (1.f / 4096.f) + EPS);
#pragma unroll
            for (int j = 0; j < 8; ++j) { const f32x4 g0 = *(const LAS f32x4*)(gl + 4096 + 8 * F.lane + 512 * j), g1 = *(const LAS f32x4*)(gl + 4096 + 8 * F.lane + 512 * j + 4);
                v4u o; o.x = cvt2(v[2 * j].x * r2 * g0.x, v[2 * j].y * r2 * g0.y); o.y = cvt2(v[2 * j].z * r2 * g0.z, v[2 * j].w * r2 * g0.w);
                o.z = cvt2(v[2 * j + 1].x * r2 * g1.x, v[2 * j + 1].y * r2 * g1.y); o.w = cvt2(v[2 * j + 1].z * r2 * g1.z, v[2 * j + 1].w * r2 * g1.w); *(GAS v4u*)(H + ro + 512 * j) = o; } }
    }
#undef ROW_ISSUE
    __syncthreads();
}
__device__ __forceinline__ void sincos_d(float angf, float& sn, float& cs) {
    const double a = (double)angf; const double n = __builtin_rint(a * 0.6366197723675814);
    double r = __builtin_fma(-n, 1.5707963267948966, a); r = __builtin_fma(-n, 6.123233995736766e-17, r);
    const double r2 = r * r;
    double sp = 1.0 / 6227020800.0; sp = sp * r2 - 1.0 / 39916800.0; sp = sp * r2 + 1.0 / 362880.0; sp = sp * r2 - 1.0 / 5040.0; sp = sp * r2 + 1.0 / 120.0; sp = sp * r2 - 1.0 / 6.0; sp = sp * r2 + 1.0; sp = sp * r;
    double cp = -1.0 / 87178291200.0; cp = cp * r2 + 1.0 / 479001600.0; cp = cp * r2 - 1.0 / 3628800.0; cp = cp * r2 + 1.0 / 40320.0; cp = cp * r2 - 1.0 / 720.0; cp = cp * r2 + 1.0 / 24.0; cp = cp * r2 - 0.5; cp = cp * r2 + 1.0;
    const int q = (int)n & 3;
    const double s = (q == 0) ? sp : (q == 1) ? cp : (q == 2) ? -sp : -cp;
    const double c = (q == 0) ? cp : (q == 1) ? -sp : (q == 2) ? -cp : sp;
    sn = (float)s; cs = (float)c;
}

typedef short v4i16_t __attribute__((ext_vector_type(4)));
__device__ __forceinline__ s16x4 vtr(const LAS unsigned char* p) { return __builtin_bit_cast(s16x4, __builtin_amdgcn_ds_read_tr16_b64_v4i16((LAS v4i16_t*)p)); }
__device__ __forceinline__ unsigned cvtpk(float lo, float hi) { unsigned r; asm volatile("s_nop 0\n\tv_cvt_pk_bf16_f32 %0, %1, %2\n\ts_nop 1" : "=v"(r) : "v"(lo), "v"(hi)); return r; }
constexpr float ATT_C2 = 0.08838834764831845f * 1.4426950408889634f;
constexpr float ATT_SCALE = 0.08838834764831845f;

template <int NR>
__device__ __forceinline__ void att_issue(v4u (&st)[NR / 32], const bf16* src, size_t gstride, int tid) {
#pragma unroll
    for (int it = 0; it < NR / 32; ++it) st[it] = *(const GAS v4u*)(src + (size_t)((tid >> 4) + 32 * it) * gstride + (tid & 15) * 8);
}
template <int NR>
__device__ __forceinline__ void att_write(const v4u (&st)[NR / 32], LAS unsigned char* img, int lrow0, int tid) {
#pragma unroll
    for (int it = 0; it < NR / 32; ++it) *(LAS v4u*)(img + (lrow0 + (tid >> 4) + 32 * it) * ATT_KSTR + (tid & 15) * 16) = st[it];
}
__device__ __forceinline__ void att_q(bf16x8 (&qf)[4], const bf16* qrow, int lane) {
#pragma unroll
    for (int s = 0; s < 4; ++s) qf[s] = *(const GAS bf16x8*)(qrow + 32 * s + 8 * (lane >> 4));
}
template <int NT, bool BAND>
__device__ __forceinline__ void att_core(const LAS unsigned char* Kimg, const LAS unsigned char* Vimg, int krow0, int kmin, int rot  ,
                                         const bf16x8 (&qf)[4]  , bf16* orow  , float* lse_out  , int lane) {
    const int fr = lane & 15, fq = lane >> 4;
    f32x4 sc[NT];
    const LAS unsigned char* kb = Kimg + fr * ATT_KSTR + 16 * fq;
#pragma unroll
    for (int T = 0; T < NT; ++T) { sc[T] = (f32x4){0.f, 0.f, 0.f, 0.f}; const int trow = (krow0 + rot + 16 * T) & 255;
#pragma unroll
        for (int s = 0; s < 4; ++s) { const bf16x8 kf = *(const LAS bf16x8*)(kb + trow * ATT_KSTR + 64 * s);
            sc[T] = __builtin_amdgcn_mfma_f32_16x16x32_bf16(kf, qf[s], sc[T], 0, 0, 0); } }
    const float NEG = -__builtin_inff();
    if (BAND) {
#pragma unroll
        for (int r = 0; r < 4; ++r) { if (4 * fq + r < fr) sc[0][r] = NEG; if (4 * fq + r > fr) sc[NT - 1][r] = NEG; }
        if (kmin > 0) {
#pragma unroll
            for (int T = 0; T < NT; ++T)
#pragma unroll
                for (int r = 0; r < 4; ++r) if (krow0 + 16 * T + 4 * fq + r < kmin) sc[T][r] = NEG;
        }
    }
    float mx = sc[0][0];
#pragma unroll
    for (int T = 0; T < NT; ++T)
#pragma unroll
        for (int r = 0; r < 4; ++r) mx = fmaxf(mx, sc[T][r]);
    mx = fmaxf(mx, __shfl_xor(mx, 16)); mx = fmaxf(mx, __shfl_xor(mx, 32));
    const float mL = mx * ATT_C2; float l = 0.f;
#pragma unroll
    for (int T = 0; T < NT; ++T)
#pragma unroll
        for (int r = 0; r < 4; ++r) { const float p = __builtin_amdgcn_exp2f(sc[T][r] * ATT_C2 - mL); sc[T][r] = p; l += p; }
    l += __shfl_xor(l, 16); l += __shfl_xor(l, 32);
    constexpr int NKS = (NT + 1) / 2;
    f32x4 oa[8];
#pragma unroll
    for (int c = 0; c < 8; ++c) oa[c] = (f32x4){0.f, 0.f, 0.f, 0.f};
    const LAS unsigned char* vb = Vimg + (4 * fq + (fr >> 2)) * ATT_KSTR + 8 * (fr & 3);
#pragma unroll
    for (int ks = 0; ks < NKS; ++ks) { const int vr0 = (krow0 + rot + 32 * ks) & 255, vr1 = (krow0 + rot + 32 * ks + 16) & 255;
        v4u pw; pw.x = cvtpk(sc[2 * ks][0], sc[2 * ks][1]); pw.y = cvtpk(sc[2 * ks][2], sc[2 * ks][3]);
        if (2 * ks + 1 < NT) { pw.z = cvtpk(sc[2 * ks + 1 < NT ? 2 * ks + 1 : 0][0], sc[2 * ks + 1 < NT ? 2 * ks + 1 : 0][1]); pw.w = cvtpk(sc[2 * ks + 1 < NT ? 2 * ks + 1 : 0][2], sc[2 * ks + 1 < NT ? 2 * ks + 1 : 0][3]); }
        else { pw.z = 0u; pw.w = 0u; }
        const bf16x8 pf = __builtin_bit_cast(bf16x8, pw);
#pragma unroll
        for (int c = 0; c < 8; ++c) { const s16x4 lo = vtr(vb + vr0 * ATT_KSTR + 32 * c), hi = vtr(vb + vr1 * ATT_KSTR + 32 * c);
            const bf16x8 vf = __builtin_shufflevector(lo, hi, 0, 1, 2, 3, 4, 5, 6, 7);
            oa[c] = __builtin_amdgcn_mfma_f32_16x16x32_bf16(vf, pf, oa[c], 0, 0, 0); }
    }
    const float rl = 1.0f / l;
#pragma unroll
    for (int c = 0; c < 8; ++c) { v2u o; o.x = cvtpk(oa[c][0] * rl, oa[c][1] * rl); o.y = cvtpk(oa[c][2] * rl, oa[c][3] * rl); *(GAS v2u*)(orow + 16 * c + 4 * fq) = o; }
    if (lse_out && fq == 0) *lse_out = mx * ATT_SCALE + __logf(l);
}
struct SaUnit { int g, d, qb, h; size_t tok0, col; };
__device__ __forceinline__ SaUnit sa_unit(int i, int per, int G, int bx) {
    int c, h;
    if (per > 0) { c = (bx >> 3) * per + i; h = bx & 7; } else { const int idx = bx + i * G; c = idx >> 3; h = idx & 7; }
    SaUnit u; u.g = c >> 7; const int cc = c & 127, sh = 2 * u.g, nblk = 32 >> sh; u.d = 1 << sh;
    u.qb = cc % nblk; const int t1 = cc / nblk, r = t1 % u.d, b = t1 / u.d; u.h = h;
    u.tok0 = (size_t)b * SEQ + r; u.col = (size_t)u.g * 1024 + h * 128; return u;
}
__device__ __forceinline__ void sa_issue(v4u (&stK)[8], v4u (&stV)[8], const bf16* K, const bf16* V, const SaUnit& u, bool shared, int tid) {
    const size_t gs = (size_t)u.d * QKVW; const int pb = 128 * (u.qb - 1) + (tid >> 4); const int fix = u.qb == 0 ? 128 : 0;
    const size_t base = u.tok0 * QKVW + u.col + (tid & 15) * 8;
    if (!shared) {
#pragma unroll
        for (int it = 0; it < 4; ++it) { const size_t off = base + (size_t)(pb + 32 * it + fix) * gs; stK[it] = *(const GAS v4u*)(K + off); stV[it] = *(const GAS v4u*)(V + off); } }
#pragma unroll
    for (int it = 4; it < 8; ++it) { const size_t off = base + (size_t)(pb + 32 * it) * gs; stK[it] = *(const GAS v4u*)(K + off); stV[it] = *(const GAS v4u*)(V + off); }
}
__device__ __forceinline__ void sa_write(const v4u (&stK)[8], const v4u (&stV)[8], LAS unsigned char* Kimg, LAS unsigned char* Vimg, bool shared, int rot, int tid) {
    if (!shared) {
#pragma unroll
        for (int it = 0; it < 4; ++it) { const int o = ((((tid >> 4) + 32 * it) + rot) & 255) * ATT_KSTR + (tid & 15) * 16; *(LAS v4u*)(Kimg + o) = stK[it]; *(LAS v4u*)(Vimg + o) = stV[it]; } }
#pragma unroll
    for (int it = 4; it < 8; ++it) { const int o = ((((tid >> 4) + 32 * it) + rot) & 255) * ATT_KSTR + (tid & 15) * 16; *(LAS v4u*)(Kimg + o) = stK[it]; *(LAS v4u*)(Vimg + o) = stV[it]; }
}
__device__ __forceinline__ void self_attn_stream(Frame& F, const bf16* Q, const bf16* K, const bf16* V, bf16* OG, float* LSE) {
    LAS unsigned char* Kimg = F.lds + ATT_K_OFF; LAS unsigned char* Vimg = F.lds + ATT_V_OFF;
    const int bx = (int)blockIdx.x, G = F.G, per = (G % 8 == 0 && 3072 % G == 0) ? 3072 / G : 0, n = per ? per : (3072 - bx + G - 1) / G;
    if (n <= 0) return;
    v4u stK[8], stV[8]; SaUnit u = sa_unit(0, per, G, bx); bool shared = false; int rot = 0;
    size_t tok = u.tok0 + (size_t)(128 * u.qb + 16 * F.wave + (F.lane & 15)) * u.d;
    bf16x8 qn[4]; att_q(qn, Q + tok * QKVW + u.col, F.lane);
    sa_issue(stK, stV, K, V, u, false, F.tid);
    for (int i = 0; i < n; ++i) {
        sa_write(stK, stV, Kimg, Vimg, shared, rot, F.tid);
        __syncthreads();
        bf16x8 qf[4];
#pragma unroll
        for (int s = 0; s < 4; ++s) qf[s] = qn[s];
        const int kmin = u.qb == 0 ? 128 : 0, crot = rot; bf16* orow = OG + ((size_t)u.g * M + tok) * AW + u.h * 128; float* lse = LSE + ((size_t)u.g * M + tok) * 8 + u.h;
        const bool more = i + 1 < n;
        if (more) { const SaUnit nu = sa_unit(i + 1, per, G, bx);
            shared = (nu.g == u.g) && (nu.tok0 == u.tok0) && (nu.h == u.h) && (nu.qb == u.qb + 1);
            rot = shared ? (rot ^ 128) : 0; u = nu;
            tok = u.tok0 + (size_t)(128 * u.qb + 16 * F.wave + (F.lane & 15)) * u.d;
            sa_issue(stK, stV, K, V, u, shared, F.tid); att_q(qn, Q + tok * QKVW + u.col, F.lane); }
        att_core<9, true>(Kimg, Vimg, 16 * F.wave, kmin, crot, qf, orow, lse, F.lane);
        __syncthreads();
    }
}
__device__ __forceinline__ void cross_attn_stream(Frame& F, const bf16* QX, const bf16* KVX, bf16* OX) {
    LAS unsigned char* Kimg = F.lds + ATT_K_OFF; LAS unsigned char* Vimg = F.lds + ATT_V_OFF;
    const int per = (512 % F.G == 0) ? 512 / F.G : 0;
    const int n = per ? per : (512 - (int)blockIdx.x + F.G - 1) / F.G; int loaded = -1;
    for (int i = 0; i < n; ++i) { const int idx = per ? (int)blockIdx.x * per + i : (int)blockIdx.x + i * F.G; if (idx >= 512) break;
        const int qblk = idx & 31, bh = idx >> 5, h = bh & 3, b = bh >> 2;
        if (bh != loaded) { if (loaded >= 0) __syncthreads();
            const size_t off = (size_t)b * NMEM * 1024 + h * 128;
            v4u stK[8], stV[8]; att_issue<256>(stK, KVX + off, 1024, F.tid); att_issue<256>(stV, KVX + off + 512, 1024, F.tid);
            att_write<256>(stK, Kimg, 0, F.tid); att_write<256>(stV, Vimg, 0, F.tid);
            __syncthreads(); loaded = bh; }
        const size_t tok = (size_t)b * SEQ + 128 * qblk + 16 * F.wave + (F.lane & 15);
        bf16x8 qf[4]; att_q(qf, QX + tok * XAW + h * 128, F.lane);
        att_core<16, false>(Kimg, Vimg, 0, 0, 0, qf, OX + tok * XAW + h * 128, nullptr, F.lane);
    }
    __syncthreads();
}
__device__ __forceinline__ void sgu_unit(Frame& F, int idx, const bf16* U, bf16* YB, const bf16* VB, const float* lnstat, const float* lng, const float* lnb, const bf16* WSP, const float* bsp) {
    const int g = idx & 15, cn = idx >> 4, C0 = g * 128; const size_t tok0 = (size_t)cn * 128;
    LAS unsigned char* img = F.lds; LAS f32x2* stat = (LAS f32x2*)(F.lds + 40960);
    if (F.tid < 128) { const float* sp = lnstat + (tok0 + F.tid) * 64; float s = 0.f, q = 0.f;
#pragma unroll
        for (int k = 0; k < 16; ++k) { const f32x4 v = *(const GAS f32x4*)(sp + 4 * k); s += v.x + v.z; q += v.y + v.w; }
        const float mu = s * (1.f / 2048.f), var = q * (1.f / 2048.f) - mu * mu; stat[F.tid] = (f32x2){mu, 1.0f / sqrtf(var + EPS)}; }
    __syncthreads();
    { const int ch = F.tid & 15; const float* gp = lng + C0 + 8 * ch; const float* bp = lnb + C0 + 8 * ch;
      const f32x4 g0 = *(const GAS f32x4*)gp, g1 = *(const GAS f32x4*)(gp + 4), b0 = *(const GAS f32x4*)bp, b1 = *(const GAS f32x4*)(bp + 4);
      v4u raw[4];
#pragma unroll
      for (int it = 0; it < 4; ++it) raw[it] = *(const GAS v4u*)(VB + (tok0 + (F.tid >> 4) + 32 * it) * SGW + C0 + 8 * ch);
#pragma unroll
      for (int it = 0; it < 4; ++it) { const int j = (F.tid >> 4) + 32 * it; const f32x2 st = stat[j]; const v4u w = raw[it]; v4u o;
          o.x = cvtpk((bflo(w.x) - st.x) * st.y * g0.x + b0.x, (bfhi(w.x) - st.x) * st.y * g0.y + b0.y); o.y = cvtpk((bflo(w.y) - st.x) * st.y * g0.z + b0.z, (bfhi(w.y) - st.x) * st.y * g0.w + b0.w);
          o.z = cvtpk((bflo(w.z) - st.x) * st.y * g1.x + b1.x, (bfhi(w.z) - st.x) * st.y * g1.y + b1.y); o.w = cvtpk((bflo(w.w) - st.x) * st.y * g1.z + b1.z, (bfhi(w.w) - st.x) * st.y * g1.w + b1.w);
          *(LAS v4u*)(img + j * ATT_KSTR + ch * 16) = o; } }
    __syncthreads();
    const int fr = F.lane & 15, fq = F.lane >> 4, w = F.wave, nsteps = (w >> 1) + 1;
    f32x4 acc[8];
#pragma unroll
    for (int c = 0; c < 8; ++c) acc[c] = (f32x4){0.f, 0.f, 0.f, 0.f};
    const bf16* wrow = WSP + ((size_t)g * 128 + 16 * w + fr) * 128 + 8 * fq;
    const LAS unsigned char* vb = img + (8 * fq + (fr >> 2)) * ATT_KSTR + 8 * (fr & 3);
    for (int s = 0; s < nsteps; ++s) { const bf16x8 wf = *(const GAS bf16x8*)(wrow + 32 * s);
#pragma unroll
        for (int c = 0; c < 8; ++c) { const s16x4 lo = vtr(vb + (32 * s) * ATT_KSTR + 32 * c), hi = vtr(vb + (32 * s + 4) * ATT_KSTR + 32 * c);
            const bf16x8 vf = __builtin_shufflevector(lo, hi, 0, 1, 2, 3, 4, 5, 6, 7);
            acc[c] = __builtin_amdgcn_mfma_f32_16x16x32_bf16(vf, wf, acc[c], 0, 0, 0); } }
    const float bias = bsp[g * 128 + 16 * w + fr];
    const bf16* urow = U + (tok0 + 16 * w + fr) * SGW + C0 + 4 * fq; bf16* yrow = YB + (tok0 + 16 * w + fr) * (AW + SGW) + AW + C0 + 4 * fq;
#pragma unroll
    for (int c = 0; c < 8; ++c) { const v2u uw = *(const GAS v2u*)(urow + 16 * c); v2u o;
        o.x = cvtpk(bflo(uw.x) * (acc[c][0] + bias), bfhi(uw.x) * (acc[c][1] + bias)); o.y = cvtpk(bflo(uw.y) * (acc[c][2] + bias), bfhi(uw.y) * (acc[c][3] + bias));
        *(GAS v2u*)(yrow + 16 * c) = o; }
    __syncthreads();
}

__device__ __forceinline__ void sgu_stream(Frame& F, int per, const bf16* U, bf16* YB, const bf16* VB, const float* lnstat, const float* lng, const float* lnb, const bf16* WSP, const float* bsp) {
    const int idx0 = (int)blockIdx.x * per, cn = idx0 >> 4, g0 = idx0 & 15; const size_t tok0 = (size_t)cn * 128;
    LAS unsigned char* img = F.lds; LAS f32x2* stat = (LAS f32x2*)(F.lds + 40960);
    if (F.tid < 128) { const float* sp = lnstat + (tok0 + F.tid) * 64; float s = 0.f, q = 0.f;
#pragma unroll
        for (int k = 0; k < 16; ++k) { const f32x4 v = *(const GAS f32x4*)(sp + 4 * k); s += v.x + v.z; q += v.y + v.w; }
        const float mu = s * (1.f / 2048.f), var = q * (1.f / 2048.f) - mu * mu; stat[F.tid] = (f32x2){mu, 1.0f / sqrtf(var + EPS)}; }
    const int ch = F.tid & 15, fr = F.lane & 15, fq = F.lane >> 4, w = F.wave, nsteps = (w >> 1) + 1;
    v4u raw[4];
#pragma unroll
    for (int it = 0; it < 4; ++it) raw[it] = *(const GAS v4u*)(VB + (tok0 + (F.tid >> 4) + 32 * it) * SGW + g0 * 128 + 8 * ch);
    __syncthreads();
    const LAS unsigned char* vb = img + (8 * fq + (fr >> 2)) * ATT_KSTR + 8 * (fr & 3);
    for (int i = 0; i < per; ++i) { const int g = g0 + i, C0 = g * 128;
        { const float* gp = lng + C0 + 8 * ch; const float* bp = lnb + C0 + 8 * ch;
          const f32x4 ga = *(const GAS f32x4*)gp, gb = *(const GAS f32x4*)(gp + 4), ba = *(const GAS f32x4*)bp, bb = *(const GAS f32x4*)(bp + 4);
#pragma unroll
          for (int it = 0; it < 4; ++it) { const int j = (F.tid >> 4) + 32 * it; const f32x2 st = stat[j]; const v4u wv = raw[it]; v4u o;
              o.x = cvtpk((bflo(wv.x) - st.x) * st.y * ga.x + ba.x, (bfhi(wv.x) - st.x) * st.y * ga.y + ba.y); o.y = cvtpk((bflo(wv.y) - st.x) * st.y * ga.z + ba.z, (bfhi(wv.y) - st.x) * st.y * ga.w + ba.w);
              o.z = cvtpk((bflo(wv.z) - st.x) * st.y * gb.x + bb.x, (bfhi(wv.z) - st.x) * st.y * gb.y + bb.y); o.w = cvtpk((bflo(wv.w) - st.x) * st.y * gb.z + bb.z, (bfhi(wv.w) - st.x) * st.y * gb.w + bb.w);
              *(LAS v4u*)(img + j * ATT_KSTR + ch * 16) = o; } }
        __syncthreads();
        const bf16* wrow = WSP + ((size_t)g * 128 + 16 * w + fr) * 128 + 8 * fq;
        bf16x8 wf[4];
#pragma unroll
        for (int s = 0; s < 4; ++s) wf[s] = *(const GAS bf16x8*)(wrow + 32 * (s < nsteps ? s : 0));
        const bf16* urow = U + (tok0 + 16 * w + fr) * SGW + C0 + 4 * fq; bf16* yrow = YB + (tok0 + 16 * w + fr) * (AW + SGW) + AW + C0 + 4 * fq;
        v2u uw[8];
#pragma unroll
        for (int c = 0; c < 8; ++c) uw[c] = *(const GAS v2u*)(urow + 16 * c);
        const float bias = bsp[g * 128 + 16 * w + fr];
        if (i + 1 < per) {
#pragma unroll
            for (int it = 0; it < 4; ++it) raw[it] = *(const GAS v4u*)(VB + (tok0 + (F.tid >> 4) + 32 * it) * SGW + C0 + 128 + 8 * ch); }
        f32x4 acc[8];
#pragma unroll
        for (int c = 0; c < 8; ++c) acc[c] = (f32x4){0.f, 0.f, 0.f, 0.f};
#pragma unroll
        for (int s = 0; s < 4; ++s) { if (s < nsteps) {
#pragma unroll
            for (int c = 0; c < 8; ++c) { const s16x4 lo = vtr(vb + (32 * s) * ATT_KSTR + 32 * c), hi = vtr(vb + (32 * s + 4) * ATT_KSTR + 32 * c);
                const bf16x8 vf = __builtin_shufflevector(lo, hi, 0, 1, 2, 3, 4, 5, 6, 7);
                acc[c] = __builtin_amdgcn_mfma_f32_16x16x32_bf16(vf, wf[s], acc[c], 0, 0, 0); } } }
#pragma unroll
        for (int c = 0; c < 8; ++c) { v2u o;
            o.x = cvtpk(bflo(uw[c].x) * (acc[c][0] + bias), bfhi(uw[c].x) * (acc[c][1] + bias)); o.y = cvtpk(bflo(uw[c].y) * (acc[c][2] + bias), bfhi(uw[c].y) * (acc[c][3] + bias));
            *(GAS v2u*)(yrow + 16 * c) = o; }
        __syncthreads();
    }
}

struct ConvJob { const float* W; bf16* WT; int K, N, row_off, ldk, koff, item; };
__device__ __forceinline__ void conv_load(f32x4 (&v)[16], const ConvJob& j, int lane) {
    const int nblk = j.N >> 6, kb = j.item / nblk, nb = j.item - kb * nblk;
    const float* src = j.W + (size_t)(64 * kb + (lane >> 4)) * j.N + 64 * nb + 4 * (lane & 15); const size_t st = (size_t)4 * j.N;
#pragma unroll
    for (int i = 0; i < 16; ++i) v[i] = *(const GAS f32x4*)(src + i * st);
}
__device__ __forceinline__ void conv_to_lds(const f32x4 (&v)[16], LAS unsigned char* scr, int lane) {
#pragma unroll
    for (int i = 0; i < 16; ++i) { v2u o; o.x = cvt2(v[i].x, v[i].y); o.y = cvt2(v[i].z, v[i].w); *(LAS v2u*)(scr + ((lane >> 4) + 4 * i) * 144 + 8 * (lane & 15)) = o; }
}
__device__ __forceinline__ void conv_store(const ConvJob& j, const LAS unsigned char* scr, int lane) {
    const int nblk = j.N >> 6, kb = j.item / nblk, nb = j.item - kb * nblk, i16 = lane & 15, fq = lane >> 4;
    const LAS unsigned char* rb = scr + (8 * fq + (i16 >> 2)) * 144 + 8 * (i16 & 3);
    bf16* dst = j.WT + (size_t)(j.row_off + 64 * nb + i16) * j.ldk + j.koff + 64 * kb + 8 * fq;
#pragma unroll
    for (int jj = 0; jj < 8; ++jj) { const int nb16 = jj & 3, kh = jj >> 2;
        const s16x4 lo = vtr(rb + (32 * kh) * 144 + 32 * nb16), hi = vtr(rb + (32 * kh + 4) * 144 + 32 * nb16);
        const bf16x8 o = __builtin_shufflevector(lo, hi, 0, 1, 2, 3, 4, 5, 6, 7);
        *(GAS bf16x8*)(dst + (size_t)(16 * nb16) * j.ldk + 32 * kh) = o; }
}
#define CONV_STREAM(LO_, HI_, CTR_, DECODE_) do { \
        LAS unsigned char* scr_ = F.lds + RING_OFF + F.wave * 16384; volatile LAS unsigned* tkL_ = (volatile LAS unsigned*)(F.lds + MISC_OFF + 64); \
        f32x4 cv_[16]; ConvJob cur_, nxt_; unsigned tv_ = 0u; int rnd_ = 0; \
        if (F.tid == 0) { tkL_[0] = __hip_atomic_fetch_add((CTR_), 1u, __ATOMIC_RELAXED, __HIP_MEMORY_SCOPE_AGENT); tkL_[1] = __hip_atomic_fetch_add((CTR_), 1u, __ATOMIC_RELAXED, __HIP_MEMORY_SCOPE_AGENT); } \
        __syncthreads(); \
        int tc_ = (int)tkL_[0], tn_ = (int)tkL_[1]; \
        __syncthreads(); \
        int it_ = (LO_) + 8 * tc_ + F.wave; bool have_ = it_ < (HI_); \
        if (have_) { DECODE_(it_, cur_); conv_load(cv_, cur_, F.lane); } \
        while ((LO_) + 8 * tc_ < (HI_)) { \
            if (F.tid == 0) tv_ = __hip_atomic_fetch_add((CTR_), 1u, __ATOMIC_RELAXED, __HIP_MEMORY_SCOPE_AGENT); \
            if (have_) conv_to_lds(cv_, scr_, F.lane); \
            const int itn_ = (LO_) + 8 * tn_ + F.wave; const bool more_ = itn_ < (HI_); \
            if (more_) { DECODE_(itn_, nxt_); conv_load(cv_, nxt_, F.lane); } \
            if (have_) { asm volatile("s_waitcnt lgkmcnt(0)" ::: "memory"); conv_store(cur_, scr_, F.lane); asm volatile("s_waitcnt lgkmcnt(0)" ::: "memory"); } \
            if (F.tid == 0) tkL_[rnd_ & 1] = tv_; \
            __syncthreads(); \
            tc_ = tn_; tn_ = (int)tkL_[rnd_ & 1]; cur_ = nxt_; have_ = more_; ++rnd_; } \
        __syncthreads(); \
    } while (0)

struct Args { const float* in[26]; float* out; unsigned char* ws; int ph_lo, ph_hi, li, pad; };
constexpr float ROPE_INV[16] = {1.0f, 0.44036659598350525f, 0.1939227432012558f, 0.08539710193872452f, 0.03760603070259094f, 0.01656043902039528f, 0.007292664609849453f, 0.0032114458736032248f,
    0.0014142135623842478f, 0.000622772378847003f, 0.00027424818836152554f, 0.00012076973507646471f, 5.318296098266728e-05f, 2.34199997066753e-05f, 1.0313386155758053e-05f, 4.541670477919979e-06f};

__global__ void __launch_bounds__(NWAVES * 64, 2) skel_fwd(Args args) {
    extern __shared__ __attribute__((aligned(16))) unsigned char lds[];
    Frame F;
    F.lds = (LAS unsigned char*)lds;
    F.MISC = (volatile LAS unsigned*)(F.lds + MISC_OFF);
    F.tid = threadIdx.x; F.lane = F.tid & 63; F.wave = __builtin_amdgcn_readfirstlane(F.tid >> 6);
    F.G = gridDim.x; { const int bx = blockIdx.x; F.vcu = (F.G % 8 == 0) ? (bx % 8) * (F.G / 8) + bx / 8 : bx; }
    unsigned char* ws = args.ws; F.ws = ws;
    F.ctl = (gu32*)(ws + WS_CTL);
    const float* x = args.in[0]; const float* mem = args.in[1]; const int* positions = (const int*)args.in[2]; const float* mix_pre_g = args.in[3]; const float* w_in = args.in[4];
    const float* sgu_ln_g = args.in[5]; const float* sgu_ln_b = args.in[6]; const float* w_spatial = args.in[7]; const float* b_spatial = args.in[8];
    const float* w_branch_a = args.in[9]; const float* w_branch_b = args.in[10]; const float* w_gate = args.in[11]; const float* b_gate = args.in[12]; const float* w_out = args.in[13];
    const float* mix_post_g = args.in[14]; const float* xa_pre_g = args.in[15]; const float* mem_norm_g = args.in[16];
    const float* w_xq = args.in[17]; const float* w_xk = args.in[18]; const float* w_xv = args.in[19]; const float* w_xo = args.in[20];
    const float* xa_post_g = args.in[21]; const float* mlp_pre_g = args.in[22]; const float* w_up = args.in[23]; const float* w_down = args.in[24]; const float* mlp_post_g = args.in[25];
    float* out = args.out;
    float* ROPE = (float*)(ws + WS_ROPE); float* LNST = (float*)(ws + WS_LNST); float* SSQ = (float*)(ws + WS_SSQ); float* LSE = (float*)(ws + WS_LSE);
    bf16* WSP = (bf16*)(ws + WS_WSP); bf16* WING = (bf16*)(ws + WS_WING); bf16* WAB = (bf16*)(ws + WS_WA); bf16* WOUT = (bf16*)(ws + WS_WOUT);
    bf16* WXQ = (bf16*)(ws + WS_WXQ); bf16* WKV = (bf16*)(ws + WS_WKV); bf16* WXO = (bf16*)(ws + WS_WXO); bf16* WUP = (bf16*)(ws + WS_WUP); bf16* WDN = (bf16*)(ws + WS_WDN);
    bf16* H = (bf16*)(ws + WS_H); bf16* Qb = (bf16*)(ws + WS_Q); bf16* Kb = (bf16*)(ws + WS_K); bf16* Vb = (bf16*)(ws + WS_V); bf16* Ub = (bf16*)(ws + WS_U); bf16* VBb = (bf16*)(ws + WS_VB);
    bf16* Gb = (bf16*)(ws + WS_G); bf16* MRG = (bf16*)(ws + WS_MRG); bf16* OG = (bf16*)(ws + WS_OG); bf16* KVX = (bf16*)(ws + WS_KVX); bf16* MB = (bf16*)(ws + WS_MB);
    bf16* T = (bf16*)(ws + WS_T); bf16* QX = (bf16*)(ws + WS_QX); bf16* OX = (bf16*)(ws + WS_OX); bf16* Ab = (bf16*)(ws + WS_A); bf16* T3 = (bf16*)(ws + WS_T3); bf16* XB = (bf16*)(ws + WS_XB); bf16* YAB = (bf16*)(ws + WS_YAB); constexpr int YABW = AW + SGW;

    for (int u = F.tid; u < (LDS_BYTES - MISC_OFF) / 4; u += NWAVES * 64) ((LAS unsigned*)(F.lds + MISC_OFF))[u] = 0u;
    __syncthreads();
#if MK_PER_PHASE
#define GRID_BAR() do { } while (0)
#else
    XcdBarrier bar = xcd_barrier_post((unsigned*)(F.ctl + CW_BAR) + args.li * XCD_BAR_WORDS, F.MISC + 8);
#define GRID_BAR() xcd_barrier(bar)
#endif
    const int lo = args.ph_lo, hi = args.ph_hi;
#define IN(k) (lo <= (k) && (k) < hi)
#define BOTH(k) (IN(k) && IN((k) + 1))
    const int gw = F.vcu * NWAVES + F.wave, NGW = F.G * NWAVES, bx = (int)blockIdx.x;
    const int gtid = bx * (NWAVES * 64) + F.tid, NGT = F.G * NWAVES * 64;
    constexpr int I_UP = 64 * (DFF / 64), I_DN = (DFF / 64) * (DM / 64), P7_BUSY = 144, CONV_PER_WAVE = 18;
    const int conv_early = (F.G > P7_BUSY) ? (((F.G - P7_BUSY) * NWAVES * CONV_PER_WAVE < I_UP + I_DN) ? (F.G - P7_BUSY) * NWAVES * CONV_PER_WAVE : I_UP + I_DN) : 0;

    if (IN(0)) {
        constexpr int I_IN = 64 * (INW / 64), I_G = 64 * (GW / 64), I_A = 16 * 64, I_B = 32 * 64, I_O = 64 * 64, I_XQ = 64 * 8, I_XO = 8 * 64;
        constexpr int NITEMS = I_IN + I_G + I_A + I_B + I_O + 3 * I_XQ + I_XO;
#define P0_DECODE(r_, J) do { int r = (r_); \
            if (r < I_IN) { J = ConvJob{w_in, WING, DM, INW, 0, DM, 0, r}; break; } r -= I_IN; \
            if (r < I_G) { J = ConvJob{w_gate, WING, DM, GW, INW, DM, 0, r}; break; } r -= I_G; \
            if (r < I_A) { J = ConvJob{w_branch_a, WAB, AW, DM, 0, AW + SGW, 0, r}; break; } r -= I_A; \
            if (r < I_B) { J = ConvJob{w_branch_b, WAB, SGW, DM, 0, AW + SGW, AW, r}; break; } r -= I_B; \
            if (r < I_O) { J = ConvJob{w_out, WOUT, DM, DM, 0, DM, 0, r}; break; } r -= I_O; \
            if (r < I_XQ) { J = ConvJob{w_xq, WXQ, DM, XAW, 0, DM, 0, r}; break; } r -= I_XQ; \
            if (r < I_XQ) { J = ConvJob{w_xk, WKV, DM, XAW, 0, DM, 0, r}; break; } r -= I_XQ; \
            if (r < I_XQ) { J = ConvJob{w_xv, WKV, DM, XAW, XAW, DM, 0, r}; break; } r -= I_XQ; \
            J = ConvJob{w_xo, WXO, XAW, DM, 0, XAW, 0, r}; } while (0)
        for (int m = gw; m < M; m += NGW) rms_row_to_bf16(x + (size_t)m * DM, mix_pre_g, H + (size_t)m * DM, F.lane);
        for (int m = gw; m < MROWS; m += NGW) rms_row_to_bf16(mem + (size_t)m * DM, mem_norm_g, MB + (size_t)m * DM, F.lane);
        __syncthreads();
        CONV_STREAM(0, NITEMS, F.ctl + CW_TICKET, P0_DECODE);
#undef P0_DECODE
        for (int i = gtid; i < M * 16; i += NGT) { const int tok = i >> 4, k = i & 15; const float ang = (float)positions[tok] * ROPE_INV[k]; float sn, cs; sincos_d(ang, sn, cs);
            ROPE[(size_t)tok * 32 + k] = cs; ROPE[(size_t)tok * 32 + 16 + k] = sn; }
        for (int i = gtid; i < 16 * 128 * 128; i += NGT) { const int jj = i & 127, ii = (i >> 7) & 127; WSP[i] = (bf16)(jj <= ii ? f2bf(w_spatial[i]) : 0u); }
        if (BOTH(0)) GRID_BAR();
    }
    if (IN(1)) {
        pg8::Gemm g{H, WING, M, NPROJ, DM}; pg8::StaticOrder S; S.init(M, NPROJ, F.G, bx);
        pg8::EpiProj E{Qb, Kb, Vb, Ub, VBb, Gb, ROPE, b_gate, LNST};
        pg8::gemm_phase<pg8::EpiProj, pg8::StaticOrder, PG8_ALIGN, PG8_SP2>(F.lds + RING_OFF, g, S, E);
        if (BOTH(1)) GRID_BAR();
    }
    if (IN(2)) {
        for (int i = F.tid; i < 16 * ATT_KSTR / 4; i += NWAVES * 64) ((LAS unsigned*)(F.lds + ATT_V_OFF + 256 * ATT_KSTR))[i] = 0u;
        __syncthreads();
        self_attn_stream(F, Qb, Kb, Vb, OG, LSE);
        { const int per = (2048 % F.G == 0) ? 2048 / F.G : 0;
          if (per == 1 || per == 2 || per == 4 || per == 8 || per == 16) sgu_stream(F, per, Ub, YAB, VBb, LNST, sgu_ln_g, sgu_ln_b, WSP, b_spatial);
          else for (int idx = bx; idx < 2048; idx += F.G) sgu_unit(F, idx, Ub, YAB, VBb, LNST, sgu_ln_g, sgu_ln_b, WSP, b_spatial); }
        if (BOTH(2)) GRID_BAR();
    }
    if (IN(3)) {
        for (int i = gtid; i < M * 8 * 16; i += NGT) { const int ch = i & 15, hh = (i >> 4) & 7; const size_t tok = (size_t)(i >> 7);
            const float l0 = LSE[tok * 8 + hh], l1 = LSE[((size_t)M + tok) * 8 + hh], l2 = LSE[((size_t)2 * M + tok) * 8 + hh];
            const float mx = fmaxf(l0, fmaxf(l1, l2)); float e0 = __expf(l0 - mx), e1 = __expf(l1 - mx), e2 = __expf(l2 - mx); const float inv = 1.0f / (e0 + e1 + e2); e0 *= inv; e1 *= inv; e2 *= inv;
            const size_t o = tok * AW + hh * 128 + ch * 8;
            const v4u a = *(const GAS v4u*)(OG + o), b = *(const GAS v4u*)(OG + (size_t)M * AW + o), c = *(const GAS v4u*)(OG + (size_t)2 * M * AW + o); v4u y;
            y.x = pk2(e0 * bflo(a.x) + e1 * bflo(b.x) + e2 * bflo(c.x), e0 * bfhi(a.x) + e1 * bfhi(b.x) + e2 * bfhi(c.x));
            y.y = pk2(e0 * bflo(a.y) + e1 * bflo(b.y) + e2 * bflo(c.y), e0 * bfhi(a.y) + e1 * bfhi(b.y) + e2 * bfhi(c.y));
            y.z = pk2(e0 * bflo(a.z) + e1 * bflo(b.z) + e2 * bflo(c.z), e0 * bfhi(a.z) + e1 * bfhi(b.z) + e2 * bfhi(c.z));
            y.w = pk2(e0 * bflo(a.w) + e1 * bflo(b.w) + e2 * bflo(c.w), e0 * bfhi(a.w) + e1 * bfhi(b.w) + e2 * bfhi(c.w));
            *(GAS v4u*)(YAB + tok * YABW + hh * 128 + ch * 8) = y; }
        if (BOTH(3)) GRID_BAR();
    }
    if (IN(4)) {
        pg8::Gemm g{YAB, WAB, M, DM, YABW}; pg8::StaticOrder S; S.init(M, DM, F.G, bx); pg8::EpiMerge E{Gb, MRG, AW / pg8::BK};
        pg8::gemm_phase<pg8::EpiMerge, pg8::StaticOrder, PG8_ALIGN, PG8_SP2>(F.lds + RING_OFF, g, S, E);
        if (BOTH(4)) GRID_BAR();
    }
    if (IN(5)) {
        pg8::Gemm g{MRG, WOUT, M, DM, DM}; pg8::StaticOrder S; S.init(M, DM, F.G, bx); pg8::EpiNorm E{T, DM, SSQ};
        pg8::gemm_phase<pg8::EpiNorm, pg8::StaticOrder, PG8_ALIGN, PG8_SP2>(F.lds + RING_OFF, g, S, E);
        if (BOTH(5)) GRID_BAR();
    }
    if (IN(6)) {
        row_phase<false, true, true>(F, x, T, SSQ, mix_post_g, xa_pre_g, XB, H, gw, NGW);
#define P6_DECODE(r_, J) do { const int r = (r_); if (r < I_UP) J = ConvJob{w_up, WUP, DM, DFF, 0, DM, 0, r}; else J = ConvJob{w_down, WDN, DFF, DM, 0, DFF, 0, r - I_UP}; } while (0)
        __syncthreads();
        CONV_STREAM(conv_early, I_UP + I_DN, F.ctl + CW_TICKET + 64, P6_DECODE);
        if (BOTH(6)) GRID_BAR();
    }
    if (IN(7)) {
        if (bx < 128) { pg8::Gemm g{H, WXQ, M, XAW, DM}; pg8::SmallOrder S; S.init(M, XAW, 0, bx); pg8::EpiPlain E{QX, XAW};
            pg8::gemm_phase<pg8::EpiPlain, pg8::SmallOrder, false, PG8_SP2>(F.lds + RING_OFF, g, S, E); }
        else if (bx < P7_BUSY) { pg8::Gemm g{MB, WKV, MROWS, 2 * XAW, DM}; pg8::SmallOrder S; S.init(MROWS, 2 * XAW, 128, bx); pg8::EpiPlain E{KVX, 2 * XAW};
            pg8::gemm_phase<pg8::EpiPlain, pg8::SmallOrder, false, PG8_SP2>(F.lds + RING_OFF, g, S, E); }
        else { CONV_STREAM(0, conv_early, F.ctl + CW_TICKET + 128, P6_DECODE); }
#undef P6_DECODE
        if (BOTH(7)) GRID_BAR();
    }
    if (IN(8)) {
        cross_attn_stream(F, QX, KVX, OX);
        if (BOTH(8)) GRID_BAR();
    }
    if (IN(9)) {
        pg8::Gemm g{OX, WXO, M, DM, XAW}; pg8::StaticOrder S; S.init(M, DM, F.G, bx); pg8::EpiNorm E{T, DM, SSQ};
        pg8::gemm_phase<pg8::EpiNorm, pg8::StaticOrder, PG8_ALIGN, PG8_SP2>(F.lds + RING_OFF, g, S, E);
        if (BOTH(9)) GRID_BAR();
    }
    if (IN(10)) {
        row_phase<true, true, true>(F, XB, T, SSQ, xa_post_g, mlp_pre_g, XB, H, gw, NGW);
        if (BOTH(10)) GRID_BAR();
    }
    if (IN(11)) {
        pg8::Gemm g{H, WUP, M, DFF, DM}; pg8::StaticOrder S; S.init(M, DFF, F.G, bx); pg8::EpiRelu2 E{Ab, DFF};
        pg8::gemm_phase<pg8::EpiRelu2, pg8::StaticOrder, PG8_ALIGN, PG8_SP2>(F.lds + RING_OFF, g, S, E);
        if (BOTH(11)) GRID_BAR();
    }
    if (IN(12)) {
        pg8::Gemm g{Ab, WDN, M, DM, DFF}; pg8::StaticOrder S; S.init(M, DM, F.G, bx); pg8::EpiNorm E{T3, DM, SSQ};
        pg8::gemm_phase<pg8::EpiNorm, pg8::StaticOrder, PG8_ALIGN, PG8_SP2>(F.lds + RING_OFF, g, S, E);
        if (BOTH(12)) GRID_BAR();
    }
    if (IN(13)) {
        row_phase<true, false, false>(F, XB, T3, SSQ, mlp_post_g, nullptr, out, nullptr, gw, NGW);
    }
#undef IN
#undef BOTH
}

extern "C" void kernel_launch(void* const* d_in, const int* in_sizes, int n_in, void* d_out, int out_size, void* d_ws, size_t ws_size, hipStream_t stream) {
    static int grid = 0;
    if (grid == 0) {
        if (n_in != 26 || in_sizes[0] != M * DM || out_size != M * DM || ws_size < WS_END) { fprintf(stderr, "kernel_launch: unexpected shapes (n_in %d, in0 %d, out %d, ws %zu < %zu?); nothing launched\n", n_in, n_in > 0 ? in_sizes[0] : -1, out_size, ws_size, (size_t)WS_END); grid = -1; return; }
        int dev = 0, cus = 0, per_cu = 0;
        if (hipGetDevice(&dev) != hipSuccess || hipDeviceGetAttribute(&cus, hipDeviceAttributeMultiprocessorCount, dev) != hipSuccess) { grid = -1; return; }
        if (hipFuncSetAttribute((const void*)skel_fwd, hipFuncAttributeMaxDynamicSharedMemorySize, LDS_BYTES) != hipSuccess) { fprintf(stderr, "kernel_launch: hipFuncSetAttribute failed\n"); grid = -1; return; }
        if (hipOccupancyMaxActiveBlocksPerMultiprocessor(&per_cu, (const void*)skel_fwd, NWAVES * 64, LDS_BYTES) != hipSuccess || per_cu < 1)
            fprintf(stderr, "kernel_launch: note: occupancy query reports %d workgroups per CU\n", per_cu);
        (void)hipGetLastError();
        grid = cus;
    }
    if (grid < 0) return;
    if (hipMemsetAsync((char*)d_ws + WS_CTL, 0, CTL_ZERO_BYTES, stream) != hipSuccess) return;
    Args a{};
    for (int i = 0; i < 26; ++i) a.in[i] = (const float*)d_in[i];
    a.out = (float*)d_out; a.ws = (unsigned char*)d_ws;
#if MK_PER_PHASE
    for (int li = 0; li < N_PHASES; ++li) { a.ph_lo = li; a.ph_hi = li + 1; a.li = li;
        hipLaunchKernelGGL(skel_fwd, dim3(grid), dim3(NWAVES * 64), LDS_BYTES, stream, a); }
#else
#if defined(PROBE_DUP)
    a.ph_lo = 0; a.ph_hi = PROBE_DUP + 1; a.li = 0;
    hipLaunchKernelGGL(skel_fwd, dim3(grid), dim3(NWAVES * 64), LDS_BYTES, stream, a);
    a.ph_lo = PROBE_DUP; a.ph_hi = N_PHASES; a.li = 1;
    hipLaunchKernelGGL(skel_fwd, dim3(grid), dim3(NWAVES * 64), LDS_BYTES, stream, a);
#else
    a.ph_lo = 0; a.ph_hi = N_PHASES; a.li = 0;
    hipLaunchKernelGGL(skel_fwd, dim3(grid), dim3(NWAVES * 64), LDS_BYTES, stream, a);
#endif
#endif
    const hipError_t le = hipPeekAtLastError();
    if (le != hipSuccess) fprintf(stderr, "kernel_launch: launch failed: %s\n", hipGetErrorName(le));
}
```

```cpp
#include <hip/hip_runtime.h>
#ifndef MID_FENCE
#define MID_FENCE 2
#endif
#include <cstdio>
#include <cstdint>
namespace pg8 {
#define PG8_LAS __attribute__((address_space(3)))
typedef unsigned short bf16_t;
typedef short bf16x8 __attribute__((ext_vector_type(8)));
typedef float f32x4 __attribute__((ext_vector_type(4)));
typedef unsigned u32x4 __attribute__((ext_vector_type(4)));
constexpr int BM = 256, BK = 64, HALF = 128, HTB = HALF * BK * 2  , STAGE_BYTES = 8 * HTB, NXCD = 8, WGM = 8;

__host__ __device__ __forceinline__ int lds_byte(int r, int c) { const int st = (r >> 4) * 2 + (c >> 5), rr = r & 15, cc = c & 31, ob = rr * 64 + cc * 2; return st * 1024 + (ob ^ (((ob >> 9) & 1) << 5)); }
__host__ __device__ __forceinline__ void stage_rc(int b, int& R, int& C) { const int st = b / 1024, sb = b % 1024, swz = sb ^ (((sb >> 9) & 1) << 5); R = (st >> 1) * 16 + swz / 64; C = (st & 1) * 32 + (swz % 64) / 2; }
__host__ __device__ __forceinline__ int perm32(int rho) { const int n = rho >> 4, i = rho & 15; return 8 * (i >> 2) + 4 * n + (i & 3); }

struct Unit { int pm, pn; };
struct Gemm { const bf16_t* A; const bf16_t* Bt; int M, N, K; };

struct StaticOrder {
    int nM, nN, nwg, G, c;
    __host__ __device__ void init(int M, int N, int G_, int c_) { nM = M / BM; nN = N / BM; nwg = nM * nN; G = G_; c = c_; }
    __host__ __device__ bool next(int i, Unit& u) const {
        const long L = (long)i * G + c; if (L >= nwg) return false;
        int wgid = (int)L; { const int q = nwg / NXCD, r = nwg % NXCD, xcd = wgid % NXCD, off = wgid / NXCD; wgid = (xcd < r ? xcd * (q + 1) : r * (q + 1) + (xcd - r) * q) + off; }
        const int nig = WGM * nN, gid = wgid / nig, fm = gid * WGM, gsz = (nM - fm) < WGM ? (nM - fm) : WGM;
        u.pm = fm + ((wgid % nig) % gsz); u.pn = (wgid % nig) / gsz; return true;
    }
    __device__ __forceinline__ void a_ready(const Unit&) const {}
    __device__ __forceinline__ void done(const Unit&) const {}
};

__device__ __forceinline__ unsigned cvt_pk_bf16(float lo, float hi) { unsigned r; asm volatile("s_nop 0\n\tv_cvt_pk_bf16_f32 %0, %1, %2" : "=v"(r) : "v"(lo), "v"(hi)); return r; }
typedef float f32x2 __attribute__((ext_vector_type(2)));
__device__ __forceinline__ u32x4 pack8(const f32x4 a, const f32x4 b) { u32x4 w; w.x = cvt_pk_bf16(a[0], a[1]); w.y = cvt_pk_bf16(a[2], a[3]); w.z = cvt_pk_bf16(b[0], b[1]); w.w = cvt_pk_bf16(b[2], b[3]); return w; }
__device__ __forceinline__ float bf_lo(unsigned w) { return __uint_as_float(w << 16); }
__device__ __forceinline__ float bf_hi(unsigned w) { return __uint_as_float(w & 0xffff0000u); }
__device__ __forceinline__ void unpack8(const u32x4 w, f32x4& a, f32x4& b) { a = (f32x4){bf_lo(w.x), bf_hi(w.x), bf_lo(w.y), bf_hi(w.y)}; b = (f32x4){bf_lo(w.z), bf_hi(w.z), bf_lo(w.w), bf_hi(w.w)}; }
__device__ __forceinline__ float gelu_tanh(float x) { const float u = x * (0.7978845608028654f + 0.035677408136300125f * x * x);
    const float e = __builtin_amdgcn_exp2f(-2.885390081777927f * u); return x * __builtin_amdgcn_rcpf(1.0f + e); }
__device__ __forceinline__ float sigmoid_f(float z) { return __builtin_amdgcn_rcpf(1.0f + __builtin_amdgcn_exp2f(-1.4426950408889634f * z)); }
__device__ __forceinline__ f32x4 gelu4(f32x4 v) { return (f32x4){gelu_tanh(v[0]), gelu_tanh(v[1]), gelu_tanh(v[2]), gelu_tanh(v[3])}; }
__device__ __forceinline__ f32x4 sigm4(f32x4 v) { return (f32x4){sigmoid_f(v[0]), sigmoid_f(v[1]), sigmoid_f(v[2]), sigmoid_f(v[3])}; }
__device__ __forceinline__ float hsum4(f32x4 v) { return (v[0] + v[1]) + (v[2] + v[3]); }

struct EpiPlain {
    static constexpr bool PERM = true, AFTER_DRAIN = false, HAS_MID = false;
    bf16_t* O; int ldc;
    __device__ __forceinline__ void operator()(const f32x4 (&acc)[2][2][4][2], const Unit& u, int wr, int wc, int fr, int fq) const {
        const int row0 = u.pm * BM + wr * 64 + fr, col0 = u.pn * BM + wc * 32 + 8 * fq;
#pragma unroll
        for (int ai = 0; ai < 2; ++ai)
#pragma unroll
            for (int m = 0; m < 4; ++m) { bf16_t* rowp = O + (size_t)(row0 + ai * HALF + m * 16) * ldc + col0;
#pragma unroll
                for (int bj = 0; bj < 2; ++bj) *(u32x4*)(rowp + bj * HALF) = pack8(acc[ai][bj][m][0], acc[ai][bj][m][1]); }
    }
};
struct EpiRelu2 {
    static constexpr bool PERM = true, AFTER_DRAIN = false, HAS_MID = false;
    bf16_t* O; int ldc;
    __device__ __forceinline__ void operator()(const f32x4 (&acc)[2][2][4][2], const Unit& u, int wr, int wc, int fr, int fq) const {
        const int row0 = u.pm * BM + wr * 64 + fr, col0 = u.pn * BM + wc * 32 + 8 * fq;
#pragma unroll
        for (int ai = 0; ai < 2; ++ai)
#pragma unroll
            for (int m = 0; m < 4; ++m) { bf16_t* rowp = O + (size_t)(row0 + ai * HALF + m * 16) * ldc + col0;
#pragma unroll
                for (int bj = 0; bj < 2; ++bj) { f32x4 v0 = acc[ai][bj][m][0], v1 = acc[ai][bj][m][1];
                    v0 = __builtin_elementwise_max(v0, (f32x4){0.f, 0.f, 0.f, 0.f}); v1 = __builtin_elementwise_max(v1, (f32x4){0.f, 0.f, 0.f, 0.f});
                    *(u32x4*)(rowp + bj * HALF) = pack8(v0 * v0, v1 * v1); } }
    }
};
struct EpiNorm {
    static constexpr bool PERM = true, AFTER_DRAIN = false, HAS_MID = false;
    bf16_t* O; int ldc; float* ssq;
    __device__ __forceinline__ void operator()(const f32x4 (&acc)[2][2][4][2], const Unit& u, int wr, int wc, int fr, int fq) const {
        const int row0 = u.pm * BM + wr * 64 + fr, col0 = u.pn * BM + wc * 32 + 8 * fq;
#pragma unroll
        for (int ai = 0; ai < 2; ++ai)
#pragma unroll
            for (int m = 0; m < 4; ++m) { const int row = row0 + ai * HALF + m * 16; bf16_t* rowp = O + (size_t)row * ldc + col0; float q = 0.f;
#pragma unroll
                for (int bj = 0; bj < 2; ++bj) { const f32x4 v0 = acc[ai][bj][m][0], v1 = acc[ai][bj][m][1]; q += hsum4(v0 * v0) + hsum4(v1 * v1);
                    *(u32x4*)(rowp + bj * HALF) = pack8(v0, v1); }
                q += __shfl_xor(q, 16); q += __shfl_xor(q, 32);
                if (fq == 0) ssq[(size_t)row * 64 + u.pn * 4 + wc] = q; }
    }
};
__device__ __forceinline__ unsigned gq4(const f32x4 g) { unsigned r = 0u; r = __builtin_amdgcn_cvt_pk_u8_f32(g[0] * 256.f - 0.5f, 0, r); r = __builtin_amdgcn_cvt_pk_u8_f32(g[1] * 256.f - 0.5f, 1, r);
    r = __builtin_amdgcn_cvt_pk_u8_f32(g[2] * 256.f - 0.5f, 2, r); r = __builtin_amdgcn_cvt_pk_u8_f32(g[3] * 256.f - 0.5f, 3, r); return r; }
__device__ __forceinline__ f32x4 gdq4(const unsigned w) { return (f32x4){((float)(w & 0xffu) + 0.5f) * (1.f / 256.f), ((float)((w >> 8) & 0xffu) + 0.5f) * (1.f / 256.f), ((float)((w >> 16) & 0xffu) + 0.5f) * (1.f / 256.f), ((float)(w >> 24) + 0.5f) * (1.f / 256.f)}; }
typedef unsigned u32x2 __attribute__((ext_vector_type(2)));
constexpr size_t GFRAG_TILE = 65536;
__device__ __forceinline__ size_t gfrag_off(int pm, int gt, int wave, int lane) { return ((size_t)(pm * 32 + gt) * 8 + wave) * 8192 + (size_t)lane * 8; }
struct EpiMerge {
    static constexpr bool PERM = true, AFTER_DRAIN = false, HAS_MID = true;
    const unsigned char* G; bf16_t* MG; int tmid;
    __device__ __forceinline__ void mid(f32x4 (&acc)[2][2][4][2], const Unit& u, int wr, int wc, int fr, int fq) const {
        size_t off0 = gfrag_off(u.pm, u.pn, wr * 4 + wc, fq * 16 + fr); asm volatile("" : "+v"(off0));
#pragma unroll
        for (int ai = 0; ai < 2; ++ai)
#pragma unroll
            for (int m = 0; m < 4; ++m) { const unsigned char* gp = G + off0 + (size_t)((ai * 4 + m) * 2) * 512;
#pragma unroll
                for (int bj = 0; bj < 2; ++bj) { const u32x2 wa = *(const u32x2*)(gp + bj * 512), wb = *(const u32x2*)(gp + (size_t)16 * GFRAG_TILE + bj * 512);
                    f32x4 a0 = gdq4(wa.x), a1 = gdq4(wa.y); const f32x4 b0 = gdq4(wb.x), b1 = gdq4(wb.y);
#pragma unroll
                    for (int e = 0; e < 4; ++e) { a0[e] *= __builtin_amdgcn_rcpf(b0[e]); a1[e] *= __builtin_amdgcn_rcpf(b1[e]); }
                    acc[ai][bj][m][0] *= a0; acc[ai][bj][m][1] *= a1; }
                if ((m & (MID_FENCE - 1)) == MID_FENCE - 1) asm volatile("" ::: "memory"); }
    }
    __device__ __forceinline__ void operator()(const f32x4 (&acc)[2][2][4][2], const Unit& u, int wr, int wc, int fr, int fq) const {
        const int row0 = u.pm * BM + wr * 64 + fr, col0 = u.pn * BM + wc * 32 + 8 * fq;
        const unsigned char* gb = G + gfrag_off(u.pm, u.pn + 16, wr * 4 + wc, fq * 16 + fr);
#pragma unroll
        for (int ai = 0; ai < 2; ++ai)
#pragma unroll
            for (int m = 0; m < 4; ++m) { const size_t row = (size_t)(row0 + ai * HALF + m * 16);
#pragma unroll
                for (int bj = 0; bj < 2; ++bj) { const u32x2 wb = *(const u32x2*)(gb + (size_t)((ai * 4 + m) * 2 + bj) * 512); const f32x4 b0 = gdq4(wb.x), b1 = gdq4(wb.y);
                    *(u32x4*)(MG + row * 4096 + col0 + bj * HALF) = pack8(acc[ai][bj][m][0] * b0, acc[ai][bj][m][1] * b1); } }
    }
};
struct EpiProj {
    static constexpr bool PERM = true, AFTER_DRAIN = false, HAS_MID = false;
    bf16_t *Q, *K, *V, *U, *VB; unsigned char* G; const float* rope; const float* bgate; float* lnstat;
    __device__ __forceinline__ void operator()(const f32x4 (&acc)[2][2][4][2], const Unit& u, int wr, int wc, int fr, int fq) const {
        const int pn = u.pn, row0 = u.pm * BM + wr * 64 + fr, lc0 = wc * 32 + 8 * fq;
        if (pn < 24) {
            bf16_t* base = pn < 12 ? Q : K; const int colt = (pn < 12 ? pn : pn - 12) * BM + lc0; const float sgn = (fq & 2) ? 1.f : -1.f;
#pragma unroll
            for (int ai = 0; ai < 2; ++ai)
#pragma unroll
                for (int m = 0; m < 4; ++m) { const size_t row = (size_t)(row0 + ai * HALF + m * 16); bf16_t* rowp = base + row * 3072 + colt;
                    f32x4 c0 = {0.f, 0.f, 0.f, 0.f}, c1 = c0, s0 = c0, s1 = c0;
                    if (wc == 0) { const float* rp = rope + row * 32 + 8 * (fq & 1); c0 = *(const f32x4*)rp; c1 = *(const f32x4*)(rp + 4); s0 = *(const f32x4*)(rp + 16); s1 = *(const f32x4*)(rp + 20); }
#pragma unroll
                    for (int bj = 0; bj < 2; ++bj) { f32x4 v0 = acc[ai][bj][m][0], v1 = acc[ai][bj][m][1];
                        if (wc == 0) { f32x4 p0, p1;
#pragma unroll
                            for (int e = 0; e < 4; ++e) { p0[e] = __shfl_xor(v0[e], 32); p1[e] = __shfl_xor(v1[e], 32); }
                            v0 = v0 * c0 + (p0 * s0) * sgn; v1 = v1 * c1 + (p1 * s1) * sgn; }
                        *(u32x4*)(rowp + bj * HALF) = pack8(v0, v1); } }
        } else if (pn < 36) {
            const int colt = (pn - 24) * BM + lc0;
#pragma unroll
            for (int ai = 0; ai < 2; ++ai)
#pragma unroll
                for (int m = 0; m < 4; ++m) { bf16_t* rowp = V + (size_t)(row0 + ai * HALF + m * 16) * 3072 + colt;
#pragma unroll
                    for (int bj = 0; bj < 2; ++bj) *(u32x4*)(rowp + bj * HALF) = pack8(acc[ai][bj][m][0], acc[ai][bj][m][1]); }
        } else if (pn < 44) {
            const int colt = (pn - 36) * BM + lc0;
#pragma unroll
            for (int ai = 0; ai < 2; ++ai)
#pragma unroll
                for (int m = 0; m < 4; ++m) { bf16_t* rowp = U + (size_t)(row0 + ai * HALF + m * 16) * 2048 + colt;
#pragma unroll
                    for (int bj = 0; bj < 2; ++bj) *(u32x4*)(rowp + bj * HALF) = pack8(gelu4(acc[ai][bj][m][0]), gelu4(acc[ai][bj][m][1])); }
        } else if (pn < 52) {
            const int colt = (pn - 44) * BM + lc0;
#pragma unroll
            for (int ai = 0; ai < 2; ++ai)
#pragma unroll
                for (int m = 0; m < 4; ++m) { const size_t row = (size_t)(row0 + ai * HALF + m * 16); bf16_t* rowp = VB + row * 2048 + colt; float s = 0.f, q = 0.f;
#pragma unroll
                    for (int bj = 0; bj < 2; ++bj) { const f32x4 v0 = gelu4(acc[ai][bj][m][0]), v1 = gelu4(acc[ai][bj][m][1]);
                        s += hsum4(v0) + hsum4(v1); q += hsum4(v0 * v0) + hsum4(v1 * v1); *(u32x4*)(rowp + bj * HALF) = pack8(v0, v1); }
                    s += __shfl_xor(s, 16); s += __shfl_xor(s, 32); q += __shfl_xor(q, 16); q += __shfl_xor(q, 32);
                    if (fq == 0) *(f32x2*)(lnstat + (row * 32 + (pn - 44) * 4 + wc) * 2) = (f32x2){s, q}; }
        } else {
            const int colt = (pn - 52) * BM + lc0;
            f32x4 bv[2][2];
#pragma unroll
            for (int bj = 0; bj < 2; ++bj) { bv[bj][0] = *(const f32x4*)(bgate + colt + bj * HALF); bv[bj][1] = *(const f32x4*)(bgate + colt + bj * HALF + 4); }
            unsigned char* gbase = G + gfrag_off(u.pm, pn - 52, wr * 4 + wc, fq * 16 + fr);
#pragma unroll
            for (int ai = 0; ai < 2; ++ai)
#pragma unroll
                for (int m = 0; m < 4; ++m) { unsigned char* gp = gbase + (size_t)((ai * 4 + m) * 2) * 512;
#pragma unroll
                    for (int bj = 0; bj < 2; ++bj) { u32x2 w; w.x = gq4(sigm4(acc[ai][bj][m][0] + bv[bj][0])); w.y = gq4(sigm4(acc[ai][bj][m][1] + bv[bj][1])); *(u32x2*)(gp + bj * 512) = w; } }
        }
    }
};
struct SmallOrder {
    int nN, nwg, c;
    __device__ void init(int M, int N, int first, int bx) { nN = N / BM; nwg = (M / BM) * nN; c = bx - first; }
    __device__ bool next(int i, Unit& u) const { if (i != 0 || c < 0 || c >= nwg) return false; u.pm = c / nN; u.pn = c % nN; return true; }
    __device__ __forceinline__ void a_ready(const Unit&) const {}
    __device__ __forceinline__ void done(const Unit&) const {}
};
template <class Epi, class Sched, bool ALIGN_EPI = false, bool SP2 = false>
__device__ __forceinline__ void gemm_phase(PG8_LAS unsigned char* lds, const Gemm g, const Sched& S, const Epi& E) {
    const int tid = threadIdx.x, wid = __builtin_amdgcn_readfirstlane(tid >> 6), lane = tid & 63, wr = wid >> 2, wc = wid & 3, fr = lane & 15, fq = lane >> 4;
    const int K = g.K, nt = K / BK;
    unsigned voffA[2], voffB[2];
#pragma unroll
    for (int i = 0; i < 2; ++i) { int R, C; stage_rc(tid * 16 + i * 8192, R, C); const int Rb = Epi::PERM ? ((R & ~31) + perm32(R & 31)) : R;
        voffA[i] = (unsigned)(R * K + C) * 2u; voffB[i] = (unsigned)(Rb * K + C) * 2u; }
    const size_t kstep = (size_t)(BK * 2);
    const size_t hstep = (size_t)HALF * K * 2;
    const size_t tstep = 2 * hstep;
    const unsigned ldsw = (unsigned)wid * 1024u;
    const int aoff = lds_byte(wr * 64 + fr, fq * 8), boff = lds_byte(wc * 32 + fr, fq * 8);
#define PG8_SA(b, h) (((b) * 2 + (h)) * HTB)
#define PG8_SB(b, h) ((4 + (b) * 2 + (h)) * HTB)
#define PG8_STAGE(bufoff, gbase, voff) do { _Pragma("unroll") for (int _i = 0; _i < 2; ++_i) \
        __builtin_amdgcn_global_load_lds((const unsigned*)((const char*)(gbase) + (voff)[_i]), (PG8_LAS unsigned*)(lds + (bufoff) + ldsw + _i * 8192), 16, 0, 0); } while (0)
#define PG8_LDA(dst, b, h) do { _Pragma("unroll") for (int m = 0; m < 4; ++m) _Pragma("unroll") for (int k = 0; k < 2; ++k) dst[m][k] = *(const PG8_LAS bf16x8*)(lds + PG8_SA(b, h) + aoff + m * 2048 + k * 1024); } while (0)
#define PG8_LDB(dst, b, h) do { _Pragma("unroll") for (int n = 0; n < 2; ++n) _Pragma("unroll") for (int k = 0; k < 2; ++k) dst[n][k] = *(const PG8_LAS bf16x8*)(lds + PG8_SB(b, h) + boff + n * 2048 + k * 1024); } while (0)
#define PG8_MMA(ai, bj, At, Bt) do { __builtin_amdgcn_s_setprio(1); _Pragma("unroll") for (int m = 0; m < 4; ++m) _Pragma("unroll") for (int n = 0; n < 2; ++n) _Pragma("unroll") for (int k = 0; k < 2; ++k) \
        acc[ai][bj][m][n] = __builtin_amdgcn_mfma_f32_16x16x32_bf16(Bt[n][k], At[m][k], acc[ai][bj][m][n], 0, 0, 0); __builtin_amdgcn_s_setprio(0); } while (0)
#define PG8_WAIT_V(n) asm volatile("s_waitcnt vmcnt(" #n ")" ::: "memory")
#define PG8_WAIT_L(n) asm volatile("s_waitcnt lgkmcnt(" #n ")" ::: "memory")
#define PG8_BAR __builtin_amdgcn_s_barrier()
#define PG8_SCHED __builtin_amdgcn_sched_barrier(0)
    Unit cur, nxt; int ui = 0;
    if (!S.next(0, cur)) return;
    f32x4 acc[2][2][4][2];
#pragma unroll
    for (int a = 0; a < 2; ++a)
#pragma unroll
        for (int b = 0; b < 2; ++b)
#pragma unroll
            for (int m = 0; m < 4; ++m)
#pragma unroll
                for (int n = 0; n < 2; ++n) acc[a][b][m][n] = (f32x4){0.f, 0.f, 0.f, 0.f};
    bf16x8 At[4][2], B0[2][2], B1[2][2];
    const char* cA = (const char*)g.A + (size_t)cur.pm * tstep; const char* cB = (const char*)g.Bt + (size_t)cur.pn * tstep;
    S.a_ready(cur);
    if constexpr (SP2) {
        PG8_STAGE(PG8_SB(0, 0), cB, voffB); PG8_STAGE(PG8_SB(0, 1), cB + hstep, voffB); PG8_STAGE(PG8_SA(0, 0), cA, voffA); PG8_STAGE(PG8_SA(0, 1), cA + hstep, voffA);
        if (wr == 1) PG8_BAR;
        PG8_WAIT_V(2); PG8_BAR;
        PG8_STAGE(PG8_SB(1, 0), cB + kstep, voffB); PG8_STAGE(PG8_SA(1, 0), cA + kstep, voffA); PG8_STAGE(PG8_SB(1, 1), cB + hstep + kstep, voffB);
        PG8_WAIT_V(6); PG8_BAR;
    } else {
        PG8_STAGE(PG8_SB(0, 0), cB, voffB); PG8_STAGE(PG8_SA(0, 0), cA, voffA); PG8_STAGE(PG8_SB(0, 1), cB + hstep, voffB); PG8_STAGE(PG8_SA(0, 1), cA + hstep, voffA);
        if (wr == 1) PG8_BAR;
        PG8_WAIT_V(4); PG8_BAR;
        PG8_STAGE(PG8_SB(1, 0), cB + kstep, voffB); PG8_STAGE(PG8_SA(1, 0), cA + kstep, voffA); PG8_STAGE(PG8_SB(1, 1), cB + hstep + kstep, voffB);
        PG8_WAIT_V(6); PG8_BAR;
    }
    for (;;) {
        const bool has_next = S.next(ui + 1, nxt);
        const char* nA = has_next ? (const char*)g.A + (size_t)nxt.pm * tstep : cA; const char* nB = has_next ? (const char*)g.Bt + (size_t)nxt.pn * tstep : cB;
#define PG8_KITER(t) do { \
            const bool last = ((t) == nt - 2); \
            const char* a1 = cA + (size_t)((t) + 1) * kstep; \
            const char* a2 = last ? nA : cA + (size_t)((t) + 2) * kstep; const char* b2 = last ? nB : cB + (size_t)((t) + 2) * kstep; \
            const char* a3 = a2 + kstep; const char* b3 = b2 + kstep; \
            if (last && has_next) S.a_ready(nxt); \
            PG8_LDB(B0, 0, 0); PG8_LDB(B1, 0, 1); PG8_SCHED; PG8_LDA(At, 0, 0); PG8_STAGE(PG8_SA(1, 1), a1 + hstep, voffA); \
            PG8_WAIT_V(8); PG8_WAIT_L(0); PG8_BAR; PG8_MMA(0, 0, At, B0); PG8_MMA(0, 1, At, B1); PG8_BAR; PG8_SCHED; \
            PG8_LDA(At, 0, 1); PG8_STAGE(PG8_SB(0, 0), b2, voffB); PG8_STAGE(PG8_SB(0, 1), b2 + hstep, voffB); PG8_STAGE(PG8_SA(0, 0), a2, voffA); \
            PG8_WAIT_V(8); PG8_WAIT_L(0); PG8_BAR; PG8_MMA(1, 0, At, B0); PG8_MMA(1, 1, At, B1); PG8_BAR; PG8_SCHED; \
            PG8_LDB(B0, 1, 0); PG8_LDB(B1, 1, 1); PG8_SCHED; PG8_LDA(At, 1, 0); PG8_STAGE(PG8_SA(0, 1), a2 + hstep, voffA); \
            PG8_WAIT_V(8); PG8_WAIT_L(0); PG8_BAR; PG8_MMA(0, 0, At, B0); PG8_MMA(0, 1, At, B1); PG8_BAR; PG8_SCHED; \
            PG8_LDA(At, 1, 1); PG8_STAGE(PG8_SB(1, 0), b3, voffB); PG8_STAGE(PG8_SB(1, 1), b3 + hstep, voffB); PG8_STAGE(PG8_SA(1, 0), a3, voffA); \
            PG8_WAIT_V(8); PG8_WAIT_L(0); PG8_BAR; PG8_MMA(1, 0, At, B0); PG8_MMA(1, 1, At, B1); PG8_BAR; PG8_SCHED; \
        } while (0)
        static_assert(SP2, "this copy of the body keeps only the two-super-phase K-loop");
        if constexpr (Epi::HAS_MID) {
            const int tm = E.tmid;
            for (int t = 0; t < tm; t += 2) PG8_KITER(t);
            E.mid(acc, cur, wr, wc, fr, fq);
            for (int t = tm; t < nt; t += 2) PG8_KITER(t);
        } else {
            for (int t = 0; t < nt; t += 2) PG8_KITER(t);
        }
#undef PG8_KITER
        if constexpr (ALIGN_EPI) { if (wr == 0) PG8_BAR; }
        if constexpr (!Epi::AFTER_DRAIN) { E(acc, cur, wr, wc, fr, fq); S.done(cur); }
        if (!has_next) break;
#pragma unroll
        for (int a = 0; a < 2; ++a)
#pragma unroll
            for (int b = 0; b < 2; ++b)
#pragma unroll
                for (int m = 0; m < 4; ++m)
#pragma unroll
                    for (int n = 0; n < 2; ++n) acc[a][b][m][n] = (f32x4){0.f, 0.f, 0.f, 0.f};
        cur = nxt; cA = nA; cB = nB; ++ui;
        if constexpr (ALIGN_EPI) { if (wr == 1) PG8_BAR; }
    }
    PG8_WAIT_V(0);
    if constexpr (!ALIGN_EPI) { if (wr == 0) PG8_BAR; }
    PG8_BAR;
    if constexpr (Epi::AFTER_DRAIN) { E.fused(acc, cur, wr, wc, fr, fq, lds, wid, lane); S.done(cur); }
#undef PG8_SA
#undef PG8_SB
#undef PG8_STAGE
#undef PG8_LDA
#undef PG8_LDB
#undef PG8_MMA
#undef PG8_WAIT_V
#undef PG8_WAIT_L
#undef PG8_BAR
#undef PG8_SCHED
}
}
#ifndef PG8_SP2
#define PG8_SP2 true
#endif
#ifndef PG8_ALIGN
#define PG8_ALIGN true
#endif
constexpr int NWAVES = 8;
#ifndef MK_PER_PHASE
#define MK_PER_PHASE 0
#endif
constexpr int N_PHASES = 14;

constexpr int BATCH = 4, SEQ = 4096, DM = 4096, M = BATCH * SEQ;
constexpr int AW = 1024, QKVW = 3072, SGW = 2048, INW = 13312, GW = 8192, NPROJ = INW + GW;
constexpr int XAW = 512, NMEM = 256, MROWS = BATCH * NMEM, DFF = 16384;
constexpr float EPS = 1e-6f;

constexpr size_t MiB = 1u << 20;
constexpr size_t WS_CTL = 0, CTL_ZERO_BYTES = 1 * MiB;
constexpr size_t WS_ROPE = 1 * MiB;
constexpr size_t WS_LNST = 3 * MiB;
constexpr size_t WS_SSQ = 7 * MiB;
constexpr size_t WS_LSE = 11 * MiB;
constexpr size_t WS_WSP = 13 * MiB;
constexpr size_t WS_WING = 16 * MiB;
constexpr size_t WS_WA = 184 * MiB;
constexpr size_t WS_WOUT = 208 * MiB;
constexpr size_t WS_WXQ = 240 * MiB;
constexpr size_t WS_WKV = 244 * MiB;
constexpr size_t WS_WXO = 252 * MiB;
constexpr size_t WS_H = 256 * MiB;
constexpr size_t WS_Q = 384 * MiB, WS_K = 480 * MiB, WS_V = 576 * MiB;
constexpr size_t WS_U = 672 * MiB, WS_VB = 736 * MiB;
constexpr size_t WS_G = 800 * MiB;
constexpr size_t WS_MRG = 1056 * MiB;
constexpr size_t WS_OG = 1056 * MiB;
constexpr size_t WS_KVX = 1216 * MiB;
constexpr size_t WS_MB = 1218 * MiB;
constexpr size_t WS_T = 384 * MiB;
constexpr size_t WS_QX = 512 * MiB, WS_OX = 528 * MiB;
constexpr size_t WS_A = 384 * MiB;
constexpr size_t WS_WUP = 896 * MiB;
constexpr size_t WS_WDN = 1024 * MiB;
constexpr size_t WS_YAB = 16 * MiB;
constexpr size_t WS_T3 = 256 * MiB;
constexpr size_t WS_XB = 16 * MiB;
constexpr size_t WS_END = 1226 * MiB;
constexpr int CW_TMO = 0, CW_CODE = 1, CW_BAR = 4096, CW_TICKET = 16384;

constexpr int RING_OFF = 0, RING_BYTES = 131072;
constexpr int ATT_KSTR = 272;
constexpr int ATT_K_OFF = 0, ATT_V_OFF = 256 * ATT_KSTR, ATT_END = ATT_V_OFF + 272 * ATT_KSTR;
constexpr int MISC_OFF = 144384, LDS_BYTES = 147456;
static_assert(ATT_END <= MISC_OFF && MISC_OFF + 128 <= LDS_BYTES, "LDS map");

#define GAS __attribute__((address_space(1)))
#define LAS __attribute__((address_space(3)))
typedef unsigned short bf16;
typedef unsigned v4u __attribute__((ext_vector_type(4)));
typedef unsigned v2u __attribute__((ext_vector_type(2)));
typedef float f32x4 __attribute__((ext_vector_type(4)));
typedef float f32x2 __attribute__((ext_vector_type(2)));
typedef short bf16x8 __attribute__((ext_vector_type(8)));
typedef short s16x4 __attribute__((ext_vector_type(4)));
typedef GAS unsigned gu32;
#define RLX_AGENT __ATOMIC_RELAXED, __HIP_MEMORY_SCOPE_AGENT
#define LDS_WAIT() asm volatile("s_waitcnt lgkmcnt(0)" ::: "memory")
#define VM_WAIT() asm volatile("s_waitcnt vmcnt(0)" ::: "memory")
__device__ __forceinline__ unsigned f2bf(float f) { unsigned u = __builtin_bit_cast(unsigned, f); return (u + 0x7fffu + ((u >> 16) & 1u)) >> 16; }
__device__ __forceinline__ unsigned pk2(float lo, float hi) { return f2bf(lo) | (f2bf(hi) << 16); }
__device__ __forceinline__ float bflo(unsigned w) { return __uint_as_float(w << 16); }
__device__ __forceinline__ float bfhi(unsigned w) { return __uint_as_float(w & 0xffff0000u); }

#define XB_TMO      128
#define XB_XCNT(j)  (256  + 64 * (j))
#define XB_XSUB(j)  (1280 + 64 * (j))
#define XB_XGEN(j)  (2304 + 64 * (j))
#define XB_TOP      3328
#define XB_TOPGEN   3392
#define XCD_BAR_WORDS 3456
#define XB_SPIN_CAP (1u << 18)

__device__ __forceinline__ unsigned xb_ld(unsigned* p)              { return __hip_atomic_load(p, __ATOMIC_RELAXED, __HIP_MEMORY_SCOPE_AGENT); }
__device__ __forceinline__ unsigned xb_add(unsigned* p, unsigned v) { return __hip_atomic_fetch_add(p, v, __ATOMIC_RELAXED, __HIP_MEMORY_SCOPE_AGENT); }
__device__ __forceinline__ unsigned xb_xcc_id() { return (unsigned)__builtin_amdgcn_s_getreg((3 << 11) | 20) & 0xFu; }
#define XB_SPIN(cond, bar) do { unsigned _sp = 0; while (cond) { __builtin_amdgcn_s_sleep(1); \
    if ((++_sp & 255u) == 0u) { if (xb_ld(&(bar)[XB_TMO])) break; if (_sp > XB_SPIN_CAP) { atomicAdd(&(bar)[XB_TMO], 1u); break; } } } } while (0)

struct XcdBarrier {
    unsigned* bar; unsigned x;
    volatile LAS unsigned* st;
};

__device__ __forceinline__ XcdBarrier xcd_barrier_post(unsigned* bar, volatile LAS unsigned* st) {
    XcdBarrier b; b.bar = bar; b.x = xb_xcc_id(); b.st = st;
    if (threadIdx.x == 0) (void)xb_add(&bar[XB_XCNT(b.x)], 1u);
    return b;
}
__device__ __forceinline__ void xcd_barrier_complete(unsigned* bar, unsigned x, unsigned& nloc, unsigned& nx) {
    const unsigned G = gridDim.x * gridDim.y * gridDim.z;
    unsigned sum, cnt, mine, sp = 0u;
    for (;;) {
        sum = 0u; cnt = 0u; mine = 0u;
#pragma unroll
        for (unsigned j = 0; j < 16; ++j) { const unsigned c = xb_ld(&bar[XB_XCNT(j)]); sum += c; cnt += (c > 0u) ? 1u : 0u; mine = (j == x) ? c : mine; }
        if (sum == G) break;
        __builtin_amdgcn_s_sleep(1);
        if ((++sp & 255u) == 0u) { if (xb_ld(&bar[XB_TMO])) break; if (sp > XB_SPIN_CAP) { atomicAdd(&bar[XB_TMO], 1u); break; } }
    }
    nloc = mine > 0u ? mine : 1u; nx = cnt > 0u ? cnt : 1u;
}

__device__ __forceinline__ void xcd_barrier(const XcdBarrier& b) {
    asm volatile("s_waitcnt vmcnt(0)" ::: "memory");
    __syncthreads();
    if (threadIdx.x == 0) {
        unsigned* bar = b.bar;
        __builtin_amdgcn_s_waitcnt(0);
        unsigned nloc = b.st[0], nx = b.st[1];
        if (nloc == 0u) { xcd_barrier_complete(bar, b.x, nloc, nx); b.st[0] = nloc; b.st[1] = nx; }
        const unsigned old = xb_add(&bar[XB_XSUB(b.x)], 1u);
        const unsigned gen = old / nloc;
        if (old + 1u == (gen + 1u) * nloc) {
            __builtin_amdgcn_fence(__ATOMIC_RELEASE, "agent");
            asm volatile("s_waitcnt vmcnt(0)" ::: "memory");
            const unsigned og = xb_add(&bar[XB_TOP], 1u);
            const unsigned tg = og / nx;
            if (og + 1u == (tg + 1u) * nx) xb_add(&bar[XB_TOPGEN], 1u);
            else XB_SPIN(xb_ld(&bar[XB_TOPGEN]) == tg, bar);
            __builtin_amdgcn_fence(__ATOMIC_ACQUIRE, "agent");
            xb_add(&bar[XB_XGEN(b.x)], 1u);
            asm volatile("s_waitcnt vmcnt(0)" ::: "memory");
        } else {
            XB_SPIN(xb_ld(&bar[XB_XGEN(b.x)]) == gen, bar);
            __builtin_amdgcn_fence(__ATOMIC_ACQUIRE, "agent");
            asm volatile("s_waitcnt vmcnt(0)" ::: "memory");
        }
    }
    __syncthreads();
}

struct Frame {
    LAS unsigned char* lds;
    volatile LAS unsigned* MISC;
    gu32* ctl;
    int tid, lane, wave;
    int vcu, G;
    unsigned char* ws;
};
__device__ __forceinline__ float wave_sum(float v) {
#pragma unroll
    for (int o = 1; o < 64; o <<= 1) v += __shfl_xor(v, o);
    return v;
}
__device__ __forceinline__ void p0_transpose_item(const float* W, int K, int N, bf16* WT, int row_off, LAS float* scr, int item, int lane, int ldk = 0, int koff = 0) {
    if (ldk == 0) ldk = K;
    const int nblk = N / 32, kb = item / nblk, nb = item % nblk, k0 = 64 * kb, n0 = 32 * nb;
#pragma unroll 8
    for (int i = 0; i < 32; ++i) { const int kk = 2 * i + (lane >> 5); scr[kk * 33 + (lane & 31)] = W[(size_t)(k0 + kk) * N + n0 + (lane & 31)]; }
    LDS_WAIT(); asm volatile("" ::: "memory");
    const int c = lane & 7;
#pragma unroll
    for (int j = 0; j < 4; ++j) { const int n = (lane >> 3) + 8 * j; const LAS float* s = scr + (8 * c) * 33 + n;
        v4u o; o.x = pk2(s[0 * 33], s[1 * 33]); o.y = pk2(s[2 * 33], s[3 * 33]); o.z = pk2(s[4 * 33], s[5 * 33]); o.w = pk2(s[6 * 33], s[7 * 33]);
        *(GAS v4u*)(WT + (size_t)(row_off + n0 + n) * ldk + koff + k0 + 8 * c) = o; }
    LDS_WAIT(); asm volatile("" ::: "memory");
}
__device__ __forceinline__ void rms_row_to_bf16(const float* xrow, const float* g, bf16* orow, int lane) {
    const GAS f32x4* xr = (const GAS f32x4*)xrow + lane; const GAS f32x4* gr = (const GAS f32x4*)g + lane;
    f32x4 v[16]; float s = 0.f;
#pragma unroll
    for (int j = 0; j < 16; ++j) { v[j] = xr[64 * j]; s += (v[j].x * v[j].x + v[j].y * v[j].y) + (v[j].z * v[j].z + v[j].w * v[j].w); }
    const float r = 1.0f / sqrtf(wave_sum(s) * (1.f / 4096.f) + EPS);
    GAS v2u* o8 = (GAS v2u*)orow + lane;
#pragma unroll
    for (int j = 0; j < 16; ++j) { const f32x4 gg = gr[64 * j]; v2u o; o.x = pk2(v[j].x * r * gg.x, v[j].y * r * gg.y); o.y = pk2(v[j].z * r * gg.z, v[j].w * r * gg.w); o8[64 * j] = o; }
}
template <bool XIB, bool XOB>
__device__ __forceinline__ void row_norm_res(const void* xin, const bf16* trow, const float* ssq, const float* gpost, const float* gpre, void* xout, bf16* hout, int lane) {
    const float r1 = 1.0f / sqrtf(wave_sum(ssq[lane]) * (1.f / 4096.f) + EPS);
    const GAS v2u* tr = (const GAS v2u*)trow + lane; const GAS f32x4* gp = (const GAS f32x4*)gpost + lane;
    f32x4 v[16]; float s = 0.f;
#pragma unroll
    for (int j = 0; j < 16; ++j) { f32x4 xv;
        if (XIB) { const v2u xw = ((const GAS v2u*)xin + lane)[64 * j]; xv = (f32x4){bflo(xw.x), bfhi(xw.x), bflo(xw.y), bfhi(xw.y)}; } else xv = ((const GAS f32x4*)xin + lane)[64 * j];
        const v2u tw = tr[64 * j]; const f32x4 gg = gp[64 * j];
        f32x4 o; o.x = xv.x + bflo(tw.x) * r1 * gg.x; o.y = xv.y + bfhi(tw.x) * r1 * gg.y; o.z = xv.z + bflo(tw.y) * r1 * gg.z; o.w = xv.w + bfhi(tw.y) * r1 * gg.w;
        v[j] = o; s += (o.x * o.x + o.y * o.y) + (o.z * o.z + o.w * o.w);
        if (XOB) { v2u ow; ow.x = pk2(o.x, o.y); ow.y = pk2(o.z, o.w); ((GAS v2u*)xout + lane)[64 * j] = ow; } else ((GAS f32x4*)xout + lane)[64 * j] = o; }
    if (hout) {
        const float r2 = 1.0f / sqrtf(wave_sum(s) * (1.f / 4096.f) + EPS);
        const GAS f32x4* gq = (const GAS f32x4*)gpre + lane; GAS v2u* o8 = (GAS v2u*)hout + lane;
#pragma unroll
        for (int j = 0; j < 16; ++j) { const f32x4 gg = gq[64 * j]; v2u o; o.x = pk2(v[j].x * r2 * gg.x, v[j].y * r2 * gg.y); o.y = pk2(v[j].z * r2 * gg.z, v[j].w * r2 * gg.w); o8[64 * j] = o; }
    }
}
__device__ __forceinline__ unsigned cvt2(float lo, float hi) { typedef float f2_t __attribute__((ext_vector_type(2))); typedef __bf16 b2_t __attribute__((ext_vector_type(2))); const f2_t v = {lo, hi}; return __builtin_bit_cast(unsigned, __builtin_convertvector(v, b2_t)); }
template <bool XIB, bool XOB, bool HOUT>
__device__ __forceinline__ void row_phase(Frame& F, const void* xin, const bf16* T, const float* SSQ, const float* gpost, const float* gpre, void* xout, bf16* H, int gw, int NGW) {
    LAS float* gl = (LAS float*)F.lds;
    for (int i = F.tid; i < 1024; i += NWAVES * 64) { *(LAS f32x4*)(gl + 4 * i) = *(const GAS f32x4*)(gpost + 4 * i); if (HOUT) *(LAS f32x4*)(gl + 4096 + 4 * i) = *(const GAS f32x4*)(gpre + 4 * i); }
    __syncthreads();
    v4u xb[8]; f32x4 xf[16]; v4u tb[8]; float sq = 0.f;
#define ROW_ISSUE(m_) do { int mo_ = (m_); asm volatile("" : "+s"(mo_));     \
        const size_t ro_ = (size_t)mo_ * DM + 8 * F.lane; \
        _Pragma("unroll") for (int j = 0; j < 8; ++j) { \
            if constexpr (XIB) xb[j] = *(const GAS v4u*)((const bf16*)xin + ro_ + 512 * j);     \
            tb[j] = *(const GAS v4u*)(T + ro_ + 512 * j); } \
        sq = SSQ[(size_t)(m_) * 64 + F.lane]; } while (0)
    int m = gw; if (m < M) ROW_ISSUE(m);
    for (; m < M; m += NGW) {
        if constexpr (!XIB) { int mx = m; asm volatile("" : "+s"(mx)); const float* xr = (const float*)xin + (size_t)mx * DM + 8 * F.lane;
#pragma unroll
            for (int j = 0; j < 8; ++j) { xf[2 * j] = *(const GAS f32x4*)(xr + 512 * j); xf[2 * j + 1] = *(const GAS f32x4*)(xr + 512 * j + 4); } }
        const float r1 = 1.0f / sqrtf(wave_sum(sq) * (1.f / 4096.f) + EPS);
        f32x4 v[16]; float s = 0.f;
#pragma unroll
        for (int j = 0; j < 8; ++j) { f32x4 x0, x1;
            if constexpr (XIB) { const v4u w = xb[j]; x0 = (f32x4){bflo(w.x), bfhi(w.x), bflo(w.y), bfhi(w.y)}; x1 = (f32x4){bflo(w.z), bfhi(w.z), bflo(w.w), bfhi(w.w)}; } else { x0 = xf[2 * j]; x1 = xf[2 * j + 1]; }
            const v4u tw = tb[j]; const f32x4 t0 = (f32x4){bflo(tw.x), bfhi(tw.x), bflo(tw.y), bfhi(tw.y)}, t1 = (f32x4){bflo(tw.z), bfhi(tw.z), bflo(tw.w), bfhi(tw.w)};
            const f32x4 g0 = *(const LAS f32x4*)(gl + 8 * F.lane + 512 * j), g1 = *(const LAS f32x4*)(gl + 8 * F.lane + 512 * j + 4);
            const f32x4 o0 = x0 + t0 * r1 * g0, o1 = x1 + t1 * r1 * g1; v[2 * j] = o0; v[2 * j + 1] = o1;
            s += ((o0.x * o0.x + o0.y * o0.y) + (o0.z * o0.z + o0.w * o0.w)) + ((o1.x * o1.x + o1.y * o1.y) + (o1.z * o1.z + o1.w * o1.w)); }
        int ms = m; asm volatile("" : "+s"(ms)); const size_t ro = (size_t)ms * DM + 8 * F.lane;
        if (m + NGW < M) ROW_ISSUE(m + NGW);
#pragma unroll
        for (int j = 0; j < 8; ++j) {
            if constexpr (XOB) { v4u o; o.x = cvt2(v[2 * j].x, v[2 * j].y); o.y = cvt2(v[2 * j].z, v[2 * j].w); o.z = cvt2(v[2 * j + 1].x, v[2 * j + 1].y); o.w = cvt2(v[2 * j + 1].z, v[2 * j + 1].w); *(GAS v4u*)((bf16*)xout + ro + 512 * j) = o; }
            else { *(GAS f32x4*)((float*)xout + ro + 512 * j) = v[2 * j]; *(GAS f32x4*)((float*)xout + ro + 512 * j + 4) = v[2 * j + 1]; } }
        if constexpr (HOUT) {
            const float r2 = 1.0f / sqrtf(wave_sum(s) * (1.f / 4096.f) + EPS);
#pragma unroll
            for (int j = 0; j < 8; ++j) { const f32x4 g0 = *(const LAS f32x4*)(gl + 4096 + 8 * F.lane + 512 * j), g1 = *(const LAS f32x4*)(gl + 4096 + 8 * F.lane + 512 * j + 4);
                v4u o; o.x = cvt2(v[2 * j].x * r2 * g0.x, v[2 * j].y * r2 * g0.y); o.y = cvt2(v[2 * j].z * r2 * g0.z, v[2 * j].w * r2 * g0.w);
                o.z = cvt2(v[2 * j + 1].x * r2 * g1.x, v[2 * j + 1].y * r2 * g1.y); o.w = cvt2(v[2 * j + 1].z * r2 * g1.z, v[2 * j + 1].w * r2 * g1.w); *(GAS v4u*)(H + ro + 512 * j) = o; } }
    }
#undef ROW_ISSUE
    __syncthreads();
}
__device__ __forceinline__ void sincos_d(float angf, float& sn, float& cs) {
    const double a = (double)angf; const double n = __builtin_rint(a * 0.6366197723675814);
    double r = __builtin_fma(-n, 1.5707963267948966, a); r = __builtin_fma(-n, 6.123233995736766e-17, r);
    const double r2 = r * r;
    double sp = 1.0 / 6227020800.0; sp = sp * r2 - 1.0 / 39916800.0; sp = sp * r2 + 1.0 / 362880.0; sp = sp * r2 - 1.0 / 5040.0; sp = sp * r2 + 1.0 / 120.0; sp = sp * r2 - 1.0 / 6.0; sp = sp * r2 + 1.0; sp = sp * r;
    double cp = -1.0 / 87178291200.0; cp = cp * r2 + 1.0 / 479001600.0; cp = cp * r2 - 1.0 / 3628800.0; cp = cp * r2 + 1.0 / 40320.0; cp = cp * r2 - 1.0 / 720.0; cp = cp * r2 + 1.0 / 24.0; cp = cp * r2 - 0.5; cp = cp * r2 + 1.0;
    const int q = (int)n & 3;
    const double s = (q == 0) ? sp : (q == 1) ? cp : (q == 2) ? -sp : -cp;
    const double c = (q == 0) ? cp : (q == 1) ? -sp : (q == 2) ? -cp : sp;
    sn = (float)s; cs = (float)c;
}

typedef short v4i16_t __attribute__((ext_vector_type(4)));
__device__ __forceinline__ s16x4 vtr(const LAS unsigned char* p) { return __builtin_bit_cast(s16x4, __builtin_amdgcn_ds_read_tr16_b64_v4i16((LAS v4i16_t*)p)); }
__device__ __forceinline__ unsigned cvtpk(float lo, float hi) { unsigned r; asm volatile("s_nop 0\n\tv_cvt_pk_bf16_f32 %0, %1, %2\n\ts_nop 1" : "=v"(r) : "v"(lo), "v"(hi)); return r; }
constexpr float ATT_C2 = 0.08838834764831845f * 1.4426950408889634f;
constexpr float ATT_SCALE = 0.08838834764831845f;

template <int NR>
__device__ __forceinline__ void att_issue(v4u (&st)[NR / 32], const bf16* src, size_t gstride, int tid) {
#pragma unroll
    for (int it = 0; it < NR / 32; ++it) st[it] = *(const GAS v4u*)(src + (size_t)((tid >> 4) + 32 * it) * gstride + (tid & 15) * 8);
}
template <int NR>
__device__ __forceinline__ void att_write(const v4u (&st)[NR / 32], LAS unsigned char* img, int lrow0, int tid) {
#pragma unroll
    for (int it = 0; it < NR / 32; ++it) *(LAS v4u*)(img + (lrow0 + (tid >> 4) + 32 * it) * ATT_KSTR + (tid & 15) * 16) = st[it];
}
__device__ __forceinline__ void att_q(bf16x8 (&qf)[4], const bf16* qrow, int lane) {
#pragma unroll
    for (int s = 0; s < 4; ++s) qf[s] = *(const GAS bf16x8*)(qrow + 32 * s + 8 * (lane >> 4));
}
template <int NT, bool BAND>
__device__ __forceinline__ void att_core(const LAS unsigned char* Kimg, const LAS unsigned char* Vimg, int krow0, int kmin, int rot  ,
                                         const bf16x8 (&qf)[4]  , bf16* orow  , float* lse_out  , int lane) {
    const int fr = lane & 15, fq = lane >> 4;
    f32x4 sc[NT];
    const LAS unsigned char* kb = Kimg + fr * ATT_KSTR + 16 * fq;
#pragma unroll
    for (int T = 0; T < NT; ++T) { sc[T] = (f32x4){0.f, 0.f, 0.f, 0.f}; const int trow = (krow0 + rot + 16 * T) & 255;
#pragma unroll
        for (int s = 0; s < 4; ++s) { const bf16x8 kf = *(const LAS bf16x8*)(kb + trow * ATT_KSTR + 64 * s);
            sc[T] = __builtin_amdgcn_mfma_f32_16x16x32_bf16(kf, qf[s], sc[T], 0, 0, 0); } }
    const float NEG = -__builtin_inff();
    if (BAND) {
#pragma unroll
        for (int r = 0; r < 4; ++r) { if (4 * fq + r < fr) sc[0][r] = NEG; if (4 * fq + r > fr) sc[NT - 1][r] = NEG; }
        if (kmin > 0) {
#pragma unroll
            for (int T = 0; T < NT; ++T)
#pragma unroll
                for (int r = 0; r < 4; ++r) if (krow0 + 16 * T + 4 * fq + r < kmin) sc[T][r] = NEG;
        }
    }
    float mx = sc[0][0];
#pragma unroll
    for (int T = 0; T < NT; ++T)
#pragma unroll
        for (int r = 0; r < 4; ++r) mx = fmaxf(mx, sc[T][r]);
    mx = fmaxf(mx, __shfl_xor(mx, 16)); mx = fmaxf(mx, __shfl_xor(mx, 32));
    const float mL = mx * ATT_C2; float l = 0.f;
#pragma unroll
    for (int T = 0; T < NT; ++T)
#pragma unroll
        for (int r = 0; r < 4; ++r) { const float p = __builtin_amdgcn_exp2f(sc[T][r] * ATT_C2 - mL); sc[T][r] = p; l += p; }
    l += __shfl_xor(l, 16); l += __shfl_xor(l, 32);
    constexpr int NKS = (NT + 1) / 2;
    f32x4 oa[8];
#pragma unroll
    for (int c = 0; c < 8; ++c) oa[c] = (f32x4){0.f, 0.f, 0.f, 0.f};
    const LAS unsigned char* vb = Vimg + (4 * fq + (fr >> 2)) * ATT_KSTR + 8 * (fr & 3);
#pragma unroll
    for (int ks = 0; ks < NKS; ++ks) { const int vr0 = (krow0 + rot + 32 * ks) & 255, vr1 = (krow0 + rot + 32 * ks + 16) & 255;
        v4u pw; pw.x = cvtpk(sc[2 * ks][0], sc[2 * ks][1]); pw.y = cvtpk(sc[2 * ks][2], sc[2 * ks][3]);
        if (2 * ks + 1 < NT) { pw.z = cvtpk(sc[2 * ks + 1 < NT ? 2 * ks + 1 : 0][0], sc[2 * ks + 1 < NT ? 2 * ks + 1 : 0][1]); pw.w = cvtpk(sc[2 * ks + 1 < NT ? 2 * ks + 1 : 0][2], sc[2 * ks + 1 < NT ? 2 * ks + 1 : 0][3]); }
        else { pw.z = 0u; pw.w = 0u; }
        const bf16x8 pf = __builtin_bit_cast(bf16x8, pw);
#pragma unroll
        for (int c = 0; c < 8; ++c) { const s16x4 lo = vtr(vb + vr0 * ATT_KSTR + 32 * c), hi = vtr(vb + vr1 * ATT_KSTR + 32 * c);
            const bf16x8 vf = __builtin_shufflevector(lo, hi, 0, 1, 2, 3, 4, 5, 6, 7);
            oa[c] = __builtin_amdgcn_mfma_f32_16x16x32_bf16(vf, pf, oa[c], 0, 0, 0); }
    }
    const float rl = 1.0f / l;
#pragma unroll
    for (int c = 0; c < 8; ++c) { v2u o; o.x = cvtpk(oa[c][0] * rl, oa[c][1] * rl); o.y = cvtpk(oa[c][2] * rl, oa[c][3] * rl); *(GAS v2u*)(orow + 16 * c + 4 * fq) = o; }
    if (lse_out && fq == 0) *lse_out = mx * ATT_SCALE + __logf(l);
}
struct SaUnit { int g, d, qb, h; size_t tok0, col; };
__device__ __forceinline__ SaUnit sa_unit(int i, int per, int G, int bx) {
    int c, h;
    if (per > 0) { c = (bx >> 3) * per + i; h = bx & 7; } else { const int idx = bx + i * G; c = idx >> 3; h = idx & 7; }
    SaUnit u; u.g = c >> 7; const int cc = c & 127, sh = 2 * u.g, nblk = 32 >> sh; u.d = 1 << sh;
    u.qb = cc % nblk; const int t1 = cc / nblk, r = t1 % u.d, b = t1 / u.d; u.h = h;
    u.tok0 = (size_t)b * SEQ + r; u.col = (size_t)u.g * 1024 + h * 128; return u;
}
__device__ __forceinline__ void sa_issue(v4u (&stK)[8], v4u (&stV)[8], const bf16* K, const bf16* V, const SaUnit& u, bool shared, int tid) {
    const size_t gs = (size_t)u.d * QKVW; const int pb = 128 * (u.qb - 1) + (tid >> 4); const int fix = u.qb == 0 ? 128 : 0;
    const size_t base = u.tok0 * QKVW + u.col + (tid & 15) * 8;
    if (!shared) {
#pragma unroll
        for (int it = 0; it < 4; ++it) { const size_t off = base + (size_t)(pb + 32 * it + fix) * gs; stK[it] = *(const GAS v4u*)(K + off); stV[it] = *(const GAS v4u*)(V + off); } }
#pragma unroll
    for (int it = 4; it < 8; ++it) { const size_t off = base + (size_t)(pb + 32 * it) * gs; stK[it] = *(const GAS v4u*)(K + off); stV[it] = *(const GAS v4u*)(V + off); }
}
__device__ __forceinline__ void sa_write(const v4u (&stK)[8], const v4u (&stV)[8], LAS unsigned char* Kimg, LAS unsigned char* Vimg, bool shared, int rot, int tid) {
    if (!shared) {
#pragma unroll
        for (int it = 0; it < 4; ++it) { const int o = ((((tid >> 4) + 32 * it) + rot) & 255) * ATT_KSTR + (tid & 15) * 16; *(LAS v4u*)(Kimg + o) = stK[it]; *(LAS v4u*)(Vimg + o) = stV[it]; } }
#pragma unroll
    for (int it = 4; it < 8; ++it) { const int o = ((((tid >> 4) + 32 * it) + rot) & 255) * ATT_KSTR + (tid & 15) * 16; *(LAS v4u*)(Kimg + o) = stK[it]; *(LAS v4u*)(Vimg + o) = stV[it]; }
}
__device__ __forceinline__ void self_attn_stream(Frame& F, const bf16* Q, const bf16* K, const bf16* V, bf16* OG, float* LSE) {
    LAS unsigned char* Kimg = F.lds + ATT_K_OFF; LAS unsigned char* Vimg = F.lds + ATT_V_OFF;
    const int bx = (int)blockIdx.x, G = F.G, per = (G % 8 == 0 && 3072 % G == 0) ? 3072 / G : 0, n = per ? per : (3072 - bx + G - 1) / G;
    if (n <= 0) return;
    v4u stK[8], stV[8]; SaUnit u = sa_unit(0, per, G, bx); bool shared = false; int rot = 0;
    size_t tok = u.tok0 + (size_t)(128 * u.qb + 16 * F.wave + (F.lane & 15)) * u.d;
    bf16x8 qn[4]; att_q(qn, Q + tok * QKVW + u.col, F.lane);
    sa_issue(stK, stV, K, V, u, false, F.tid);
    for (int i = 0; i < n; ++i) {
        sa_write(stK, stV, Kimg, Vimg, shared, rot, F.tid);
        __syncthreads();
        bf16x8 qf[4];
#pragma unroll
        for (int s = 0; s < 4; ++s) qf[s] = qn[s];
        const int kmin = u.qb == 0 ? 128 : 0, crot = rot; bf16* orow = OG + ((size_t)u.g * M + tok) * AW + u.h * 128; float* lse = LSE + ((size_t)u.g * M + tok) * 8 + u.h;
        const bool more = i + 1 < n;
        if (more) { const SaUnit nu = sa_unit(i + 1, per, G, bx);
            shared = (nu.g == u.g) && (nu.tok0 == u.tok0) && (nu.h == u.h) && (nu.qb == u.qb + 1);
            rot = shared ? (rot ^ 128) : 0; u = nu;
            tok = u.tok0 + (size_t)(128 * u.qb + 16 * F.wave + (F.lane & 15)) * u.d;
            sa_issue(stK, stV, K, V, u, shared, F.tid); att_q(qn, Q + tok * QKVW + u.col, F.lane); }
        att_core<9, true>(Kimg, Vimg, 16 * F.wave, kmin, crot, qf, orow, lse, F.lane);
        __syncthreads();
    }
}
__device__ __forceinline__ void cross_attn_stream(Frame& F, const bf16* QX, const bf16* KVX, bf16* OX) {
    LAS unsigned char* Kimg = F.lds + ATT_K_OFF; LAS unsigned char* Vimg = F.lds + ATT_V_OFF;
    const int per = (512 % F.G == 0) ? 512 / F.G : 0;
    const int n = per ? per : (512 - (int)blockIdx.x + F.G - 1) / F.G; int loaded = -1;
    for (int i = 0; i < n; ++i) { const int idx = per ? (int)blockIdx.x * per + i : (int)blockIdx.x + i * F.G; if (idx >= 512) break;
        const int qblk = idx & 31, bh = idx >> 5, h = bh & 3, b = bh >> 2;
        if (bh != loaded) { if (loaded >= 0) __syncthreads();
            const size_t off = (size_t)b * NMEM * 1024 + h * 128;
            v4u stK[8], stV[8]; att_issue<256>(stK, KVX + off, 1024, F.tid); att_issue<256>(stV, KVX + off + 512, 1024, F.tid);
            att_write<256>(stK, Kimg, 0, F.tid); att_write<256>(stV, Vimg, 0, F.tid);
            __syncthreads(); loaded = bh; }
        const size_t tok = (size_t)b * SEQ + 128 * qblk + 16 * F.wave + (F.lane & 15);
        bf16x8 qf[4]; att_q(qf, QX + tok * XAW + h * 128, F.lane);
        att_core<16, false>(Kimg, Vimg, 0, 0, 0, qf, OX + tok * XAW + h * 128, nullptr, F.lane);
    }
    __syncthreads();
}
__device__ __forceinline__ void sgu_unit(Frame& F, int idx, const bf16* U, bf16* YB, const bf16* VB, const float* lnstat, const float* lng, const float* lnb, const bf16* WSP, const float* bsp) {
    const int g = idx & 15, cn = idx >> 4, C0 = g * 128; const size_t tok0 = (size_t)cn * 128;
    LAS unsigned char* img = F.lds; LAS f32x2* stat = (LAS f32x2*)(F.lds + 40960);
    if (F.tid < 128) { const float* sp = lnstat + (tok0 + F.tid) * 64; float s = 0.f, q = 0.f;
#pragma unroll
        for (int k = 0; k < 16; ++k) { const f32x4 v = *(const GAS f32x4*)(sp + 4 * k); s += v.x + v.z; q += v.y + v.w; }
        const float mu = s * (1.f / 2048.f), var = q * (1.f / 2048.f) - mu * mu; stat[F.tid] = (f32x2){mu, 1.0f / sqrtf(var + EPS)}; }
    __syncthreads();
    { const int ch = F.tid & 15; const float* gp = lng + C0 + 8 * ch; const float* bp = lnb + C0 + 8 * ch;
      const f32x4 g0 = *(const GAS f32x4*)gp, g1 = *(const GAS f32x4*)(gp + 4), b0 = *(const GAS f32x4*)bp, b1 = *(const GAS f32x4*)(bp + 4);
      v4u raw[4];
#pragma unroll
      for (int it = 0; it < 4; ++it) raw[it] = *(const GAS v4u*)(VB + (tok0 + (F.tid >> 4) + 32 * it) * SGW + C0 + 8 * ch);
#pragma unroll
      for (int it = 0; it < 4; ++it) { const int j = (F.tid >> 4) + 32 * it; const f32x2 st = stat[j]; const v4u w = raw[it]; v4u o;
          o.x = cvtpk((bflo(w.x) - st.x) * st.y * g0.x + b0.x, (bfhi(w.x) - st.x) * st.y * g0.y + b0.y); o.y = cvtpk((bflo(w.y) - st.x) * st.y * g0.z + b0.z, (bfhi(w.y) - st.x) * st.y * g0.w + b0.w);
          o.z = cvtpk((bflo(w.z) - st.x) * st.y * g1.x + b1.x, (bfhi(w.z) - st.x) * st.y * g1.y + b1.y); o.w = cvtpk((bflo(w.w) - st.x) * st.y * g1.z + b1.z, (bfhi(w.w) - st.x) * st.y * g1.w + b1.w);
          *(LAS v4u*)(img + j * ATT_KSTR + ch * 16) = o; } }
    __syncthreads();
    const int fr = F.lane & 15, fq = F.lane >> 4, w = F.wave, nsteps = (w >> 1) + 1;
    f32x4 acc[8];
#pragma unroll
    for (int c = 0; c < 8; ++c) acc[c] = (f32x4){0.f, 0.f, 0.f, 0.f};
    const bf16* wrow = WSP + ((size_t)g * 128 + 16 * w + fr) * 128 + 8 * fq;
    const LAS unsigned char* vb = img + (8 * fq + (fr >> 2)) * ATT_KSTR + 8 * (fr & 3);
    for (int s = 0; s < nsteps; ++s) { const bf16x8 wf = *(const GAS bf16x8*)(wrow + 32 * s);
#pragma unroll
        for (int c = 0; c < 8; ++c) { const s16x4 lo = vtr(vb + (32 * s) * ATT_KSTR + 32 * c), hi = vtr(vb + (32 * s + 4) * ATT_KSTR + 32 * c);
            const bf16x8 vf = __builtin_shufflevector(lo, hi, 0, 1, 2, 3, 4, 5, 6, 7);
            acc[c] = __builtin_amdgcn_mfma_f32_16x16x32_bf16(vf, wf, acc[c], 0, 0, 0); } }
    const float bias = bsp[g * 128 + 16 * w + fr];
    const bf16* urow = U + (tok0 + 16 * w + fr) * SGW + C0 + 4 * fq; bf16* yrow = YB + (tok0 + 16 * w + fr) * (AW + SGW) + AW + C0 + 4 * fq;
#pragma unroll
    for (int c = 0; c < 8; ++c) { const v2u uw = *(const GAS v2u*)(urow + 16 * c); v2u o;
        o.x = cvtpk(bflo(uw.x) * (acc[c][0] + bias), bfhi(uw.x) * (acc[c][1] + bias)); o.y = cvtpk(bflo(uw.y) * (acc[c][2] + bias), bfhi(uw.y) * (acc[c][3] + bias));
        *(GAS v2u*)(yrow + 16 * c) = o; }
    __syncthreads();
}

__device__ __forceinline__ void sgu_stream(Frame& F, int per, const bf16* U, bf16* YB, const bf16* VB, const float* lnstat, const float* lng, const float* lnb, const bf16* WSP, const float* bsp) {
    const int idx0 = (int)blockIdx.x * per, cn = idx0 >> 4, g0 = idx0 & 15; const size_t tok0 = (size_t)cn * 128;
    LAS unsigned char* img = F.lds; LAS f32x2* stat = (LAS f32x2*)(F.lds + 40960);
    if (F.tid < 128) { const float* sp = lnstat + (tok0 + F.tid) * 64; float s = 0.f, q = 0.f;
#pragma unroll
        for (int k = 0; k < 16; ++k) { const f32x4 v = *(const GAS f32x4*)(sp + 4 * k); s += v.x + v.z; q += v.y + v.w; }
        const float mu = s * (1.f / 2048.f), var = q * (1.f / 2048.f) - mu * mu; stat[F.tid] = (f32x2){mu, 1.0f / sqrtf(var + EPS)}; }
    const int ch = F.tid & 15, fr = F.lane & 15, fq = F.lane >> 4, w = F.wave, nsteps = (w >> 1) + 1;
    v4u raw[4];
#pragma unroll
    for (int it = 0; it < 4; ++it) raw[it] = *(const GAS v4u*)(VB + (tok0 + (F.tid >> 4) + 32 * it) * SGW + g0 * 128 + 8 * ch);
    __syncthreads();
    const LAS unsigned char* vb = img + (8 * fq + (fr >> 2)) * ATT_KSTR + 8 * (fr & 3);
    for (int i = 0; i < per; ++i) { const int g = g0 + i, C0 = g * 128;
        { const float* gp = lng + C0 + 8 * ch; const float* bp = lnb + C0 + 8 * ch;
          const f32x4 ga = *(const GAS f32x4*)gp, gb = *(const GAS f32x4*)(gp + 4), ba = *(const GAS f32x4*)bp, bb = *(const GAS f32x4*)(bp + 4);
#pragma unroll
          for (int it = 0; it < 4; ++it) { const int j = (F.tid >> 4) + 32 * it; const f32x2 st = stat[j]; const v4u wv = raw[it]; v4u o;
              o.x = cvtpk((bflo(wv.x) - st.x) * st.y * ga.x + ba.x, (bfhi(wv.x) - st.x) * st.y * ga.y + ba.y); o.y = cvtpk((bflo(wv.y) - st.x) * st.y * ga.z + ba.z, (bfhi(wv.y) - st.x) * st.y * ga.w + ba.w);
              o.z = cvtpk((bflo(wv.z) - st.x) * st.y * gb.x + bb.x, (bfhi(wv.z) - st.x) * st.y * gb.y + bb.y); o.w = cvtpk((bflo(wv.w) - st.x) * st.y * gb.z + bb.z, (bfhi(wv.w) - st.x) * st.y * gb.w + bb.w);
              *(LAS v4u*)(img + j * ATT_KSTR + ch * 16) = o; } }
        __syncthreads();
        const bf16* wrow = WSP + ((size_t)g * 128 + 16 * w + fr) * 128 + 8 * fq;
        bf16x8 wf[4];
#pragma unroll
        for (int s = 0; s < 4; ++s) wf[s] = *(const GAS bf16x8*)(wrow + 32 * (s < nsteps ? s : 0));
        const bf16* urow = U + (tok0 + 16 * w + fr) * SGW + C0 + 4 * fq; bf16* yrow = YB + (tok0 + 16 * w + fr) * (AW + SGW) + AW + C0 + 4 * fq;
        v2u uw[8];
#pragma unroll
        for (int c = 0; c < 8; ++c) uw[c] = *(const GAS v2u*)(urow + 16 * c);
        const float bias = bsp[g * 128 + 16 * w + fr];
        if (i + 1 < per) {
#pragma unroll
            for (int it = 0; it < 4; ++it) raw[it] = *(const GAS v4u*)(VB + (tok0 + (F.tid >> 4) + 32 * it) * SGW + C0 + 128 + 8 * ch); }
        f32x4 acc[8];
#pragma unroll
        for (int c = 0; c < 8; ++c) acc[c] = (f32x4){0.f, 0.f, 0.f, 0.f};
#pragma unroll
        for (int s = 0; s < 4; ++s) { if (s < nsteps) {
#pragma unroll
            for (int c = 0; c < 8; ++c) { const s16x4 lo = vtr(vb + (32 * s) * ATT_KSTR + 32 * c), hi = vtr(vb + (32 * s + 4) * ATT_KSTR + 32 * c);
                const bf16x8 vf = __builtin_shufflevector(lo, hi, 0, 1, 2, 3, 4, 5, 6, 7);
                acc[c] = __builtin_amdgcn_mfma_f32_16x16x32_bf16(vf, wf[s], acc[c], 0, 0, 0); } } }
#pragma unroll
        for (int c = 0; c < 8; ++c) { v2u o;
            o.x = cvtpk(bflo(uw[c].x) * (acc[c][0] + bias), bfhi(uw[c].x) * (acc[c][1] + bias)); o.y = cvtpk(bflo(uw[c].y) * (acc[c][2] + bias), bfhi(uw[c].y) * (acc[c][3] + bias));
            *(GAS v2u*)(yrow + 16 * c) = o; }
        __syncthreads();
    }
}

struct ConvJob { const float* W; bf16* WT; int K, N, row_off, ldk, koff, item; };
__device__ __forceinline__ void conv_load(f32x4 (&v)[16], const ConvJob& j, int lane) {
    const int nblk = j.N >> 6, kb = j.item / nblk, nb = j.item - kb * nblk;
    const float* src = j.W + (size_t)(64 * kb + (lane >> 4)) * j.N + 64 * nb + 4 * (lane & 15); const size_t st = (size_t)4 * j.N;
#pragma unroll
    for (int i = 0; i < 16; ++i) v[i] = *(const GAS f32x4*)(src + i * st);
}
__device__ __forceinline__ void conv_to_lds(const f32x4 (&v)[16], LAS unsigned char* scr, int lane) {
#pragma unroll
    for (int i = 0; i < 16; ++i) { v2u o; o.x = cvt2(v[i].x, v[i].y); o.y = cvt2(v[i].z, v[i].w); *(LAS v2u*)(scr + ((lane >> 4) + 4 * i) * 144 + 8 * (lane & 15)) = o; }
}
__device__ __forceinline__ void conv_store(const ConvJob& j, const LAS unsigned char* scr, int lane) {
    const int nblk = j.N >> 6, kb = j.item / nblk, nb = j.item - kb * nblk, i16 = lane & 15, fq = lane >> 4;
    const LAS unsigned char* rb = scr + (8 * fq + (i16 >> 2)) * 144 + 8 * (i16 & 3);
    bf16* dst = j.WT + (size_t)(j.row_off + 64 * nb + i16) * j.ldk + j.koff + 64 * kb + 8 * fq;
#pragma unroll
    for (int jj = 0; jj < 8; ++jj) { const int nb16 = jj & 3, kh = jj >> 2;
        const s16x4 lo = vtr(rb + (32 * kh) * 144 + 32 * nb16), hi = vtr(rb + (32 * kh + 4) * 144 + 32 * nb16);
        const bf16x8 o = __builtin_shufflevector(lo, hi, 0, 1, 2, 3, 4, 5, 6, 7);
        *(GAS bf16x8*)(dst + (size_t)(16 * nb16) * j.ldk + 32 * kh) = o; }
}
#define CONV_STREAM(LO_, HI_, CTR_, DECODE_) do { \
        LAS unsigned char* scr_ = F.lds + RING_OFF + F.wave * 16384; volatile LAS unsigned* tkL_ = (volatile LAS unsigned*)(F.lds + MISC_OFF + 64); \
        f32x4 cv_[16]; ConvJob cur_, nxt_; unsigned tv_ = 0u; int rnd_ = 0; \
        if (F.tid == 0) { tkL_[0] = __hip_atomic_fetch_add((CTR_), 1u, __ATOMIC_RELAXED, __HIP_MEMORY_SCOPE_AGENT); tkL_[1] = __hip_atomic_fetch_add((CTR_), 1u, __ATOMIC_RELAXED, __HIP_MEMORY_SCOPE_AGENT); } \
        __syncthreads(); \
        int tc_ = (int)tkL_[0], tn_ = (int)tkL_[1]; \
        __syncthreads(); \
        int it_ = (LO_) + 8 * tc_ + F.wave; bool have_ = it_ < (HI_); \
        if (have_) { DECODE_(it_, cur_); conv_load(cv_, cur_, F.lane); } \
        while ((LO_) + 8 * tc_ < (HI_)) { \
            if (F.tid == 0) tv_ = __hip_atomic_fetch_add((CTR_), 1u, __ATOMIC_RELAXED, __HIP_MEMORY_SCOPE_AGENT); \
            if (have_) conv_to_lds(cv_, scr_, F.lane); \
            const int itn_ = (LO_) + 8 * tn_ + F.wave; const bool more_ = itn_ < (HI_); \
            if (more_) { DECODE_(itn_, nxt_); conv_load(cv_, nxt_, F.lane); } \
            if (have_) { asm volatile("s_waitcnt lgkmcnt(0)" ::: "memory"); conv_store(cur_, scr_, F.lane); asm volatile("s_waitcnt lgkmcnt(0)" ::: "memory"); } \
            if (F.tid == 0) tkL_[rnd_ & 1] = tv_; \
            __syncthreads(); \
            tc_ = tn_; tn_ = (int)tkL_[rnd_ & 1]; cur_ = nxt_; have_ = more_; ++rnd_; } \
        __syncthreads(); \
    } while (0)

struct Args { const float* in[26]; float* out; unsigned char* ws; int ph_lo, ph_hi, li, pad; };
constexpr float ROPE_INV[16] = {1.0f, 0.44036659598350525f, 0.1939227432012558f, 0.08539710193872452f, 0.03760603070259094f, 0.01656043902039528f, 0.007292664609849453f, 0.0032114458736032248f,
    0.0014142135623842478f, 0.000622772378847003f, 0.00027424818836152554f, 0.00012076973507646471f, 5.318296098266728e-05f, 2.34199997066753e-05f, 1.0313386155758053e-05f, 4.541670477919979e-06f};

__global__ void __launch_bounds__(NWAVES * 64, 2) skel_fwd(Args args) {
    extern __shared__ __attribute__((aligned(16))) unsigned char lds[];
    Frame F;
    F.lds = (LAS unsigned char*)lds;
    F.MISC = (volatile LAS unsigned*)(F.lds + MISC_OFF);
    F.tid = threadIdx.x; F.lane = F.tid & 63; F.wave = __builtin_amdgcn_readfirstlane(F.tid >> 6);
    F.G = gridDim.x; { const int bx = blockIdx.x; F.vcu = (F.G % 8 == 0) ? (bx % 8) * (F.G / 8) + bx / 8 : bx; }
    unsigned char* ws = args.ws; F.ws = ws;
    F.ctl = (gu32*)(ws + WS_CTL);
    const float* x = args.in[0]; const float* mem = args.in[1]; const int* positions = (const int*)args.in[2]; const float* mix_pre_g = args.in[3]; const float* w_in = args.in[4];
    const float* sgu_ln_g = args.in[5]; const float* sgu_ln_b = args.in[6]; const float* w_spatial = args.in[7]; const float* b_spatial = args.in[8];
    const float* w_branch_a = args.in[9]; const float* w_branch_b = args.in[10]; const float* w_gate = args.in[11]; const float* b_gate = args.in[12]; const float* w_out = args.in[13];
    const float* mix_post_g = args.in[14]; const float* xa_pre_g = args.in[15]; const float* mem_norm_g = args.in[16];
    const float* w_xq = args.in[17]; const float* w_xk = args.in[18]; const float* w_xv = args.in[19]; const float* w_xo = args.in[20];
    const float* xa_post_g = args.in[21]; const float* mlp_pre_g = args.in[22]; const float* w_up = args.in[23]; const float* w_down = args.in[24]; const float* mlp_post_g = args.in[25];
    float* out = args.out;
    float* ROPE = (float*)(ws + WS_ROPE); float* LNST = (float*)(ws + WS_LNST); float* SSQ = (float*)(ws + WS_SSQ); float* LSE = (float*)(ws + WS_LSE);
    bf16* WSP = (bf16*)(ws + WS_WSP); bf16* WING = (bf16*)(ws + WS_WING); bf16* WAB = (bf16*)(ws + WS_WA); bf16* WOUT = (bf16*)(ws + WS_WOUT);
    bf16* WXQ = (bf16*)(ws + WS_WXQ); bf16* WKV = (bf16*)(ws + WS_WKV); bf16* WXO = (bf16*)(ws + WS_WXO); bf16* WUP = (bf16*)(ws + WS_WUP); bf16* WDN = (bf16*)(ws + WS_WDN);
    bf16* H = (bf16*)(ws + WS_H); bf16* Qb = (bf16*)(ws + WS_Q); bf16* Kb = (bf16*)(ws + WS_K); bf16* Vb = (bf16*)(ws + WS_V); bf16* Ub = (bf16*)(ws + WS_U); bf16* VBb = (bf16*)(ws + WS_VB);
    unsigned char* Gb = ws + WS_G; bf16* MRG = (bf16*)(ws + WS_MRG); bf16* OG = (bf16*)(ws + WS_OG); bf16* KVX = (bf16*)(ws + WS_KVX); bf16* MB = (bf16*)(ws + WS_MB);
    bf16* T = (bf16*)(ws + WS_T); bf16* QX = (bf16*)(ws + WS_QX); bf16* OX = (bf16*)(ws + WS_OX); bf16* Ab = (bf16*)(ws + WS_A); bf16* T3 = (bf16*)(ws + WS_T3); bf16* XB = (bf16*)(ws + WS_XB); bf16* YAB = (bf16*)(ws + WS_YAB); constexpr int YABW = AW + SGW;

    for (int u = F.tid; u < (LDS_BYTES - MISC_OFF) / 4; u += NWAVES * 64) ((LAS unsigned*)(F.lds + MISC_OFF))[u] = 0u;
    __syncthreads();
#if MK_PER_PHASE
#define GRID_BAR() do { } while (0)
#else
    XcdBarrier bar = xcd_barrier_post((unsigned*)(F.ctl + CW_BAR) + args.li * XCD_BAR_WORDS, F.MISC + 8);
#define GRID_BAR() xcd_barrier(bar)
#endif
    const int lo = args.ph_lo, hi = args.ph_hi;
#define IN(k) (lo <= (k) && (k) < hi)
#define BOTH(k) (IN(k) && IN((k) + 1))
    const int gw = F.vcu * NWAVES + F.wave, NGW = F.G * NWAVES, bx = (int)blockIdx.x;
    const int gtid = bx * (NWAVES * 64) + F.tid, NGT = F.G * NWAVES * 64;
    constexpr int I_UP = 64 * (DFF / 64), I_DN = (DFF / 64) * (DM / 64), P7_BUSY = 144, CONV_PER_WAVE = 18;
    const int conv_early = (F.G > P7_BUSY) ? (((F.G - P7_BUSY) * NWAVES * CONV_PER_WAVE < I_UP + I_DN) ? (F.G - P7_BUSY) * NWAVES * CONV_PER_WAVE : I_UP + I_DN) : 0;

    if (IN(0)) {
        constexpr int I_IN = 64 * (INW / 64), I_G = 64 * (GW / 64), I_A = 16 * 64, I_B = 32 * 64, I_O = 64 * 64, I_XQ = 64 * 8, I_XO = 8 * 64;
        constexpr int NITEMS = I_IN + I_G + I_A + I_B + I_O + 3 * I_XQ + I_XO;
#define P0_DECODE(r_, J) do { int r = (r_); \
            if (r < I_IN) { J = ConvJob{w_in, WING, DM, INW, 0, DM, 0, r}; break; } r -= I_IN; \
            if (r < I_G) { J = ConvJob{w_gate, WING, DM, GW, INW, DM, 0, r}; break; } r -= I_G; \
            if (r < I_A) { J = ConvJob{w_branch_a, WAB, AW, DM, 0, AW + SGW, 0, r}; break; } r -= I_A; \
            if (r < I_B) { J = ConvJob{w_branch_b, WAB, SGW, DM, 0, AW + SGW, AW, r}; break; } r -= I_B; \
            if (r < I_O) { J = ConvJob{w_out, WOUT, DM, DM, 0, DM, 0, r}; break; } r -= I_O; \
            if (r < I_XQ) { J = ConvJob{w_xq, WXQ, DM, XAW, 0, DM, 0, r}; break; } r -= I_XQ; \
            if (r < I_XQ) { J = ConvJob{w_xk, WKV, DM, XAW, 0, DM, 0, r}; break; } r -= I_XQ; \
            if (r < I_XQ) { J = ConvJob{w_xv, WKV, DM, XAW, XAW, DM, 0, r}; break; } r -= I_XQ; \
            J = ConvJob{w_xo, WXO, XAW, DM, 0, XAW, 0, r}; } while (0)
        for (int m = gw; m < M; m += NGW) rms_row_to_bf16(x + (size_t)m * DM, mix_pre_g, H + (size_t)m * DM, F.lane);
        for (int m = gw; m < MROWS; m += NGW) rms_row_to_bf16(mem + (size_t)m * DM, mem_norm_g, MB + (size_t)m * DM, F.lane);
        __syncthreads();
        CONV_STREAM(0, NITEMS, F.ctl + CW_TICKET, P0_DECODE);
#undef P0_DECODE
        for (int i = gtid; i < M * 16; i += NGT) { const int tok = i >> 4, k = i & 15; const float ang = (float)positions[tok] * ROPE_INV[k]; float sn, cs; sincos_d(ang, sn, cs);
            ROPE[(size_t)tok * 32 + k] = cs; ROPE[(size_t)tok * 32 + 16 + k] = sn; }
        for (int i = gtid; i < 16 * 128 * 128; i += NGT) { const int jj = i & 127, ii = (i >> 7) & 127; WSP[i] = (bf16)(jj <= ii ? f2bf(w_spatial[i]) : 0u); }
        if (BOTH(0)) GRID_BAR();
    }
    if (IN(1)) {
        pg8::Gemm g{H, WING, M, NPROJ, DM}; pg8::StaticOrder S; S.init(M, NPROJ, F.G, bx);
        pg8::EpiProj E{Qb, Kb, Vb, Ub, VBb, Gb, ROPE, b_gate, LNST};
        pg8::gemm_phase<pg8::EpiProj, pg8::StaticOrder, PG8_ALIGN, PG8_SP2>(F.lds + RING_OFF, g, S, E);
        if (BOTH(1)) GRID_BAR();
    }
    if (IN(2)) {
        for (int i = F.tid; i < 16 * ATT_KSTR / 4; i += NWAVES * 64) ((LAS unsigned*)(F.lds + ATT_V_OFF + 256 * ATT_KSTR))[i] = 0u;
        __syncthreads();
        self_attn_stream(F, Qb, Kb, Vb, OG, LSE);
        { const int per = (2048 % F.G == 0) ? 2048 / F.G : 0;
          if (per == 1 || per == 2 || per == 4 || per == 8 || per == 16) sgu_stream(F, per, Ub, YAB, VBb, LNST, sgu_ln_g, sgu_ln_b, WSP, b_spatial);
          else for (int idx = bx; idx < 2048; idx += F.G) sgu_unit(F, idx, Ub, YAB, VBb, LNST, sgu_ln_g, sgu_ln_b, WSP, b_spatial); }
        if (BOTH(2)) GRID_BAR();
    }
    if (IN(3)) {
        for (int i = gtid; i < M * 8 * 16; i += NGT) { const int ch = i & 15, hh = (i >> 4) & 7; const size_t tok = (size_t)(i >> 7);
            const float l0 = LSE[tok * 8 + hh], l1 = LSE[((size_t)M + tok) * 8 + hh], l2 = LSE[((size_t)2 * M + tok) * 8 + hh];
            const float mx = fmaxf(l0, fmaxf(l1, l2)); float e0 = __expf(l0 - mx), e1 = __expf(l1 - mx), e2 = __expf(l2 - mx); const float inv = 1.0f / (e0 + e1 + e2); e0 *= inv; e1 *= inv; e2 *= inv;
            const size_t o = tok * AW + hh * 128 + ch * 8;
            const v4u a = *(const GAS v4u*)(OG + o), b = *(const GAS v4u*)(OG + (size_t)M * AW + o), c = *(const GAS v4u*)(OG + (size_t)2 * M * AW + o); v4u y;
            y.x = pk2(e0 * bflo(a.x) + e1 * bflo(b.x) + e2 * bflo(c.x), e0 * bfhi(a.x) + e1 * bfhi(b.x) + e2 * bfhi(c.x));
            y.y = pk2(e0 * bflo(a.y) + e1 * bflo(b.y) + e2 * bflo(c.y), e0 * bfhi(a.y) + e1 * bfhi(b.y) + e2 * bfhi(c.y));
            y.z = pk2(e0 * bflo(a.z) + e1 * bflo(b.z) + e2 * bflo(c.z), e0 * bfhi(a.z) + e1 * bfhi(b.z) + e2 * bfhi(c.z));
            y.w = pk2(e0 * bflo(a.w) + e1 * bflo(b.w) + e2 * bflo(c.w), e0 * bfhi(a.w) + e1 * bfhi(b.w) + e2 * bfhi(c.w));
            *(GAS v4u*)(YAB + tok * YABW + hh * 128 + ch * 8) = y; }
        if (BOTH(3)) GRID_BAR();
    }
    if (IN(4)) {
        pg8::Gemm g{YAB, WAB, M, DM, YABW}; pg8::StaticOrder S; S.init(M, DM, F.G, bx); pg8::EpiMerge E{Gb, MRG, AW / pg8::BK};
        pg8::gemm_phase<pg8::EpiMerge, pg8::StaticOrder, PG8_ALIGN, PG8_SP2>(F.lds + RING_OFF, g, S, E);
        if (BOTH(4)) GRID_BAR();
    }
    if (IN(5)) {
        pg8::Gemm g{MRG, WOUT, M, DM, DM}; pg8::StaticOrder S; S.init(M, DM, F.G, bx); pg8::EpiNorm E{T, DM, SSQ};
        pg8::gemm_phase<pg8::EpiNorm, pg8::StaticOrder, PG8_ALIGN, PG8_SP2>(F.lds + RING_OFF, g, S, E);
        if (BOTH(5)) GRID_BAR();
    }
    if (IN(6)) {
        row_phase<false, true, true>(F, x, T, SSQ, mix_post_g, xa_pre_g, XB, H, gw, NGW);
#define P6_DECODE(r_, J) do { const int r = (r_); if (r < I_UP) J = ConvJob{w_up, WUP, DM, DFF, 0, DM, 0, r}; else J = ConvJob{w_down, WDN, DFF, DM, 0, DFF, 0, r - I_UP}; } while (0)
        __syncthreads();
        CONV_STREAM(conv_early, I_UP + I_DN, F.ctl + CW_TICKET + 64, P6_DECODE);
        if (BOTH(6)) GRID_BAR();
    }
    if (IN(7)) {
        if (bx < 128) { pg8::Gemm g{H, WXQ, M, XAW, DM}; pg8::SmallOrder S; S.init(M, XAW, 0, bx); pg8::EpiPlain E{QX, XAW};
            pg8::gemm_phase<pg8::EpiPlain, pg8::SmallOrder, false, PG8_SP2>(F.lds + RING_OFF, g, S, E); }
        else if (bx < P7_BUSY) { pg8::Gemm g{MB, WKV, MROWS, 2 * XAW, DM}; pg8::SmallOrder S; S.init(MROWS, 2 * XAW, 128, bx); pg8::EpiPlain E{KVX, 2 * XAW};
            pg8::gemm_phase<pg8::EpiPlain, pg8::SmallOrder, false, PG8_SP2>(F.lds + RING_OFF, g, S, E); }
        else { CONV_STREAM(0, conv_early, F.ctl + CW_TICKET + 128, P6_DECODE); }
#undef P6_DECODE
        if (BOTH(7)) GRID_BAR();
    }
    if (IN(8)) {
        cross_attn_stream(F, QX, KVX, OX);
        if (BOTH(8)) GRID_BAR();
    }
    if (IN(9)) {
        pg8::Gemm g{OX, WXO, M, DM, XAW}; pg8::StaticOrder S; S.init(M, DM, F.G, bx); pg8::EpiNorm E{T, DM, SSQ};
        pg8::gemm_phase<pg8::EpiNorm, pg8::StaticOrder, PG8_ALIGN, PG8_SP2>(F.lds + RING_OFF, g, S, E);
        if (BOTH(9)) GRID_BAR();
    }
    if (IN(10)) {
        row_phase<true, true, true>(F, XB, T, SSQ, xa_post_g, mlp_pre_g, XB, H, gw, NGW);
        if (BOTH(10)) GRID_BAR();
    }
    if (IN(11)) {
        pg8::Gemm g{H, WUP, M, DFF, DM}; pg8::StaticOrder S; S.init(M, DFF, F.G, bx); pg8::EpiRelu2 E{Ab, DFF};
        pg8::gemm_phase<pg8::EpiRelu2, pg8::StaticOrder, PG8_ALIGN, PG8_SP2>(F.lds + RING_OFF, g, S, E);
        if (BOTH(11)) GRID_BAR();
    }
    if (IN(12)) {
        pg8::Gemm g{Ab, WDN, M, DM, DFF}; pg8::StaticOrder S; S.init(M, DM, F.G, bx); pg8::EpiNorm E{T3, DM, SSQ};
        pg8::gemm_phase<pg8::EpiNorm, pg8::StaticOrder, PG8_ALIGN, PG8_SP2>(F.lds + RING_OFF, g, S, E);
        if (BOTH(12)) GRID_BAR();
    }
    if (IN(13)) {
        row_phase<true, false, false>(F, XB, T3, SSQ, mlp_post_g, nullptr, out, nullptr, gw, NGW);
    }
#undef IN
#undef BOTH
}

extern "C" void kernel_launch(void* const* d_in, const int* in_sizes, int n_in, void* d_out, int out_size, void* d_ws, size_t ws_size, hipStream_t stream) {
    static int grid = 0;
    if (grid == 0) {
        if (n_in != 26 || in_sizes[0] != M * DM || out_size != M * DM || ws_size < WS_END) { fprintf(stderr, "kernel_launch: unexpected shapes (n_in %d, in0 %d, out %d, ws %zu < %zu?); nothing launched\n", n_in, n_in > 0 ? in_sizes[0] : -1, out_size, ws_size, (size_t)WS_END); grid = -1; return; }
        int dev = 0, cus = 0, per_cu = 0;
        if (hipGetDevice(&dev) != hipSuccess || hipDeviceGetAttribute(&cus, hipDeviceAttributeMultiprocessorCount, dev) != hipSuccess) { grid = -1; return; }
        if (hipFuncSetAttribute((const void*)skel_fwd, hipFuncAttributeMaxDynamicSharedMemorySize, LDS_BYTES) != hipSuccess) { fprintf(stderr, "kernel_launch: hipFuncSetAttribute failed\n"); grid = -1; return; }
        if (hipOccupancyMaxActiveBlocksPerMultiprocessor(&per_cu, (const void*)skel_fwd, NWAVES * 64, LDS_BYTES) != hipSuccess || per_cu < 1)
            fprintf(stderr, "kernel_launch: note: occupancy query reports %d workgroups per CU\n", per_cu);
        (void)hipGetLastError();
        grid = cus;
    }
    if (grid < 0) return;
    if (hipMemsetAsync((char*)d_ws + WS_CTL, 0, CTL_ZERO_BYTES, stream) != hipSuccess) return;
    Args a{};
    for (int i = 0; i < 26; ++i) a.in[i] = (const float*)d_in[i];
    a.out = (float*)d_out; a.ws = (unsigned char*)d_ws;
#if MK_PER_PHASE
    for (int li = 0; li < N_PHASES; ++li) { a.ph_lo = li; a.ph_hi = li + 1; a.li = li;
        hipLaunchKernelGGL(skel_fwd, dim3(grid), dim3(NWAVES * 64), LDS_BYTES, stream, a); }
#else
#if defined(PROBE_DUP)
    a.ph_lo = 0; a.ph_hi = PROBE_DUP + 1; a.li = 0;
    hipLaunchKernelGGL(skel_fwd, dim3(grid), dim3(NWAVES * 64), LDS_BYTES, stream, a);
    a.ph_lo = PROBE_DUP; a.ph_hi = N_PHASES; a.li = 1;
    hipLaunchKernelGGL(skel_fwd, dim3(grid), dim3(NWAVES * 64), LDS_BYTES, stream, a);
#else
    a.ph_lo = 0; a.ph_hi = N_PHASES; a.li = 0;
    hipLaunchKernelGGL(skel_fwd, dim3(grid), dim3(NWAVES * 64), LDS_BYTES, stream, a);
#endif
#endif
    const hipError_t le = hipPeekAtLastError();
    if (le != hipSuccess) fprintf(stderr, "kernel_launch: launch failed: %s\n", hipGetErrorName(le));
}
```

```cpp
#include <hip/hip_runtime.h>
#ifndef CPW_KNOB
#define CPW_KNOB 22
#endif
#ifndef MID_FENCE
#define MID_FENCE 2
#endif
#include <cstdio>
#include <cstdint>
namespace pg8 {
#define PG8_LAS __attribute__((address_space(3)))
typedef unsigned short bf16_t;
typedef short bf16x8 __attribute__((ext_vector_type(8)));
typedef float f32x4 __attribute__((ext_vector_type(4)));
typedef unsigned u32x4 __attribute__((ext_vector_type(4)));
constexpr int BM = 256, BK = 64, HALF = 128, HTB = HALF * BK * 2  , STAGE_BYTES = 8 * HTB, NXCD = 8, WGM = 8;

__host__ __device__ __forceinline__ int lds_byte(int r, int c) { const int st = (r >> 4) * 2 + (c >> 5), rr = r & 15, cc = c & 31, ob = rr * 64 + cc * 2; return st * 1024 + (ob ^ (((ob >> 9) & 1) << 5)); }
__host__ __device__ __forceinline__ void stage_rc(int b, int& R, int& C) { const int st = b / 1024, sb = b % 1024, swz = sb ^ (((sb >> 9) & 1) << 5); R = (st >> 1) * 16 + swz / 64; C = (st & 1) * 32 + (swz % 64) / 2; }
__host__ __device__ __forceinline__ int perm32(int rho) { const int n = rho >> 4, i = rho & 15; return 8 * (i >> 2) + 4 * n + (i & 3); }

struct Unit { int pm, pn; };
struct Gemm { const bf16_t* A; const bf16_t* Bt; int M, N, K; };

struct StaticOrder {
    int nM, nN, nwg, G, c;
    __host__ __device__ void init(int M, int N, int G_, int c_) { nM = M / BM; nN = N / BM; nwg = nM * nN; G = G_; c = c_; }
    __host__ __device__ bool next(int i, Unit& u) const {
        const long L = (long)i * G + c; if (L >= nwg) return false;
        int wgid = (int)L; { const int q = nwg / NXCD, r = nwg % NXCD, xcd = wgid % NXCD, off = wgid / NXCD; wgid = (xcd < r ? xcd * (q + 1) : r * (q + 1) + (xcd - r) * q) + off; }
        const int nig = WGM * nN, gid = wgid / nig, fm = gid * WGM, gsz = (nM - fm) < WGM ? (nM - fm) : WGM;
        u.pm = fm + ((wgid % nig) % gsz); u.pn = (wgid % nig) / gsz; return true;
    }
    __device__ __forceinline__ void a_ready(const Unit&) const {}
    __device__ __forceinline__ void done(const Unit&) const {}
};

__device__ __forceinline__ unsigned cvt_pk_bf16(float lo, float hi) { unsigned r; asm volatile("s_nop 0\n\tv_cvt_pk_bf16_f32 %0, %1, %2" : "=v"(r) : "v"(lo), "v"(hi)); return r; }
typedef float f32x2 __attribute__((ext_vector_type(2)));
__device__ __forceinline__ u32x4 pack8(const f32x4 a, const f32x4 b) { u32x4 w; w.x = cvt_pk_bf16(a[0], a[1]); w.y = cvt_pk_bf16(a[2], a[3]); w.z = cvt_pk_bf16(b[0], b[1]); w.w = cvt_pk_bf16(b[2], b[3]); return w; }
__device__ __forceinline__ float bf_lo(unsigned w) { return __uint_as_float(w << 16); }
__device__ __forceinline__ float bf_hi(unsigned w) { return __uint_as_float(w & 0xffff0000u); }
__device__ __forceinline__ void unpack8(const u32x4 w, f32x4& a, f32x4& b) { a = (f32x4){bf_lo(w.x), bf_hi(w.x), bf_lo(w.y), bf_hi(w.y)}; b = (f32x4){bf_lo(w.z), bf_hi(w.z), bf_lo(w.w), bf_hi(w.w)}; }
__device__ __forceinline__ float gelu_tanh(float x) { const float u = x * (0.7978845608028654f + 0.035677408136300125f * x * x);
    const float e = __builtin_amdgcn_exp2f(-2.885390081777927f * u); return x * __builtin_amdgcn_rcpf(1.0f + e); }
__device__ __forceinline__ float sigmoid_f(float z) { return __builtin_amdgcn_rcpf(1.0f + __builtin_amdgcn_exp2f(-1.4426950408889634f * z)); }
__device__ __forceinline__ f32x4 gelu4(f32x4 v) { return (f32x4){gelu_tanh(v[0]), gelu_tanh(v[1]), gelu_tanh(v[2]), gelu_tanh(v[3])}; }
__device__ __forceinline__ f32x4 sigm4(f32x4 v) { return (f32x4){sigmoid_f(v[0]), sigmoid_f(v[1]), sigmoid_f(v[2]), sigmoid_f(v[3])}; }
__device__ __forceinline__ float hsum4(f32x4 v) { return (v[0] + v[1]) + (v[2] + v[3]); }

struct EpiPlain {
    static constexpr bool PERM = true, AFTER_DRAIN = false, HAS_MID = false;
    bf16_t* O; int ldc;
    __device__ __forceinline__ void operator()(const f32x4 (&acc)[2][2][4][2], const Unit& u, int wr, int wc, int fr, int fq) const {
        const int row0 = u.pm * BM + wr * 64 + fr, col0 = u.pn * BM + wc * 32 + 8 * fq;
#pragma unroll
        for (int ai = 0; ai < 2; ++ai)
#pragma unroll
            for (int m = 0; m < 4; ++m) { bf16_t* rowp = O + (size_t)(row0 + ai * HALF + m * 16) * ldc + col0;
#pragma unroll
                for (int bj = 0; bj < 2; ++bj) *(u32x4*)(rowp + bj * HALF) = pack8(acc[ai][bj][m][0], acc[ai][bj][m][1]); }
    }
};
struct EpiRelu2 {
    static constexpr bool PERM = true, AFTER_DRAIN = false, HAS_MID = false;
    bf16_t* O; int ldc;
    __device__ __forceinline__ void operator()(const f32x4 (&acc)[2][2][4][2], const Unit& u, int wr, int wc, int fr, int fq) const {
        const int row0 = u.pm * BM + wr * 64 + fr, col0 = u.pn * BM + wc * 32 + 8 * fq;
#pragma unroll
        for (int ai = 0; ai < 2; ++ai)
#pragma unroll
            for (int m = 0; m < 4; ++m) { bf16_t* rowp = O + (size_t)(row0 + ai * HALF + m * 16) * ldc + col0;
#pragma unroll
                for (int bj = 0; bj < 2; ++bj) { f32x4 v0 = acc[ai][bj][m][0], v1 = acc[ai][bj][m][1];
                    v0 = __builtin_elementwise_max(v0, (f32x4){0.f, 0.f, 0.f, 0.f}); v1 = __builtin_elementwise_max(v1, (f32x4){0.f, 0.f, 0.f, 0.f});
                    *(u32x4*)(rowp + bj * HALF) = pack8(v0 * v0, v1 * v1); } }
    }
};
struct EpiNorm {
    static constexpr bool PERM = true, AFTER_DRAIN = false, HAS_MID = false;
    bf16_t* O; int ldc; float* ssq;
    __device__ __forceinline__ void operator()(const f32x4 (&acc)[2][2][4][2], const Unit& u, int wr, int wc, int fr, int fq) const {
        const int row0 = u.pm * BM + wr * 64 + fr, col0 = u.pn * BM + wc * 32 + 8 * fq;
#pragma unroll
        for (int ai = 0; ai < 2; ++ai)
#pragma unroll
            for (int m = 0; m < 4; ++m) { const int row = row0 + ai * HALF + m * 16; bf16_t* rowp = O + (size_t)row * ldc + col0; float q = 0.f;
#pragma unroll
                for (int bj = 0; bj < 2; ++bj) { const f32x4 v0 = acc[ai][bj][m][0], v1 = acc[ai][bj][m][1]; q += hsum4(v0 * v0) + hsum4(v1 * v1);
                    *(u32x4*)(rowp + bj * HALF) = pack8(v0, v1); }
                q += __shfl_xor(q, 16); q += __shfl_xor(q, 32);
                if (fq == 0) ssq[(size_t)row * 64 + u.pn * 4 + wc] = q; }
    }
};
__device__ __forceinline__ unsigned gq4(const f32x4 g) { unsigned r = 0u; r = __builtin_amdgcn_cvt_pk_u8_f32(g[0] * 256.f - 0.5f, 0, r); r = __builtin_amdgcn_cvt_pk_u8_f32(g[1] * 256.f - 0.5f, 1, r);
    r = __builtin_amdgcn_cvt_pk_u8_f32(g[2] * 256.f - 0.5f, 2, r); r = __builtin_amdgcn_cvt_pk_u8_f32(g[3] * 256.f - 0.5f, 3, r); return r; }
__device__ __forceinline__ f32x4 gdq4(const unsigned w) { return (f32x4){((float)(w & 0xffu) + 0.5f) * (1.f / 256.f), ((float)((w >> 8) & 0xffu) + 0.5f) * (1.f / 256.f), ((float)((w >> 16) & 0xffu) + 0.5f) * (1.f / 256.f), ((float)(w >> 24) + 0.5f) * (1.f / 256.f)}; }
typedef unsigned u32x2 __attribute__((ext_vector_type(2)));
constexpr size_t GFRAG_TILE = 65536;
__device__ __forceinline__ size_t gfrag_off(int pm, int gt, int wave, int lane) { return ((size_t)(pm * 32 + gt) * 8 + wave) * 8192 + (size_t)lane * 8; }
struct EpiMerge {
    static constexpr bool PERM = true, AFTER_DRAIN = false, HAS_MID = true;
    const unsigned char* G; bf16_t* MG; int tmid;
    __device__ __forceinline__ void mid(f32x4 (&acc)[2][2][4][2], const Unit& u, int wr, int wc, int fr, int fq) const {
        size_t off0 = gfrag_off(u.pm, u.pn, wr * 4 + wc, fq * 16 + fr); asm volatile("" : "+v"(off0));
#pragma unroll
        for (int ai = 0; ai < 2; ++ai)
#pragma unroll
            for (int m = 0; m < 4; ++m) { const unsigned char* gp = G + off0 + (size_t)((ai * 4 + m) * 2) * 512;
#pragma unroll
                for (int bj = 0; bj < 2; ++bj) { const u32x2 wa = *(const u32x2*)(gp + bj * 512), wb = *(const u32x2*)(gp + (size_t)16 * GFRAG_TILE + bj * 512);
                    f32x4 a0 = gdq4(wa.x), a1 = gdq4(wa.y); const f32x4 b0 = gdq4(wb.x), b1 = gdq4(wb.y);
#pragma unroll
                    for (int e = 0; e < 4; ++e) { a0[e] *= __builtin_amdgcn_rcpf(b0[e]); a1[e] *= __builtin_amdgcn_rcpf(b1[e]); }
                    acc[ai][bj][m][0] *= a0; acc[ai][bj][m][1] *= a1; }
                if ((m & (MID_FENCE - 1)) == MID_FENCE - 1) asm volatile("" ::: "memory"); }
    }
    __device__ __forceinline__ void operator()(const f32x4 (&acc)[2][2][4][2], const Unit& u, int wr, int wc, int fr, int fq) const {
        const int row0 = u.pm * BM + wr * 64 + fr, col0 = u.pn * BM + wc * 32 + 8 * fq;
        const unsigned char* gb = G + gfrag_off(u.pm, u.pn + 16, wr * 4 + wc, fq * 16 + fr);
#pragma unroll
        for (int ai = 0; ai < 2; ++ai)
#pragma unroll
            for (int m = 0; m < 4; ++m) { const size_t row = (size_t)(row0 + ai * HALF + m * 16);
#pragma unroll
                for (int bj = 0; bj < 2; ++bj) { const u32x2 wb = *(const u32x2*)(gb + (size_t)((ai * 4 + m) * 2 + bj) * 512); const f32x4 b0 = gdq4(wb.x), b1 = gdq4(wb.y);
                    *(u32x4*)(MG + row * 4096 + col0 + bj * HALF) = pack8(acc[ai][bj][m][0] * b0, acc[ai][bj][m][1] * b1); } }
    }
};
struct EpiProj {
    static constexpr bool PERM = true, AFTER_DRAIN = false, HAS_MID = false;
    bf16_t *Q, *K, *V, *U, *VB; unsigned char* G; const float* rope; const float* bgate; float* lnstat;
    __device__ __forceinline__ void operator()(const f32x4 (&acc)[2][2][4][2], const Unit& u, int wr, int wc, int fr, int fq) const {
        const int pn = u.pn, lc0 = wc * 32 + 8 * fq; int row0 = u.pm * BM + wr * 64 + fr; asm volatile("" : "+v"(row0));
        if (pn < 24) {
            bf16_t* base = pn < 12 ? Q : K; const int colt = (pn < 12 ? pn : pn - 12) * BM + lc0; const float sgn = (fq & 2) ? 1.f : -1.f;
#pragma unroll
            for (int ai = 0; ai < 2; ++ai)
#pragma unroll
                for (int m = 0; m < 4; ++m) { const size_t row = (size_t)(row0 + ai * HALF + m * 16); bf16_t* rowp = base + row * 3072 + colt;
                    f32x4 c0 = {0.f, 0.f, 0.f, 0.f}, c1 = c0, s0 = c0, s1 = c0;
                    if (wc == 0) { const float* rp = rope + row * 32 + 8 * (fq & 1); c0 = *(const f32x4*)rp; c1 = *(const f32x4*)(rp + 4); s0 = *(const f32x4*)(rp + 16); s1 = *(const f32x4*)(rp + 20); }
#pragma unroll
                    for (int bj = 0; bj < 2; ++bj) { f32x4 v0 = acc[ai][bj][m][0], v1 = acc[ai][bj][m][1];
                        if (wc == 0) { f32x4 p0, p1;
#pragma unroll
                            for (int e = 0; e < 4; ++e) { p0[e] = __shfl_xor(v0[e], 32); p1[e] = __shfl_xor(v1[e], 32); }
                            v0 = v0 * c0 + (p0 * s0) * sgn; v1 = v1 * c1 + (p1 * s1) * sgn; }
                        *(u32x4*)(rowp + bj * HALF) = pack8(v0, v1); } }
        } else if (pn < 36) {
            const int colt = (pn - 24) * BM + lc0;
#pragma unroll
            for (int ai = 0; ai < 2; ++ai)
#pragma unroll
                for (int m = 0; m < 4; ++m) { bf16_t* rowp = V + (size_t)(row0 + ai * HALF + m * 16) * 3072 + colt;
#pragma unroll
                    for (int bj = 0; bj < 2; ++bj) *(u32x4*)(rowp + bj * HALF) = pack8(acc[ai][bj][m][0], acc[ai][bj][m][1]); }
        } else if (pn < 44) {
            const int colt = (pn - 36) * BM + lc0;
#pragma unroll
            for (int ai = 0; ai < 2; ++ai)
#pragma unroll
                for (int m = 0; m < 4; ++m) { bf16_t* rowp = U + (size_t)(row0 + ai * HALF + m * 16) * 2048 + colt;
#pragma unroll
                    for (int bj = 0; bj < 2; ++bj) *(u32x4*)(rowp + bj * HALF) = pack8(gelu4(acc[ai][bj][m][0]), gelu4(acc[ai][bj][m][1])); }
        } else if (pn < 52) {
            const int colt = (pn - 44) * BM + lc0;
#pragma unroll
            for (int ai = 0; ai < 2; ++ai)
#pragma unroll
                for (int m = 0; m < 4; ++m) { const size_t row = (size_t)(row0 + ai * HALF + m * 16); bf16_t* rowp = VB + row * 2048 + colt; float s = 0.f, q = 0.f;
#pragma unroll
                    for (int bj = 0; bj < 2; ++bj) { const f32x4 v0 = gelu4(acc[ai][bj][m][0]), v1 = gelu4(acc[ai][bj][m][1]);
                        s += hsum4(v0) + hsum4(v1); q += hsum4(v0 * v0) + hsum4(v1 * v1); *(u32x4*)(rowp + bj * HALF) = pack8(v0, v1); }
                    s += __shfl_xor(s, 16); s += __shfl_xor(s, 32); q += __shfl_xor(q, 16); q += __shfl_xor(q, 32);
                    if (fq == 0) *(f32x2*)(lnstat + (row * 32 + (pn - 44) * 4 + wc) * 2) = (f32x2){s, q}; }
        }
    }
};
struct EpiGates {
    static constexpr bool PERM = true, AFTER_DRAIN = false, HAS_MID = false;
    unsigned char* G; const float* bgate; float inv;
    __device__ __forceinline__ void operator()(const f32x4 (&acc)[2][2][4][2], const Unit& u, int wr, int wc, int fr, int fq) const {
        int colt = u.pn * BM + wc * 32 + 8 * fq; size_t goff = gfrag_off(u.pm, u.pn, wr * 4 + wc, fq * 16 + fr);
        asm volatile("" : "+v"(colt), "+v"(goff));
        f32x4 bv[2][2];
#pragma unroll
        for (int bj = 0; bj < 2; ++bj) { bv[bj][0] = *(const f32x4*)(bgate + colt + bj * HALF); bv[bj][1] = *(const f32x4*)(bgate + colt + bj * HALF + 4); }
        unsigned char* gbase = G + goff;
#pragma unroll
        for (int ai = 0; ai < 2; ++ai)
#pragma unroll
            for (int m = 0; m < 4; ++m) { unsigned char* gp = gbase + (size_t)((ai * 4 + m) * 2) * 512;
#pragma unroll
                for (int bj = 0; bj < 2; ++bj) { u32x2 w; w.x = gq4(sigm4(acc[ai][bj][m][0] * inv + bv[bj][0])); w.y = gq4(sigm4(acc[ai][bj][m][1] * inv + bv[bj][1])); *(u32x2*)(gp + bj * 512) = w; } }
    }
};
struct SmallOrder {
    int nN, nwg, c;
    __device__ void init(int M, int N, int first, int bx) { nN = N / BM; nwg = (M / BM) * nN; c = bx - first; }
    __device__ bool next(int i, Unit& u) const { if (i != 0 || c < 0 || c >= nwg) return false; u.pm = c / nN; u.pn = c % nN; return true; }
    __device__ __forceinline__ void a_ready(const Unit&) const {}
    __device__ __forceinline__ void done(const Unit&) const {}
};
typedef int v4i32_t __attribute__((ext_vector_type(4))); typedef int v8i32_t __attribute__((ext_vector_type(8)));
__device__ __forceinline__ v8i32_t cat8(const bf16x8 lo, const bf16x8 hi) { return __builtin_shufflevector(__builtin_bit_cast(v4i32_t, lo), __builtin_bit_cast(v4i32_t, hi), 0, 1, 2, 3, 4, 5, 6, 7); }
template <class Epi, class Sched, bool ALIGN_EPI = false, bool SP2 = false, bool FP8 = false>
__device__ __forceinline__ void gemm_phase(PG8_LAS unsigned char* lds, const Gemm g, const Sched& S, const Epi& E) {
    const int tid = threadIdx.x, wid = __builtin_amdgcn_readfirstlane(tid >> 6), lane = tid & 63, wr = wid >> 2, wc = wid & 3, fr = lane & 15, fq = lane >> 4;
    const int K = g.K, nt = K / BK;
    unsigned voffA[2], voffB[2];
#pragma unroll
    for (int i = 0; i < 2; ++i) { int R, C; stage_rc(tid * 16 + i * 8192, R, C); const int Rb = Epi::PERM ? ((R & ~31) + perm32(R & 31)) : R;
        voffA[i] = (unsigned)(R * K + C) * 2u; voffB[i] = (unsigned)(Rb * K + C) * 2u; }
    const size_t kstep = (size_t)(BK * 2);
    const size_t hstep = (size_t)HALF * K * 2;
    const size_t tstep = 2 * hstep;
    const unsigned ldsw = (unsigned)wid * 1024u;
    const int aoff = lds_byte(wr * 64 + fr, FP8 ? fq * 16 : fq * 8), boff = lds_byte(wc * 32 + fr, FP8 ? fq * 16 : fq * 8);

#define PG8_SA(b, h) (((b) * 2 + (h)) * HTB)
#define PG8_SB(b, h) ((4 + (b) * 2 + (h)) * HTB)
#define PG8_STAGE(bufoff, gbase, voff) do { _Pragma("unroll") for (int _i = 0; _i < 2; ++_i) \
        __builtin_amdgcn_global_load_lds((const unsigned*)((const char*)(gbase) + (voff)[_i]), (PG8_LAS unsigned*)(lds + (bufoff) + ldsw + _i * 8192), 16, 0, 0); } while (0)
#define PG8_LDA(dst, b, h) do { if constexpr (FP8) { _Pragma("unroll") for (int m = 0; m < 4; ++m) dst##8[m] = cat8(*(const PG8_LAS bf16x8*)(lds + PG8_SA(b, h) + aoff + m * 2048), *(const PG8_LAS bf16x8*)(lds + PG8_SA(b, h) + aoff + m * 2048 + 16)); } \
        else { _Pragma("unroll") for (int m = 0; m < 4; ++m) _Pragma("unroll") for (int k = 0; k < 2; ++k) dst[m][k] = *(const PG8_LAS bf16x8*)(lds + PG8_SA(b, h) + aoff + m * 2048 + k * 1024); } } while (0)
#define PG8_LDB(dst, b, h) do { if constexpr (FP8) { _Pragma("unroll") for (int n = 0; n < 2; ++n) dst##8[n] = cat8(*(const PG8_LAS bf16x8*)(lds + PG8_SB(b, h) + boff + n * 2048), *(const PG8_LAS bf16x8*)(lds + PG8_SB(b, h) + boff + n * 2048 + 16)); } \
        else { _Pragma("unroll") for (int n = 0; n < 2; ++n) _Pragma("unroll") for (int k = 0; k < 2; ++k) dst[n][k] = *(const PG8_LAS bf16x8*)(lds + PG8_SB(b, h) + boff + n * 2048 + k * 1024); } } while (0)
#define PG8_MMA(ai, bj, At, Bt) do { __builtin_amdgcn_s_setprio(1); \
        if constexpr (FP8) { _Pragma("unroll") for (int m = 0; m < 4; ++m) _Pragma("unroll") for (int n = 0; n < 2; ++n) \
            asm volatile("v_mfma_scale_f32_16x16x128_f8f6f4 %0, %1, %2, %0, %3, %3 op_sel_hi:[0,0,0]" : "+v"(acc[ai][bj][m][n]) : "v"(Bt##8[n]), "v"(At##8[m]), "v"(sc8)); } \
        else { _Pragma("unroll") for (int m = 0; m < 4; ++m) _Pragma("unroll") for (int n = 0; n < 2; ++n) _Pragma("unroll") for (int k = 0; k < 2; ++k) \
            acc[ai][bj][m][n] = __builtin_amdgcn_mfma_f32_16x16x32_bf16(Bt[n][k], At[m][k], acc[ai][bj][m][n], 0, 0, 0); } \
        __builtin_amdgcn_s_setprio(0); } while (0)
#define PG8_WAIT_V(n) asm volatile("s_waitcnt vmcnt(" #n ")" ::: "memory")
#define PG8_WAIT_L(n) asm volatile("s_waitcnt lgkmcnt(" #n ")" ::: "memory")
#define PG8_BAR __builtin_amdgcn_s_barrier()
#define PG8_SCHED __builtin_amdgcn_sched_barrier(0)
    Unit cur, nxt; int ui = 0;
    if (!S.next(0, cur)) return;
    f32x4 acc[2][2][4][2];
#pragma unroll
    for (int a = 0; a < 2; ++a)
#pragma unroll
        for (int b = 0; b < 2; ++b)
#pragma unroll
            for (int m = 0; m < 4; ++m)
#pragma unroll
                for (int n = 0; n < 2; ++n) acc[a][b][m][n] = (f32x4){0.f, 0.f, 0.f, 0.f};
    bf16x8 At[4][2], B0[2][2], B1[2][2];
    v8i32_t At8[4], B08[2], B18[2];
    const unsigned sc8 = 0x7F7F7F7Fu;
    const char* cA = (const char*)g.A + (size_t)cur.pm * tstep; const char* cB = (const char*)g.Bt + (size_t)cur.pn * tstep;
    S.a_ready(cur);
    if constexpr (SP2) {
        PG8_STAGE(PG8_SB(0, 0), cB, voffB); PG8_STAGE(PG8_SB(0, 1), cB + hstep, voffB); PG8_STAGE(PG8_SA(0, 0), cA, voffA); PG8_STAGE(PG8_SA(0, 1), cA + hstep, voffA);
        if (wr == 1) PG8_BAR;
        PG8_WAIT_V(2); PG8_BAR;
        PG8_STAGE(PG8_SB(1, 0), cB + kstep, voffB); PG8_STAGE(PG8_SA(1, 0), cA + kstep, voffA); PG8_STAGE(PG8_SB(1, 1), cB + hstep + kstep, voffB);
        PG8_WAIT_V(6); PG8_BAR;
    } else {
        PG8_STAGE(PG8_SB(0, 0), cB, voffB); PG8_STAGE(PG8_SA(0, 0), cA, voffA); PG8_STAGE(PG8_SB(0, 1), cB + hstep, voffB); PG8_STAGE(PG8_SA(0, 1), cA + hstep, voffA);
        if (wr == 1) PG8_BAR;
        PG8_WAIT_V(4); PG8_BAR;
        PG8_STAGE(PG8_SB(1, 0), cB + kstep, voffB); PG8_STAGE(PG8_SA(1, 0), cA + kstep, voffA); PG8_STAGE(PG8_SB(1, 1), cB + hstep + kstep, voffB);
        PG8_WAIT_V(6); PG8_BAR;
    }
    for (;;) {
        const bool has_next = S.next(ui + 1, nxt);
        const char* nA = has_next ? (const char*)g.A + (size_t)nxt.pm * tstep : cA; const char* nB = has_next ? (const char*)g.Bt + (size_t)nxt.pn * tstep : cB;
#define PG8_KITER(t) do { \
            const bool last = ((t) == nt - 2); \
            const char* a1 = cA + (size_t)((t) + 1) * kstep; \
            const char* a2 = last ? nA : cA + (size_t)((t) + 2) * kstep; const char* b2 = last ? nB : cB + (size_t)((t) + 2) * kstep; \
            const char* a3 = a2 + kstep; const char* b3 = b2 + kstep; \
            if (last && has_next) S.a_ready(nxt); \
            PG8_LDB(B0, 0, 0); PG8_LDB(B1, 0, 1); PG8_SCHED; PG8_LDA(At, 0, 0); PG8_STAGE(PG8_SA(1, 1), a1 + hstep, voffA); \
            PG8_WAIT_V(8); PG8_WAIT_L(0); PG8_BAR; PG8_MMA(0, 0, At, B0); PG8_MMA(0, 1, At, B1); PG8_BAR; PG8_SCHED; \
            PG8_LDA(At, 0, 1); PG8_STAGE(PG8_SB(0, 0), b2, voffB); PG8_STAGE(PG8_SB(0, 1), b2 + hstep, voffB); PG8_STAGE(PG8_SA(0, 0), a2, voffA); \
            PG8_WAIT_V(8); PG8_WAIT_L(0); PG8_BAR; PG8_MMA(1, 0, At, B0); PG8_MMA(1, 1, At, B1); PG8_BAR; PG8_SCHED; \
            PG8_LDB(B0, 1, 0); PG8_LDB(B1, 1, 1); PG8_SCHED; PG8_LDA(At, 1, 0); PG8_STAGE(PG8_SA(0, 1), a2 + hstep, voffA); \
            PG8_WAIT_V(8); PG8_WAIT_L(0); PG8_BAR; PG8_MMA(0, 0, At, B0); PG8_MMA(0, 1, At, B1); PG8_BAR; PG8_SCHED; \
            PG8_LDA(At, 1, 1); PG8_STAGE(PG8_SB(1, 0), b3, voffB); PG8_STAGE(PG8_SB(1, 1), b3 + hstep, voffB); PG8_STAGE(PG8_SA(1, 0), a3, voffA); \
            PG8_WAIT_V(8); PG8_WAIT_L(0); PG8_BAR; PG8_MMA(1, 0, At, B0); PG8_MMA(1, 1, At, B1); PG8_BAR; PG8_SCHED; \
        } while (0)
        static_assert(SP2, "this copy of the body keeps only the two-super-phase K-loop");
        if constexpr (Epi::HAS_MID) {
            const int tm = E.tmid;
            for (int t = 0; t < tm; t += 2) PG8_KITER(t);
            E.mid(acc, cur, wr, wc, fr, fq);
            for (int t = tm; t < nt; t += 2) PG8_KITER(t);
        } else {
            for (int t = 0; t < nt; t += 2) PG8_KITER(t);
        }
#undef PG8_KITER
        if constexpr (FP8) asm volatile("s_nop 15\n\ts_nop 15" ::: "memory");
        if constexpr (ALIGN_EPI) { if (wr == 0) PG8_BAR; }
        if constexpr (!Epi::AFTER_DRAIN) { E(acc, cur, wr, wc, fr, fq); S.done(cur); }
        if (!has_next) break;
#pragma unroll
        for (int a = 0; a < 2; ++a)
#pragma unroll
            for (int b = 0; b < 2; ++b)
#pragma unroll
                for (int m = 0; m < 4; ++m)
#pragma unroll
                    for (int n = 0; n < 2; ++n) acc[a][b][m][n] = (f32x4){0.f, 0.f, 0.f, 0.f};
        cur = nxt; cA = nA; cB = nB; ++ui;
        if constexpr (ALIGN_EPI) { if (wr == 1) PG8_BAR; }
    }
    PG8_WAIT_V(0);
    if constexpr (!ALIGN_EPI) { if (wr == 0) PG8_BAR; }
    PG8_BAR;
    if constexpr (Epi::AFTER_DRAIN) { E.fused(acc, cur, wr, wc, fr, fq, lds, wid, lane); S.done(cur); }
#undef PG8_SA
#undef PG8_SB
#undef PG8_STAGE
#undef PG8_LDA
#undef PG8_LDB
#undef PG8_MMA
#undef PG8_WAIT_V
#undef PG8_WAIT_L
#undef PG8_BAR
#undef PG8_SCHED
}
}
#ifndef PG8_SP2
#define PG8_SP2 true
#endif
#ifndef PG8_ALIGN
#define PG8_ALIGN true
#endif
constexpr int NWAVES = 8;
#ifndef MK_PER_PHASE
#define MK_PER_PHASE 0
#endif
constexpr int N_PHASES = 14;

constexpr int BATCH = 4, SEQ = 4096, DM = 4096, M = BATCH * SEQ;
constexpr int AW = 1024, QKVW = 3072, SGW = 2048, INW = 13312, GW = 8192, NPROJ = INW + GW;
constexpr int XAW = 512, NMEM = 256, MROWS = BATCH * NMEM, DFF = 16384;
constexpr float EPS = 1e-6f;
constexpr float FP8_SH = 32.f, FP8_SW = 2048.f;

constexpr size_t MiB = 1u << 20;
constexpr size_t WS_CTL = 0, CTL_ZERO_BYTES = 1 * MiB;
constexpr size_t WS_ROPE = 1 * MiB;
constexpr size_t WS_LNST = 3 * MiB;
constexpr size_t WS_SSQ = 7 * MiB;
constexpr size_t WS_LSE = 11 * MiB;
constexpr size_t WS_WSP = 13 * MiB;
constexpr size_t WS_WING = 16 * MiB;
constexpr size_t WS_WG8 = 120 * MiB;
constexpr size_t WS_H8 = 1058 * MiB;
constexpr size_t WS_WA = 184 * MiB;
constexpr size_t WS_WOUT = 208 * MiB;
constexpr size_t WS_WXQ = 240 * MiB;
constexpr size_t WS_WKV = 244 * MiB;
constexpr size_t WS_WXO = 252 * MiB;
constexpr size_t WS_H = 256 * MiB;
constexpr size_t WS_Q = 384 * MiB, WS_K = 480 * MiB, WS_V = 576 * MiB;
constexpr size_t WS_U = 672 * MiB, WS_VB = 736 * MiB;
constexpr size_t WS_G = 800 * MiB;
constexpr size_t WS_MRG = 1056 * MiB;
constexpr size_t WS_OG = 1056 * MiB;
constexpr size_t WS_KVX = 1216 * MiB;
constexpr size_t WS_MB = 1218 * MiB;
constexpr size_t WS_T = 384 * MiB;
constexpr size_t WS_QX = 512 * MiB, WS_OX = 528 * MiB;
constexpr size_t WS_A = 384 * MiB;
constexpr size_t WS_WUP = 896 * MiB;
constexpr size_t WS_WDN = 1024 * MiB;
constexpr size_t WS_YAB = 16 * MiB;
constexpr size_t WS_T3 = 256 * MiB;
constexpr size_t WS_XB = 16 * MiB;
constexpr size_t WS_END = 1226 * MiB;
constexpr int CW_TMO = 0, CW_CODE = 1, CW_BAR = 4096, CW_TICKET = 16384;

constexpr int RING_OFF = 0, RING_BYTES = 131072;
constexpr int ATT_KSTR = 272;
constexpr int ATT_K_OFF = 0, ATT_V_OFF = 256 * ATT_KSTR, ATT_END = ATT_V_OFF + 272 * ATT_KSTR;
constexpr int MISC_OFF = 144384, LDS_BYTES = 147456;
static_assert(ATT_END <= MISC_OFF && MISC_OFF + 128 <= LDS_BYTES, "LDS map");

#define GAS __attribute__((address_space(1)))
#define LAS __attribute__((address_space(3)))
typedef unsigned short bf16;
typedef unsigned v4u __attribute__((ext_vector_type(4)));
typedef unsigned v2u __attribute__((ext_vector_type(2)));
typedef float f32x4 __attribute__((ext_vector_type(4)));
typedef float f32x2 __attribute__((ext_vector_type(2)));
typedef short bf16x8 __attribute__((ext_vector_type(8)));
typedef short s16x4 __attribute__((ext_vector_type(4)));
typedef GAS unsigned gu32;
#define RLX_AGENT __ATOMIC_RELAXED, __HIP_MEMORY_SCOPE_AGENT
#define LDS_WAIT() asm volatile("s_waitcnt lgkmcnt(0)" ::: "memory")
#define VM_WAIT() asm volatile("s_waitcnt vmcnt(0)" ::: "memory")
__device__ __forceinline__ unsigned f2bf(float f) { unsigned u = __builtin_bit_cast(unsigned, f); return (u + 0x7fffu + ((u >> 16) & 1u)) >> 16; }
__device__ __forceinline__ unsigned pk2(float lo, float hi) { return f2bf(lo) | (f2bf(hi) << 16); }
__device__ __forceinline__ float bflo(unsigned w) { return __uint_as_float(w << 16); }
__device__ __forceinline__ float bfhi(unsigned w) { return __uint_as_float(w & 0xffff0000u); }

#define XB_TMO      128
#define XB_XCNT(j)  (256  + 64 * (j))
#define XB_XSUB(j)  (1280 + 64 * (j))
#define XB_XGEN(j)  (2304 + 64 * (j))
#define XB_TOP      3328
#define XB_TOPGEN   3392
#define XCD_BAR_WORDS 3456
#define XB_SPIN_CAP (1u << 18)

__device__ __forceinline__ unsigned xb_ld(unsigned* p)              { return __hip_atomic_load(p, __ATOMIC_RELAXED, __HIP_MEMORY_SCOPE_AGENT); }
__device__ __forceinline__ unsigned xb_add(unsigned* p, unsigned v) { return __hip_atomic_fetch_add(p, v, __ATOMIC_RELAXED, __HIP_MEMORY_SCOPE_AGENT); }
__device__ __forceinline__ unsigned xb_xcc_id() { return (unsigned)__builtin_amdgcn_s_getreg((3 << 11) | 20) & 0xFu; }
#define XB_SPIN(cond, bar) do { unsigned _sp = 0; while (cond) { __builtin_amdgcn_s_sleep(1); \
    if ((++_sp & 255u) == 0u) { if (xb_ld(&(bar)[XB_TMO])) break; if (_sp > XB_SPIN_CAP) { atomicAdd(&(bar)[XB_TMO], 1u); break; } } } } while (0)

struct XcdBarrier {
    unsigned* bar; unsigned x;
    volatile LAS unsigned* st;
};

__device__ __forceinline__ XcdBarrier xcd_barrier_post(unsigned* bar, volatile LAS unsigned* st) {
    XcdBarrier b; b.bar = bar; b.x = xb_xcc_id(); b.st = st;
    if (threadIdx.x == 0) (void)xb_add(&bar[XB_XCNT(b.x)], 1u);
    return b;
}
__device__ __forceinline__ void xcd_barrier_complete(unsigned* bar, unsigned x, unsigned& nloc, unsigned& nx) {
    const unsigned G = gridDim.x * gridDim.y * gridDim.z;
    unsigned sum, cnt, mine, sp = 0u;
    for (;;) {
        sum = 0u; cnt = 0u; mine = 0u;
#pragma unroll
        for (unsigned j = 0; j < 16; ++j) { const unsigned c = xb_ld(&bar[XB_XCNT(j)]); sum += c; cnt += (c > 0u) ? 1u : 0u; mine = (j == x) ? c : mine; }
        if (sum == G) break;
        __builtin_amdgcn_s_sleep(1);
        if ((++sp & 255u) == 0u) { if (xb_ld(&bar[XB_TMO])) break; if (sp > XB_SPIN_CAP) { atomicAdd(&bar[XB_TMO], 1u); break; } }
    }
    nloc = mine > 0u ? mine : 1u; nx = cnt > 0u ? cnt : 1u;
}

__device__ __forceinline__ void xcd_barrier(const XcdBarrier& b) {
    asm volatile("s_waitcnt vmcnt(0)" ::: "memory");
    __syncthreads();
    if (threadIdx.x == 0) {
        unsigned* bar = b.bar;
        __builtin_amdgcn_s_waitcnt(0);
        unsigned nloc = b.st[0], nx = b.st[1];
        if (nloc == 0u) { xcd_barrier_complete(bar, b.x, nloc, nx); b.st[0] = nloc; b.st[1] = nx; }
        const unsigned old = xb_add(&bar[XB_XSUB(b.x)], 1u);
        const unsigned gen = old / nloc;
        if (old + 1u == (gen + 1u) * nloc) {
            __builtin_amdgcn_fence(__ATOMIC_RELEASE, "agent");
            asm volatile("s_waitcnt vmcnt(0)" ::: "memory");
            const unsigned og = xb_add(&bar[XB_TOP], 1u);
            const unsigned tg = og / nx;
            if (og + 1u == (tg + 1u) * nx) xb_add(&bar[XB_TOPGEN], 1u);
            else XB_SPIN(xb_ld(&bar[XB_TOPGEN]) == tg, bar);
            __builtin_amdgcn_fence(__ATOMIC_ACQUIRE, "agent");
            xb_add(&bar[XB_XGEN(b.x)], 1u);
            asm volatile("s_waitcnt vmcnt(0)" ::: "memory");
        } else {
            XB_SPIN(xb_ld(&bar[XB_XGEN(b.x)]) == gen, bar);
            __builtin_amdgcn_fence(__ATOMIC_ACQUIRE, "agent");
            asm volatile("s_waitcnt vmcnt(0)" ::: "memory");
        }
    }
    __syncthreads();
}

struct Frame {
    LAS unsigned char* lds;
    volatile LAS unsigned* MISC;
    gu32* ctl;
    int tid, lane, wave;
    int vcu, G;
    unsigned char* ws;
};
__device__ __forceinline__ float wave_sum(float v) {
#pragma unroll
    for (int o = 1; o < 64; o <<= 1) v += __shfl_xor(v, o);
    return v;
}
__device__ __forceinline__ void p0_transpose_item(const float* W, int K, int N, bf16* WT, int row_off, LAS float* scr, int item, int lane, int ldk = 0, int koff = 0) {
    if (ldk == 0) ldk = K;
    const int nblk = N / 32, kb = item / nblk, nb = item % nblk, k0 = 64 * kb, n0 = 32 * nb;
#pragma unroll 8
    for (int i = 0; i < 32; ++i) { const int kk = 2 * i + (lane >> 5); scr[kk * 33 + (lane & 31)] = W[(size_t)(k0 + kk) * N + n0 + (lane & 31)]; }
    LDS_WAIT(); asm volatile("" ::: "memory");
    const int c = lane & 7;
#pragma unroll
    for (int j = 0; j < 4; ++j) { const int n = (lane >> 3) + 8 * j; const LAS float* s = scr + (8 * c) * 33 + n;
        v4u o; o.x = pk2(s[0 * 33], s[1 * 33]); o.y = pk2(s[2 * 33], s[3 * 33]); o.z = pk2(s[4 * 33], s[5 * 33]); o.w = pk2(s[6 * 33], s[7 * 33]);
        *(GAS v4u*)(WT + (size_t)(row_off + n0 + n) * ldk + koff + k0 + 8 * c) = o; }
    LDS_WAIT(); asm volatile("" ::: "memory");
}
__device__ __forceinline__ float sat8(float v) { return __builtin_amdgcn_fmed3f(v, -448.f, 448.f); }
__device__ __forceinline__ unsigned fp8x4(float a, float b, float c, float d) { int w = 0; w = __builtin_amdgcn_cvt_pk_fp8_f32(sat8(a), sat8(b), w, false); w = __builtin_amdgcn_cvt_pk_fp8_f32(sat8(c), sat8(d), w, true); return (unsigned)w; }
__device__ __forceinline__ void rms_row_to_bf16(const float* xrow, const float* g, bf16* orow, int lane, unsigned char* o8row = nullptr) {
    const GAS f32x4* xr = (const GAS f32x4*)xrow + lane; const GAS f32x4* gr = (const GAS f32x4*)g + lane;
    f32x4 v[16]; float s = 0.f;
#pragma unroll
    for (int j = 0; j < 16; ++j) { v[j] = xr[64 * j]; s += (v[j].x * v[j].x + v[j].y * v[j].y) + (v[j].z * v[j].z + v[j].w * v[j].w); }
    const float r = 1.0f / sqrtf(wave_sum(s) * (1.f / 4096.f) + EPS);
    GAS v2u* o8 = (GAS v2u*)orow + lane;
#pragma unroll
    for (int j = 0; j < 16; ++j) { const f32x4 gg = gr[64 * j]; const f32x4 hv = (f32x4){v[j].x * r * gg.x, v[j].y * r * gg.y, v[j].z * r * gg.z, v[j].w * r * gg.w};
        v2u o; o.x = pk2(hv.x, hv.y); o.y = pk2(hv.z, hv.w); o8[64 * j] = o;
        if (o8row) ((GAS unsigned*)o8row + lane)[64 * j] = fp8x4(hv.x * FP8_SH, hv.y * FP8_SH, hv.z * FP8_SH, hv.w * FP8_SH); }
}
template <bool XIB, bool XOB>
__device__ __forceinline__ void row_norm_res(const void* xin, const bf16* trow, const float* ssq, const float* gpost, const float* gpre, void* xout, bf16* hout, int lane) {
    const float r1 = 1.0f / sqrtf(wave_sum(ssq[lane]) * (1.f / 4096.f) + EPS);
    const GAS v2u* tr = (const GAS v2u*)trow + lane; const GAS f32x4* gp = (const GAS f32x4*)gpost + lane;
    f32x4 v[16]; float s = 0.f;
#pragma unroll
    for (int j = 0; j < 16; ++j) { f32x4 xv;
        if (XIB) { const v2u xw = ((const GAS v2u*)xin + lane)[64 * j]; xv = (f32x4){bflo(xw.x), bfhi(xw.x), bflo(xw.y), bfhi(xw.y)}; } else xv = ((const GAS f32x4*)xin + lane)[64 * j];
        const v2u tw = tr[64 * j]; const f32x4 gg = gp[64 * j];
        f32x4 o; o.x = xv.x + bflo(tw.x) * r1 * gg.x; o.y = xv.y + bfhi(tw.x) * r1 * gg.y; o.z = xv.z + bflo(tw.y) * r1 * gg.z; o.w = xv.w + bfhi(tw.y) * r1 * gg.w;
        v[j] = o; s += (o.x * o.x + o.y * o.y) + (o.z * o.z + o.w * o.w);
        if (XOB) { v2u ow; ow.x = pk2(o.x, o.y); ow.y = pk2(o.z, o.w); ((GAS v2u*)xout + lane)[64 * j] = ow; } else ((GAS f32x4*)xout + lane)[64 * j] = o; }
    if (hout) {
        const float r2 = 1.0f / sqrtf(wave_sum(s) * (1.f / 4096.f) + EPS);
        const GAS f32x4* gq = (const GAS f32x4*)gpre + lane; GAS v2u* o8 = (GAS v2u*)hout + lane;
#pragma unroll
        for (int j = 0; j < 16; ++j) { const f32x4 gg = gq[64 * j]; v2u o; o.x = pk2(v[j].x * r2 * gg.x, v[j].y * r2 * gg.y); o.y = pk2(v[j].z * r2 * gg.z, v[j].w * r2 * gg.w); o8[64 * j] = o; }
    }
}
__device__ __forceinline__ unsigned cvt2(float lo, float hi) { typedef float f2_t __attribute__((ext_vector_type(2))); typedef __bf16 b2_t __attribute__((ext_vector_type(2))); const f2_t v = {lo, hi}; return __builtin_bit_cast(unsigned, __builtin_convertvector(v, b2_t)); }
template <bool XIB, bool XOB, bool HOUT>
__device__ __forceinline__ void row_phase(Frame& F, const void* xin, const bf16* T, const float* SSQ, const float* gpost, const float* gpre, void* xout, bf16* H, int gw, int NGW) {
    LAS float* gl = (LAS float*)F.lds;
    for (int i = F.tid; i < 1024; i += NWAVES * 64) { *(LAS f32x4*)(gl + 4 * i) = *(const GAS f32x4*)(gpost + 4 * i); if (HOUT) *(LAS f32x4*)(gl + 4096 + 4 * i) = *(const GAS f32x4*)(gpre + 4 * i); }
    __syncthreads();
    v4u xb[8]; f32x4 xf[16]; v4u tb[8]; float sq = 0.f;
#define ROW_ISSUE(m_) do { int mo_ = (m_); asm volatile("" : "+s"(mo_));     \
        const size_t ro_ = (size_t)mo_ * DM + 8 * F.lane; \
        _Pragma("unroll") for (int j = 0; j < 8; ++j) { \
            if constexpr (XIB) xb[j] = *(const GAS v4u*)((const bf16*)xin + ro_ + 512 * j);     \
            tb[j] = *(const GAS v4u*)(T + ro_ + 512 * j); } \
        sq = SSQ[(size_t)(m_) * 64 + F.lane]; } while (0)
    int m = gw; if (m < M) ROW_ISSUE(m);
    for (; m < M; m += NGW) {
        if constexpr (!XIB) { int mx = m; asm volatile("" : "+s"(mx)); const float* xr = (const float*)xin + (size_t)mx * DM + 8 * F.lane;
#pragma unroll
            for (int j = 0; j < 8; ++j) { xf[2 * j] = *(const GAS f32x4*)(xr + 512 * j); xf[2 * j + 1] = *(const GAS f32x4*)(xr + 512 * j + 4); } }
        const float r1 = 1.0f / sqrtf(wave_sum(sq) * (1.f / 4096.f) + EPS);
        f32x4 v[16]; float s = 0.f;
#pragma unroll
        for (int j = 0; j < 8; ++j) { f32x4 x0, x1;
            if constexpr (XIB) { const v4u w = xb[j]; x0 = (f32x4){bflo(w.x), bfhi(w.x), bflo(w.y), bfhi(w.y)}; x1 = (f32x4){bflo(w.z), bfhi(w.z), bflo(w.w), bfhi(w.w)}; } else { x0 = xf[2 * j]; x1 = xf[2 * j + 1]; }
            const v4u tw = tb[j]; const f32x4 t0 = (f32x4){bflo(tw.x), bfhi(tw.x), bflo(tw.y), bfhi(tw.y)}, t1 = (f32x4){bflo(tw.z), bfhi(tw.z), bflo(tw.w), bfhi(tw.w)};
            const f32x4 g0 = *(const LAS f32x4*)(gl + 8 * F.lane + 512 * j), g1 = *(const LAS f32x4*)(gl + 8 * F.lane + 512 * j + 4);
            const f32x4 o0 = x0 + t0 * r1 * g0, o1 = x1 + t1 * r1 * g1; v[2 * j] = o0; v[2 * j + 1] = o1;
            s += ((o0.x * o0.x + o0.y * o0.y) + (o0.z * o0.z + o0.w * o0.w)) + ((o1.x * o1.x + o1.y * o1.y) + (o1.z * o1.z + o1.w * o1.w)); }
        int ms = m; asm volatile("" : "+s"(ms)); const size_t ro = (size_t)ms * DM + 8 * F.lane;
        if (m + NGW < M) ROW_ISSUE(m + NGW);
#pragma unroll
        for (int j = 0; j < 8; ++j) {
            if constexpr (XOB) { v4u o; o.x = cvt2(v[2 * j].x, v[2 * j].y); o.y = cvt2(v[2 * j].z, v[2 * j].w); o.z = cvt2(v[2 * j + 1].x, v[2 * j + 1].y); o.w = cvt2(v[2 * j + 1].z, v[2 * j + 1].w); *(GAS v4u*)((bf16*)xout + ro + 512 * j) = o; }
            else { *(GAS f32x4*)((float*)xout + ro + 512 * j) = v[2 * j]; *(GAS f32x4*)((float*)xout + ro + 512 * j + 4) = v[2 * j + 1]; } }
        if constexpr (HOUT) {
            const float r2 = 1.0f / sqrtf(wave_sum(s) * (1.f / 4096.f) + EPS);
#pragma unroll
            for (int j = 0; j < 8; ++j) { const f32x4 g0 = *(const LAS f32x4*)(gl + 4096 + 8 * F.lane + 512 * j), g1 = *(const LAS f32x4*)(gl + 4096 + 8 * F.lane + 512 * j + 4);
                v4u o; o.x = cvt2(v[2 * j].x * r2 * g0.x, v[2 * j].y * r2 * g0.y); o.y = cvt2(v[2 * j].z * r2 * g0.z, v[2 * j].w * r2 * g0.w);
                o.z = cvt2(v[2 * j + 1].x * r2 * g1.x, v[2 * j + 1].y * r2 * g1.y); o.w = cvt2(v[2 * j + 1].z * r2 * g1.z, v[2 * j + 1].w * r2 * g1.w); *(GAS v4u*)(H + ro + 512 * j) = o; } }
    }
#undef ROW_ISSUE
    __syncthreads();
}
__device__ __forceinline__ void sincos_d(float angf, float& sn, float& cs) {
    const double a = (double)angf; const double n = __builtin_rint(a * 0.6366197723675814);
    double r = __builtin_fma(-n, 1.5707963267948966, a); r = __builtin_fma(-n, 6.123233995736766e-17, r);
    const double r2 = r * r;
    double sp = 1.0 / 6227020800.0; sp = sp * r2 - 1.0 / 39916800.0; sp = sp * r2 + 1.0 / 362880.0; sp = sp * r2 - 1.0 / 5040.0; sp = sp * r2 + 1.0 / 120.0; sp = sp * r2 - 1.0 / 6.0; sp = sp * r2 + 1.0; sp = sp * r;
    double cp = -1.0 / 87178291200.0; cp = cp * r2 + 1.0 / 479001600.0; cp = cp * r2 - 1.0 / 3628800.0; cp = cp * r2 + 1.0 / 40320.0; cp = cp * r2 - 1.0 / 720.0; cp = cp * r2 + 1.0 / 24.0; cp = cp * r2 - 0.5; cp = cp * r2 + 1.0;
    const int q = (int)n & 3;
    const double s = (q == 0) ? sp : (q == 1) ? cp : (q == 2) ? -sp : -cp;
    const double c = (q == 0) ? cp : (q == 1) ? -sp : (q == 2) ? -cp : sp;
    sn = (float)s; cs = (float)c;
}

typedef short v4i16_t __attribute__((ext_vector_type(4)));
__device__ __forceinline__ s16x4 vtr(const LAS unsigned char* p) { return __builtin_bit_cast(s16x4, __builtin_amdgcn_ds_read_tr16_b64_v4i16((LAS v4i16_t*)p)); }
__device__ __forceinline__ unsigned cvtpk(float lo, float hi) { unsigned r; asm volatile("s_nop 0\n\tv_cvt_pk_bf16_f32 %0, %1, %2\n\ts_nop 1" : "=v"(r) : "v"(lo), "v"(hi)); return r; }
constexpr float ATT_C2 = 0.08838834764831845f * 1.4426950408889634f;
constexpr float ATT_SCALE = 0.08838834764831845f;

template <int NR>
__device__ __forceinline__ void att_issue(v4u (&st)[NR / 32], const bf16* src, size_t gstride, int tid) {
#pragma unroll
    for (int it = 0; it < NR / 32; ++it) st[it] = *(const GAS v4u*)(src + (size_t)((tid >> 4) + 32 * it) * gstride + (tid & 15) * 8);
}
template <int NR>
__device__ __forceinline__ void att_write(const v4u (&st)[NR / 32], LAS unsigned char* img, int lrow0, int tid) {
#pragma unroll
    for (int it = 0; it < NR / 32; ++it) *(LAS v4u*)(img + (lrow0 + (tid >> 4) + 32 * it) * ATT_KSTR + (tid & 15) * 16) = st[it];
}
__device__ __forceinline__ void att_q(bf16x8 (&qf)[4], const bf16* qrow, int lane) {
#pragma unroll
    for (int s = 0; s < 4; ++s) qf[s] = *(const GAS bf16x8*)(qrow + 32 * s + 8 * (lane >> 4));
}
template <int NT, bool BAND>
__device__ __forceinline__ void att_core(const LAS unsigned char* Kimg, const LAS unsigned char* Vimg, int krow0, int kmin, int rot  ,
                                         const bf16x8 (&qf)[4]  , bf16* orow  , float* lse_out  , int lane) {
    const int fr = lane & 15, fq = lane >> 4;
    f32x4 sc[NT];
    const LAS unsigned char* kb = Kimg + fr * ATT_KSTR + 16 * fq;
#pragma unroll
    for (int T = 0; T < NT; ++T) { sc[T] = (f32x4){0.f, 0.f, 0.f, 0.f}; const int trow = (krow0 + rot + 16 * T) & 255;
#pragma unroll
        for (int s = 0; s < 4; ++s) { const bf16x8 kf = *(const LAS bf16x8*)(kb + trow * ATT_KSTR + 64 * s);
            sc[T] = __builtin_amdgcn_mfma_f32_16x16x32_bf16(kf, qf[s], sc[T], 0, 0, 0); } }
    const float NEG = -__builtin_inff();
    if (BAND) {
#pragma unroll
        for (int r = 0; r < 4; ++r) { if (4 * fq + r < fr) sc[0][r] = NEG; if (4 * fq + r > fr) sc[NT - 1][r] = NEG; }
        if (kmin > 0) {
#pragma unroll
            for (int T = 0; T < NT; ++T)
#pragma unroll
                for (int r = 0; r < 4; ++r) if (krow0 + 16 * T + 4 * fq + r < kmin) sc[T][r] = NEG;
        }
    }
    float mx = sc[0][0];
#pragma unroll
    for (int T = 0; T < NT; ++T)
#pragma unroll
        for (int r = 0; r < 4; ++r) mx = fmaxf(mx, sc[T][r]);
    mx = fmaxf(mx, __shfl_xor(mx, 16)); mx = fmaxf(mx, __shfl_xor(mx, 32));
    const float mL = mx * ATT_C2; float l = 0.f;
#pragma unroll
    for (int T = 0; T < NT; ++T)
#pragma unroll
        for (int r = 0; r < 4; ++r) { const float p = __builtin_amdgcn_exp2f(sc[T][r] * ATT_C2 - mL); sc[T][r] = p; l += p; }
    l += __shfl_xor(l, 16); l += __shfl_xor(l, 32);
    constexpr int NKS = (NT + 1) / 2;
    f32x4 oa[8];
#pragma unroll
    for (int c = 0; c < 8; ++c) oa[c] = (f32x4){0.f, 0.f, 0.f, 0.f};
    const LAS unsigned char* vb = Vimg + (4 * fq + (fr >> 2)) * ATT_KSTR + 8 * (fr & 3);
#pragma unroll
    for (int ks = 0; ks < NKS; ++ks) { const int vr0 = (krow0 + rot + 32 * ks) & 255, vr1 = (krow0 + rot + 32 * ks + 16) & 255;
        v4u pw; pw.x = cvtpk(sc[2 * ks][0], sc[2 * ks][1]); pw.y = cvtpk(sc[2 * ks][2], sc[2 * ks][3]);
        if (2 * ks + 1 < NT) { pw.z = cvtpk(sc[2 * ks + 1 < NT ? 2 * ks + 1 : 0][0], sc[2 * ks + 1 < NT ? 2 * ks + 1 : 0][1]); pw.w = cvtpk(sc[2 * ks + 1 < NT ? 2 * ks + 1 : 0][2], sc[2 * ks + 1 < NT ? 2 * ks + 1 : 0][3]); }
        else { pw.z = 0u; pw.w = 0u; }
        const bf16x8 pf = __builtin_bit_cast(bf16x8, pw);
#pragma unroll
        for (int c = 0; c < 8; ++c) { const s16x4 lo = vtr(vb + vr0 * ATT_KSTR + 32 * c), hi = vtr(vb + vr1 * ATT_KSTR + 32 * c);
            const bf16x8 vf = __builtin_shufflevector(lo, hi, 0, 1, 2, 3, 4, 5, 6, 7);
            oa[c] = __builtin_amdgcn_mfma_f32_16x16x32_bf16(vf, pf, oa[c], 0, 0, 0); }
    }
    const float rl = 1.0f / l;
#pragma unroll
    for (int c = 0; c < 8; ++c) { v2u o; o.x = cvtpk(oa[c][0] * rl, oa[c][1] * rl); o.y = cvtpk(oa[c][2] * rl, oa[c][3] * rl); *(GAS v2u*)(orow + 16 * c + 4 * fq) = o; }
    if (lse_out && fq == 0) *lse_out = mx * ATT_SCALE + __logf(l);
}
struct SaUnit { int g, d, qb, h; size_t tok0, col; };
__device__ __forceinline__ SaUnit sa_unit(int i, int per, int G, int bx) {
    int c, h;
    if (per > 0) { c = (bx >> 3) * per + i; h = bx & 7; } else { const int idx = bx + i * G; c = idx >> 3; h = idx & 7; }
    SaUnit u; u.g = c >> 7; const int cc = c & 127, sh = 2 * u.g, nblk = 32 >> sh; u.d = 1 << sh;
    u.qb = cc % nblk; const int t1 = cc / nblk, r = t1 % u.d, b = t1 / u.d; u.h = h;
    u.tok0 = (size_t)b * SEQ + r; u.col = (size_t)u.g * 1024 + h * 128; return u;
}
__device__ __forceinline__ void sa_issue(v4u (&stK)[8], v4u (&stV)[8], const bf16* K, const bf16* V, const SaUnit& u, bool shared, int tid) {
    const size_t gs = (size_t)u.d * QKVW; const int pb = 128 * (u.qb - 1) + (tid >> 4); const int fix = u.qb == 0 ? 128 : 0;
    const size_t base = u.tok0 * QKVW + u.col + (tid & 15) * 8;
    if (!shared) {
#pragma unroll
        for (int it = 0; it < 4; ++it) { const size_t off = base + (size_t)(pb + 32 * it + fix) * gs; stK[it] = *(const GAS v4u*)(K + off); stV[it] = *(const GAS v4u*)(V + off); } }
#pragma unroll
    for (int it = 4; it < 8; ++it) { const size_t off = base + (size_t)(pb + 32 * it) * gs; stK[it] = *(const GAS v4u*)(K + off); stV[it] = *(const GAS v4u*)(V + off); }
}
__device__ __forceinline__ void sa_write(const v4u (&stK)[8], const v4u (&stV)[8], LAS unsigned char* Kimg, LAS unsigned char* Vimg, bool shared, int rot, int tid) {
    if (!shared) {
#pragma unroll
        for (int it = 0; it < 4; ++it) { const int o = ((((tid >> 4) + 32 * it) + rot) & 255) * ATT_KSTR + (tid & 15) * 16; *(LAS v4u*)(Kimg + o) = stK[it]; *(LAS v4u*)(Vimg + o) = stV[it]; } }
#pragma unroll
    for (int it = 4; it < 8; ++it) { const int o = ((((tid >> 4) + 32 * it) + rot) & 255) * ATT_KSTR + (tid & 15) * 16; *(LAS v4u*)(Kimg + o) = stK[it]; *(LAS v4u*)(Vimg + o) = stV[it]; }
}
__device__ __forceinline__ void self_attn_stream(Frame& F, const bf16* Q, const bf16* K, const bf16* V, bf16* OG, float* LSE) {
    LAS unsigned char* Kimg = F.lds + ATT_K_OFF; LAS unsigned char* Vimg = F.lds + ATT_V_OFF;
    const int bx = (int)blockIdx.x, G = F.G, per = (G % 8 == 0 && 3072 % G == 0) ? 3072 / G : 0, n = per ? per : (3072 - bx + G - 1) / G;
    if (n <= 0) return;
    v4u stK[8], stV[8]; SaUnit u = sa_unit(0, per, G, bx); bool shared = false; int rot = 0;
    size_t tok = u.tok0 + (size_t)(128 * u.qb + 16 * F.wave + (F.lane & 15)) * u.d;
    bf16x8 qn[4]; att_q(qn, Q + tok * QKVW + u.col, F.lane);
    sa_issue(stK, stV, K, V, u, false, F.tid);
    for (int i = 0; i < n; ++i) {
        sa_write(stK, stV, Kimg, Vimg, shared, rot, F.tid);
        __syncthreads();
        bf16x8 qf[4];
#pragma unroll
        for (int s = 0; s < 4; ++s) qf[s] = qn[s];
        const int kmin = u.qb == 0 ? 128 : 0, crot = rot; bf16* orow = OG + ((size_t)u.g * M + tok) * AW + u.h * 128; float* lse = LSE + ((size_t)u.g * M + tok) * 8 + u.h;
        const bool more = i + 1 < n;
        if (more) { const SaUnit nu = sa_unit(i + 1, per, G, bx);
            shared = (nu.g == u.g) && (nu.tok0 == u.tok0) && (nu.h == u.h) && (nu.qb == u.qb + 1);
            rot = shared ? (rot ^ 128) : 0; u = nu;
            tok = u.tok0 + (size_t)(128 * u.qb + 16 * F.wave + (F.lane & 15)) * u.d;
            sa_issue(stK, stV, K, V, u, shared, F.tid); att_q(qn, Q + tok * QKVW + u.col, F.lane); }
        att_core<9, true>(Kimg, Vimg, 16 * F.wave, kmin, crot, qf, orow, lse, F.lane);
        __syncthreads();
    }
}
__device__ __forceinline__ void cross_attn_stream(Frame& F, const bf16* QX, const bf16* KVX, bf16* OX) {
    LAS unsigned char* Kimg = F.lds + ATT_K_OFF; LAS unsigned char* Vimg = F.lds + ATT_V_OFF;
    const int per = (512 % F.G == 0) ? 512 / F.G : 0;
    const int n = per ? per : (512 - (int)blockIdx.x + F.G - 1) / F.G; int loaded = -1;
    for (int i = 0; i < n; ++i) { const int idx = per ? (int)blockIdx.x * per + i : (int)blockIdx.x + i * F.G; if (idx >= 512) break;
        const int qblk = idx & 31, bh = idx >> 5, h = bh & 3, b = bh >> 2;
        if (bh != loaded) { if (loaded >= 0) __syncthreads();
            const size_t off = (size_t)b * NMEM * 1024 + h * 128;
            v4u stK[8], stV[8]; att_issue<256>(stK, KVX + off, 1024, F.tid); att_issue<256>(stV, KVX + off + 512, 1024, F.tid);
            att_write<256>(stK, Kimg, 0, F.tid); att_write<256>(stV, Vimg, 0, F.tid);
            __syncthreads(); loaded = bh; }
        const size_t tok = (size_t)b * SEQ + 128 * qblk + 16 * F.wave + (F.lane & 15);
        bf16x8 qf[4]; att_q(qf, QX + tok * XAW + h * 128, F.lane);
        att_core<16, false>(Kimg, Vimg, 0, 0, 0, qf, OX + tok * XAW + h * 128, nullptr, F.lane);
    }
    __syncthreads();
}
__device__ __forceinline__ void sgu_unit(Frame& F, int idx, const bf16* U, bf16* YB, const bf16* VB, const float* lnstat, const float* lng, const float* lnb, const bf16* WSP, const float* bsp) {
    const int g = idx & 15, cn = idx >> 4, C0 = g * 128; const size_t tok0 = (size_t)cn * 128;
    LAS unsigned char* img = F.lds; LAS f32x2* stat = (LAS f32x2*)(F.lds + 40960);
    if (F.tid < 128) { const float* sp = lnstat + (tok0 + F.tid) * 64; float s = 0.f, q = 0.f;
#pragma unroll
        for (int k = 0; k < 16; ++k) { const f32x4 v = *(const GAS f32x4*)(sp + 4 * k); s += v.x + v.z; q += v.y + v.w; }
        const float mu = s * (1.f / 2048.f), var = q * (1.f / 2048.f) - mu * mu; stat[F.tid] = (f32x2){mu, 1.0f / sqrtf(var + EPS)}; }
    __syncthreads();
    { const int ch = F.tid & 15; const float* gp = lng + C0 + 8 * ch; const float* bp = lnb + C0 + 8 * ch;
      const f32x4 g0 = *(const GAS f32x4*)gp, g1 = *(const GAS f32x4*)(gp + 4), b0 = *(const GAS f32x4*)bp, b1 = *(const GAS f32x4*)(bp + 4);
      v4u raw[4];
#pragma unroll
      for (int it = 0; it < 4; ++it) raw[it] = *(const GAS v4u*)(VB + (tok0 + (F.tid >> 4) + 32 * it) * SGW + C0 + 8 * ch);
#pragma unroll
      for (int it = 0; it < 4; ++it) { const int j = (F.tid >> 4) + 32 * it; const f32x2 st = stat[j]; const v4u w = raw[it]; v4u o;
          o.x = cvtpk((bflo(w.x) - st.x) * st.y * g0.x + b0.x, (bfhi(w.x) - st.x) * st.y * g0.y + b0.y); o.y = cvtpk((bflo(w.y) - st.x) * st.y * g0.z + b0.z, (bfhi(w.y) - st.x) * st.y * g0.w + b0.w);
          o.z = cvtpk((bflo(w.z) - st.x) * st.y * g1.x + b1.x, (bfhi(w.z) - st.x) * st.y * g1.y + b1.y); o.w = cvtpk((bflo(w.w) - st.x) * st.y * g1.z + b1.z, (bfhi(w.w) - st.x) * st.y * g1.w + b1.w);
          *(LAS v4u*)(img + j * ATT_KSTR + ch * 16) = o; } }
    __syncthreads();
    const int fr = F.lane & 15, fq = F.lane >> 4, w = F.wave, nsteps = (w >> 1) + 1;
    f32x4 acc[8];
#pragma unroll
    for (int c = 0; c < 8; ++c) acc[c] = (f32x4){0.f, 0.f, 0.f, 0.f};
    const bf16* wrow = WSP + ((size_t)g * 128 + 16 * w + fr) * 128 + 8 * fq;
    const LAS unsigned char* vb = img + (8 * fq + (fr >> 2)) * ATT_KSTR + 8 * (fr & 3);
    for (int s = 0; s < nsteps; ++s) { const bf16x8 wf = *(const GAS bf16x8*)(wrow + 32 * s);
#pragma unroll
        for (int c = 0; c < 8; ++c) { const s16x4 lo = vtr(vb + (32 * s) * ATT_KSTR + 32 * c), hi = vtr(vb + (32 * s + 4) * ATT_KSTR + 32 * c);
            const bf16x8 vf = __builtin_shufflevector(lo, hi, 0, 1, 2, 3, 4, 5, 6, 7);
            acc[c] = __builtin_amdgcn_mfma_f32_16x16x32_bf16(vf, wf, acc[c], 0, 0, 0); } }
    const float bias = bsp[g * 128 + 16 * w + fr];
    const bf16* urow = U + (tok0 + 16 * w + fr) * SGW + C0 + 4 * fq; bf16* yrow = YB + (tok0 + 16 * w + fr) * (AW + SGW) + AW + C0 + 4 * fq;
#pragma unroll
    for (int c = 0; c < 8; ++c) { const v2u uw = *(const GAS v2u*)(urow + 16 * c); v2u o;
        o.x = cvtpk(bflo(uw.x) * (acc[c][0] + bias), bfhi(uw.x) * (acc[c][1] + bias)); o.y = cvtpk(bflo(uw.y) * (acc[c][2] + bias), bfhi(uw.y) * (acc[c][3] + bias));
        *(GAS v2u*)(yrow + 16 * c) = o; }
    __syncthreads();
}

__device__ __forceinline__ void sgu_stream(Frame& F, int per, const bf16* U, bf16* YB, const bf16* VB, const float* lnstat, const float* lng, const float* lnb, const bf16* WSP, const float* bsp) {
    const int idx0 = (int)blockIdx.x * per, cn = idx0 >> 4, g0 = idx0 & 15; const size_t tok0 = (size_t)cn * 128;
    LAS unsigned char* img = F.lds; LAS f32x2* stat = (LAS f32x2*)(F.lds + 40960);
    if (F.tid < 128) { const float* sp = lnstat + (tok0 + F.tid) * 64; float s = 0.f, q = 0.f;
#pragma unroll
        for (int k = 0; k < 16; ++k) { const f32x4 v = *(const GAS f32x4*)(sp + 4 * k); s += v.x + v.z; q += v.y + v.w; }
        const float mu = s * (1.f / 2048.f), var = q * (1.f / 2048.f) - mu * mu; stat[F.tid] = (f32x2){mu, 1.0f / sqrtf(var + EPS)}; }
    const int ch = F.tid & 15, fr = F.lane & 15, fq = F.lane >> 4, w = F.wave, nsteps = (w >> 1) + 1;
    v4u raw[4];
#pragma unroll
    for (int it = 0; it < 4; ++it) raw[it] = *(const GAS v4u*)(VB + (tok0 + (F.tid >> 4) + 32 * it) * SGW + g0 * 128 + 8 * ch);
    __syncthreads();
    const LAS unsigned char* vb = img + (8 * fq + (fr >> 2)) * ATT_KSTR + 8 * (fr & 3);
    for (int i = 0; i < per; ++i) { const int g = g0 + i, C0 = g * 128;
        { const float* gp = lng + C0 + 8 * ch; const float* bp = lnb + C0 + 8 * ch;
          const f32x4 ga = *(const GAS f32x4*)gp, gb = *(const GAS f32x4*)(gp + 4), ba = *(const GAS f32x4*)bp, bb = *(const GAS f32x4*)(bp + 4);
#pragma unroll
          for (int it = 0; it < 4; ++it) { const int j = (F.tid >> 4) + 32 * it; const f32x2 st = stat[j]; const v4u wv = raw[it]; v4u o;
              o.x = cvtpk((bflo(wv.x) - st.x) * st.y * ga.x + ba.x, (bfhi(wv.x) - st.x) * st.y * ga.y + ba.y); o.y = cvtpk((bflo(wv.y) - st.x) * st.y * ga.z + ba.z, (bfhi(wv.y) - st.x) * st.y * ga.w + ba.w);
              o.z = cvtpk((bflo(wv.z) - st.x) * st.y * gb.x + bb.x, (bfhi(wv.z) - st.x) * st.y * gb.y + bb.y); o.w = cvtpk((bflo(wv.w) - st.x) * st.y * gb.z + bb.z, (bfhi(wv.w) - st.x) * st.y * gb.w + bb.w);
              *(LAS v4u*)(img + j * ATT_KSTR + ch * 16) = o; } }
        __syncthreads();
        const bf16* wrow = WSP + ((size_t)g * 128 + 16 * w + fr) * 128 + 8 * fq;
        bf16x8 wf[4];
#pragma unroll
        for (int s = 0; s < 4; ++s) wf[s] = *(const GAS bf16x8*)(wrow + 32 * (s < nsteps ? s : 0));
        const bf16* urow = U + (tok0 + 16 * w + fr) * SGW + C0 + 4 * fq; bf16* yrow = YB + (tok0 + 16 * w + fr) * (AW + SGW) + AW + C0 + 4 * fq;
        v2u uw[8];
#pragma unroll
        for (int c = 0; c < 8; ++c) uw[c] = *(const GAS v2u*)(urow + 16 * c);
        const float bias = bsp[g * 128 + 16 * w + fr];
        if (i + 1 < per) {
#pragma unroll
            for (int it = 0; it < 4; ++it) raw[it] = *(const GAS v4u*)(VB + (tok0 + (F.tid >> 4) + 32 * it) * SGW + C0 + 128 + 8 * ch); }
        f32x4 acc[8];
#pragma unroll
        for (int c = 0; c < 8; ++c) acc[c] = (f32x4){0.f, 0.f, 0.f, 0.f};
#pragma unroll
        for (int s = 0; s < 4; ++s) { if (s < nsteps) {
#pragma unroll
            for (int c = 0; c < 8; ++c) { const s16x4 lo = vtr(vb + (32 * s) * ATT_KSTR + 32 * c), hi = vtr(vb + (32 * s + 4) * ATT_KSTR + 32 * c);
                const bf16x8 vf = __builtin_shufflevector(lo, hi, 0, 1, 2, 3, 4, 5, 6, 7);
                acc[c] = __builtin_amdgcn_mfma_f32_16x16x32_bf16(vf, wf[s], acc[c], 0, 0, 0); } } }
#pragma unroll
        for (int c = 0; c < 8; ++c) { v2u o;
            o.x = cvtpk(bflo(uw[c].x) * (acc[c][0] + bias), bfhi(uw[c].x) * (acc[c][1] + bias)); o.y = cvtpk(bflo(uw[c].y) * (acc[c][2] + bias), bfhi(uw[c].y) * (acc[c][3] + bias));
            *(GAS v2u*)(yrow + 16 * c) = o; }
        __syncthreads();
    }
}

struct ConvJob { const float* W; bf16* WT; int K, N, row_off, ldk, koff, item, fp8; };
__device__ __forceinline__ void conv_load(f32x4 (&v)[16], const ConvJob& j, int lane) {
    const int nblk = j.N >> 6, kb = j.item / nblk, nb = j.item - kb * nblk;
    const float* src = j.W + (size_t)(64 * kb + (lane >> 4)) * j.N + 64 * nb + 4 * (lane & 15); const size_t st = (size_t)4 * j.N;
#pragma unroll
    for (int i = 0; i < 16; ++i) v[i] = *(const GAS f32x4*)(src + i * st);
}
__device__ __forceinline__ void conv_to_lds(const f32x4 (&v)[16], LAS unsigned char* scr, int lane) {
#pragma unroll
    for (int i = 0; i < 16; ++i) { v2u o; o.x = cvt2(v[i].x, v[i].y); o.y = cvt2(v[i].z, v[i].w); *(LAS v2u*)(scr + ((lane >> 4) + 4 * i) * 144 + 8 * (lane & 15)) = o; }
}
__device__ __forceinline__ void conv_store(const ConvJob& j, const LAS unsigned char* scr, int lane) {
    const int nblk = j.N >> 6, kb = j.item / nblk, nb = j.item - kb * nblk, i16 = lane & 15, fq = lane >> 4;
    const LAS unsigned char* rb = scr + (8 * fq + (i16 >> 2)) * 144 + 8 * (i16 & 3);
    bf16* dst = j.WT + (size_t)(j.row_off + 64 * nb + i16) * j.ldk + j.koff + 64 * kb + 8 * fq;
#pragma unroll
    for (int jj = 0; jj < 8; ++jj) { const int nb16 = jj & 3, kh = jj >> 2;
        const s16x4 lo = vtr(rb + (32 * kh) * 144 + 32 * nb16), hi = vtr(rb + (32 * kh + 4) * 144 + 32 * nb16);
        const bf16x8 o = __builtin_shufflevector(lo, hi, 0, 1, 2, 3, 4, 5, 6, 7);
        if (j.fp8) { const v4u w = __builtin_bit_cast(v4u, o); v2u q;
            q.x = fp8x4(bflo(w.x) * FP8_SW, bfhi(w.x) * FP8_SW, bflo(w.y) * FP8_SW, bfhi(w.y) * FP8_SW); q.y = fp8x4(bflo(w.z) * FP8_SW, bfhi(w.z) * FP8_SW, bflo(w.w) * FP8_SW, bfhi(w.w) * FP8_SW);
            *(GAS v2u*)((unsigned char*)j.WT + (size_t)(j.row_off + 64 * nb + i16 + 16 * nb16) * j.ldk + j.koff + 64 * kb + 8 * fq + 32 * kh) = q; }
        else *(GAS bf16x8*)(dst + (size_t)(16 * nb16) * j.ldk + 32 * kh) = o; }
}
#define CONV_STREAM(LO_, HI_, CTR_, DECODE_) do { \
        LAS unsigned char* scr_ = F.lds + RING_OFF + F.wave * 16384; volatile LAS unsigned* tkL_ = (volatile LAS unsigned*)(F.lds + MISC_OFF + 64); \
        f32x4 cv_[16]; ConvJob cur_, nxt_; unsigned tv_ = 0u; int rnd_ = 0; \
        if (F.tid == 0) { tkL_[0] = __hip_atomic_fetch_add((CTR_), 1u, __ATOMIC_RELAXED, __HIP_MEMORY_SCOPE_AGENT); tkL_[1] = __hip_atomic_fetch_add((CTR_), 1u, __ATOMIC_RELAXED, __HIP_MEMORY_SCOPE_AGENT); } \
        __syncthreads(); \
        int tc_ = (int)tkL_[0], tn_ = (int)tkL_[1]; \
        __syncthreads(); \
        int it_ = (LO_) + 8 * tc_ + F.wave; bool have_ = it_ < (HI_); \
        if (have_) { DECODE_(it_, cur_); conv_load(cv_, cur_, F.lane); } \
        while ((LO_) + 8 * tc_ < (HI_)) { \
            if (F.tid == 0) tv_ = __hip_atomic_fetch_add((CTR_), 1u, __ATOMIC_RELAXED, __HIP_MEMORY_SCOPE_AGENT); \
            if (have_) conv_to_lds(cv_, scr_, F.lane); \
            const int itn_ = (LO_) + 8 * tn_ + F.wave; const bool more_ = itn_ < (HI_); \
            if (more_) { DECODE_(itn_, nxt_); conv_load(cv_, nxt_, F.lane); } \
            if (have_) { asm volatile("s_waitcnt lgkmcnt(0)" ::: "memory"); conv_store(cur_, scr_, F.lane); asm volatile("s_waitcnt lgkmcnt(0)" ::: "memory"); } \
            if (F.tid == 0) tkL_[rnd_ & 1] = tv_; \
            __syncthreads(); \
            tc_ = tn_; tn_ = (int)tkL_[rnd_ & 1]; cur_ = nxt_; have_ = more_; ++rnd_; } \
        __syncthreads(); \
    } while (0)

struct Args { const float* in[26]; float* out; unsigned char* ws; int ph_lo, ph_hi, li, pad; };
constexpr float ROPE_INV[16] = {1.0f, 0.44036659598350525f, 0.1939227432012558f, 0.08539710193872452f, 0.03760603070259094f, 0.01656043902039528f, 0.007292664609849453f, 0.0032114458736032248f,
    0.0014142135623842478f, 0.000622772378847003f, 0.00027424818836152554f, 0.00012076973507646471f, 5.318296098266728e-05f, 2.34199997066753e-05f, 1.0313386155758053e-05f, 4.541670477919979e-06f};

__global__ void __launch_bounds__(NWAVES * 64, 2) skel_fwd(Args args) {
    extern __shared__ __attribute__((aligned(16))) unsigned char lds[];
    Frame F;
    F.lds = (LAS unsigned char*)lds;
    F.MISC = (volatile LAS unsigned*)(F.lds + MISC_OFF);
    F.tid = threadIdx.x; F.lane = F.tid & 63; F.wave = __builtin_amdgcn_readfirstlane(F.tid >> 6);
    F.G = gridDim.x; { const int bx = blockIdx.x; F.vcu = (F.G % 8 == 0) ? (bx % 8) * (F.G / 8) + bx / 8 : bx; }
    unsigned char* ws = args.ws; F.ws = ws;
    F.ctl = (gu32*)(ws + WS_CTL);
    const float* x = args.in[0]; const float* mem = args.in[1]; const int* positions = (const int*)args.in[2]; const float* mix_pre_g = args.in[3]; const float* w_in = args.in[4];
    const float* sgu_ln_g = args.in[5]; const float* sgu_ln_b = args.in[6]; const float* w_spatial = args.in[7]; const float* b_spatial = args.in[8];
    const float* w_branch_a = args.in[9]; const float* w_branch_b = args.in[10]; const float* w_gate = args.in[11]; const float* b_gate = args.in[12]; const float* w_out = args.in[13];
    const float* mix_post_g = args.in[14]; const float* xa_pre_g = args.in[15]; const float* mem_norm_g = args.in[16];
    const float* w_xq = args.in[17]; const float* w_xk = args.in[18]; const float* w_xv = args.in[19]; const float* w_xo = args.in[20];
    const float* xa_post_g = args.in[21]; const float* mlp_pre_g = args.in[22]; const float* w_up = args.in[23]; const float* w_down = args.in[24]; const float* mlp_post_g = args.in[25];
    float* out = args.out;
    float* ROPE = (float*)(ws + WS_ROPE); float* LNST = (float*)(ws + WS_LNST); float* SSQ = (float*)(ws + WS_SSQ); float* LSE = (float*)(ws + WS_LSE);
    bf16* WSP = (bf16*)(ws + WS_WSP); bf16* WING = (bf16*)(ws + WS_WING); unsigned char* WG8 = ws + WS_WG8; unsigned char* H8 = ws + WS_H8; bf16* WAB = (bf16*)(ws + WS_WA); bf16* WOUT = (bf16*)(ws + WS_WOUT);
    bf16* WXQ = (bf16*)(ws + WS_WXQ); bf16* WKV = (bf16*)(ws + WS_WKV); bf16* WXO = (bf16*)(ws + WS_WXO); bf16* WUP = (bf16*)(ws + WS_WUP); bf16* WDN = (bf16*)(ws + WS_WDN);
    bf16* H = (bf16*)(ws + WS_H); bf16* Qb = (bf16*)(ws + WS_Q); bf16* Kb = (bf16*)(ws + WS_K); bf16* Vb = (bf16*)(ws + WS_V); bf16* Ub = (bf16*)(ws + WS_U); bf16* VBb = (bf16*)(ws + WS_VB);
    unsigned char* Gb = ws + WS_G; bf16* MRG = (bf16*)(ws + WS_MRG); bf16* OG = (bf16*)(ws + WS_OG); bf16* KVX = (bf16*)(ws + WS_KVX); bf16* MB = (bf16*)(ws + WS_MB);
    bf16* T = (bf16*)(ws + WS_T); bf16* QX = (bf16*)(ws + WS_QX); bf16* OX = (bf16*)(ws + WS_OX); bf16* Ab = (bf16*)(ws + WS_A); bf16* T3 = (bf16*)(ws + WS_T3); bf16* XB = (bf16*)(ws + WS_XB); bf16* YAB = (bf16*)(ws + WS_YAB); constexpr int YABW = AW + SGW;

    for (int u = F.tid; u < (LDS_BYTES - MISC_OFF) / 4; u += NWAVES * 64) ((LAS unsigned*)(F.lds + MISC_OFF))[u] = 0u;
    __syncthreads();
#if MK_PER_PHASE
#define GRID_BAR() do { } while (0)
#else
    XcdBarrier bar = xcd_barrier_post((unsigned*)(F.ctl + CW_BAR) + args.li * XCD_BAR_WORDS, F.MISC + 8);
#define GRID_BAR() xcd_barrier(bar)
#endif
    const int lo = args.ph_lo, hi = args.ph_hi;
#define IN(k) (lo <= (k) && (k) < hi)
#define BOTH(k) (IN(k) && IN((k) + 1))
    const int gw = F.vcu * NWAVES + F.wave, NGW = F.G * NWAVES, bx = (int)blockIdx.x;
    const int gtid = bx * (NWAVES * 64) + F.tid, NGT = F.G * NWAVES * 64;
    constexpr int I_UP = 64 * (DFF / 64), I_DN = (DFF / 64) * (DM / 64), P7_BUSY = 144, CONV_PER_WAVE = CPW_KNOB;
    const int conv_early = (F.G > P7_BUSY) ? (((F.G - P7_BUSY) * NWAVES * CONV_PER_WAVE < I_UP + I_DN) ? (F.G - P7_BUSY) * NWAVES * CONV_PER_WAVE : I_UP + I_DN) : 0;

    if (IN(0)) {
        constexpr int I_IN = 64 * (INW / 64), I_G = 64 * (GW / 64), I_A = 16 * 64, I_B = 32 * 64, I_O = 64 * 64, I_XQ = 64 * 8, I_XO = 8 * 64;
        constexpr int NITEMS = I_IN + I_G + I_A + I_B + I_O + 3 * I_XQ + I_XO;
#define P0_DECODE(r_, J) do { int r = (r_); \
            if (r < I_IN) { J = ConvJob{w_in, WING, DM, INW, 0, DM, 0, r, 0}; break; } r -= I_IN; \
            if (r < I_G) { J = ConvJob{w_gate, (bf16*)WG8, DM, GW, 0, DM, 0, r, 1}; break; } r -= I_G; \
            if (r < I_A) { J = ConvJob{w_branch_a, WAB, AW, DM, 0, AW + SGW, 0, r, 0}; break; } r -= I_A; \
            if (r < I_B) { J = ConvJob{w_branch_b, WAB, SGW, DM, 0, AW + SGW, AW, r, 0}; break; } r -= I_B; \
            if (r < I_O) { J = ConvJob{w_out, WOUT, DM, DM, 0, DM, 0, r, 0}; break; } r -= I_O; \
            if (r < I_XQ) { J = ConvJob{w_xq, WXQ, DM, XAW, 0, DM, 0, r, 0}; break; } r -= I_XQ; \
            if (r < I_XQ) { J = ConvJob{w_xk, WKV, DM, XAW, 0, DM, 0, r, 0}; break; } r -= I_XQ; \
            if (r < I_XQ) { J = ConvJob{w_xv, WKV, DM, XAW, XAW, DM, 0, r, 0}; break; } r -= I_XQ; \
            J = ConvJob{w_xo, WXO, XAW, DM, 0, XAW, 0, r, 0}; } while (0)
        for (int m = gw; m < M; m += NGW) rms_row_to_bf16(x + (size_t)m * DM, mix_pre_g, H + (size_t)m * DM, F.lane, H8 + (size_t)m * DM);
        for (int m = gw; m < MROWS; m += NGW) rms_row_to_bf16(mem + (size_t)m * DM, mem_norm_g, MB + (size_t)m * DM, F.lane);
        __syncthreads();
        CONV_STREAM(0, NITEMS, F.ctl + CW_TICKET, P0_DECODE);
#undef P0_DECODE
        for (int i = gtid; i < M * 16; i += NGT) { const int tok = i >> 4, k = i & 15; const float ang = (float)positions[tok] * ROPE_INV[k]; float sn, cs; sincos_d(ang, sn, cs);
            ROPE[(size_t)tok * 32 + k] = cs; ROPE[(size_t)tok * 32 + 16 + k] = sn; }
        for (int i = gtid; i < 16 * 128 * 128; i += NGT) { const int jj = i & 127, ii = (i >> 7) & 127; WSP[i] = (bf16)(jj <= ii ? f2bf(w_spatial[i]) : 0u); }
        if (BOTH(0)) GRID_BAR();
    }
    if (IN(1)) {
        { pg8::Gemm g{H, WING, M, INW, DM}; pg8::StaticOrder S; S.init(M, INW, F.G, bx);
          pg8::EpiProj E{Qb, Kb, Vb, Ub, VBb, Gb, ROPE, b_gate, LNST};
          pg8::gemm_phase<pg8::EpiProj, pg8::StaticOrder, PG8_ALIGN, PG8_SP2>(F.lds + RING_OFF, g, S, E); }
        VM_WAIT(); __syncthreads();
        { pg8::Gemm g{(const bf16*)H8, (const bf16*)WG8, M, GW, DM / 2}; pg8::StaticOrder S; S.init(M, GW, F.G, bx);
          pg8::EpiGates E{Gb, b_gate, 1.0f / (FP8_SH * FP8_SW)};
          pg8::gemm_phase<pg8::EpiGates, pg8::StaticOrder, PG8_ALIGN, PG8_SP2, true>(F.lds + RING_OFF, g, S, E); }
        if (BOTH(1)) GRID_BAR();
    }
    if (IN(2)) {
        for (int i = F.tid; i < 16 * ATT_KSTR / 4; i += NWAVES * 64) ((LAS unsigned*)(F.lds + ATT_V_OFF + 256 * ATT_KSTR))[i] = 0u;
        __syncthreads();
        self_attn_stream(F, Qb, Kb, Vb, OG, LSE);
        { const int per = (2048 % F.G == 0) ? 2048 / F.G : 0;
          if (per == 1 || per == 2 || per == 4 || per == 8 || per == 16) sgu_stream(F, per, Ub, YAB, VBb, LNST, sgu_ln_g, sgu_ln_b, WSP, b_spatial);
          else for (int idx = bx; idx < 2048; idx += F.G) sgu_unit(F, idx, Ub, YAB, VBb, LNST, sgu_ln_g, sgu_ln_b, WSP, b_spatial); }
        if (BOTH(2)) GRID_BAR();
    }
    if (IN(3)) {
        for (int i = gtid; i < M * 8 * 16; i += NGT) { const int ch = i & 15, hh = (i >> 4) & 7; const size_t tok = (size_t)(i >> 7);
            const float l0 = LSE[tok * 8 + hh], l1 = LSE[((size_t)M + tok) * 8 + hh], l2 = LSE[((size_t)2 * M + tok) * 8 + hh];
            const float mx = fmaxf(l0, fmaxf(l1, l2)); float e0 = __expf(l0 - mx), e1 = __expf(l1 - mx), e2 = __expf(l2 - mx); const float inv = 1.0f / (e0 + e1 + e2); e0 *= inv; e1 *= inv; e2 *= inv;
            const size_t o = tok * AW + hh * 128 + ch * 8;
            const v4u a = *(const GAS v4u*)(OG + o), b = *(const GAS v4u*)(OG + (size_t)M * AW + o), c = *(const GAS v4u*)(OG + (size_t)2 * M * AW + o); v4u y;
            y.x = pk2(e0 * bflo(a.x) + e1 * bflo(b.x) + e2 * bflo(c.x), e0 * bfhi(a.x) + e1 * bfhi(b.x) + e2 * bfhi(c.x));
            y.y = pk2(e0 * bflo(a.y) + e1 * bflo(b.y) + e2 * bflo(c.y), e0 * bfhi(a.y) + e1 * bfhi(b.y) + e2 * bfhi(c.y));
            y.z = pk2(e0 * bflo(a.z) + e1 * bflo(b.z) + e2 * bflo(c.z), e0 * bfhi(a.z) + e1 * bfhi(b.z) + e2 * bfhi(c.z));
            y.w = pk2(e0 * bflo(a.w) + e1 * bflo(b.w) + e2 * bflo(c.w), e0 * bfhi(a.w) + e1 * bfhi(b.w) + e2 * bfhi(c.w));
            *(GAS v4u*)(YAB + tok * YABW + hh * 128 + ch * 8) = y; }
        if (BOTH(3)) GRID_BAR();
    }
    if (IN(4)) {
        pg8::Gemm g{YAB, WAB, M, DM, YABW}; pg8::StaticOrder S; S.init(M, DM, F.G, bx); pg8::EpiMerge E{Gb, MRG, AW / pg8::BK};
        pg8::gemm_phase<pg8::EpiMerge, pg8::StaticOrder, PG8_ALIGN, PG8_SP2>(F.lds + RING_OFF, g, S, E);
        if (BOTH(4)) GRID_BAR();
    }
    if (IN(5)) {
        pg8::Gemm g{MRG, WOUT, M, DM, DM}; pg8::StaticOrder S; S.init(M, DM, F.G, bx); pg8::EpiNorm E{T, DM, SSQ};
        pg8::gemm_phase<pg8::EpiNorm, pg8::StaticOrder, PG8_ALIGN, PG8_SP2>(F.lds + RING_OFF, g, S, E);
        if (BOTH(5)) GRID_BAR();
    }
    if (IN(6)) {
        row_phase<false, true, true>(F, x, T, SSQ, mix_post_g, xa_pre_g, XB, H, gw, NGW);
#define P6_DECODE(r_, J) do { const int r = (r_); if (r < I_UP) J = ConvJob{w_up, WUP, DM, DFF, 0, DM, 0, r, 0}; else J = ConvJob{w_down, WDN, DFF, DM, 0, DFF, 0, r - I_UP, 0}; } while (0)
        __syncthreads();
        CONV_STREAM(conv_early, I_UP + I_DN, F.ctl + CW_TICKET + 64, P6_DECODE);
        if (BOTH(6)) GRID_BAR();
    }
    if (IN(7)) {
        if (bx < 128) { pg8::Gemm g{H, WXQ, M, XAW, DM}; pg8::SmallOrder S; S.init(M, XAW, 0, bx); pg8::EpiPlain E{QX, XAW};
            pg8::gemm_phase<pg8::EpiPlain, pg8::SmallOrder, false, PG8_SP2>(F.lds + RING_OFF, g, S, E); }
        else if (bx < P7_BUSY) { pg8::Gemm g{MB, WKV, MROWS, 2 * XAW, DM}; pg8::SmallOrder S; S.init(MROWS, 2 * XAW, 128, bx); pg8::EpiPlain E{KVX, 2 * XAW};
            pg8::gemm_phase<pg8::EpiPlain, pg8::SmallOrder, false, PG8_SP2>(F.lds + RING_OFF, g, S, E); }
        if (bx < P7_BUSY) { VM_WAIT(); __syncthreads(); }
        CONV_STREAM(0, conv_early, F.ctl + CW_TICKET + 128, P6_DECODE);
#undef P6_DECODE
        if (BOTH(7)) GRID_BAR();
    }
    if (IN(8)) {
        cross_attn_stream(F, QX, KVX, OX);
        if (BOTH(8)) GRID_BAR();
    }
    if (IN(9)) {
        pg8::Gemm g{OX, WXO, M, DM, XAW}; pg8::StaticOrder S; S.init(M, DM, F.G, bx); pg8::EpiNorm E{T, DM, SSQ};
        pg8::gemm_phase<pg8::EpiNorm, pg8::StaticOrder, PG8_ALIGN, PG8_SP2>(F.lds + RING_OFF, g, S, E);
        if (BOTH(9)) GRID_BAR();
    }
    if (IN(10)) {
        row_phase<true, true, true>(F, XB, T, SSQ, xa_post_g, mlp_pre_g, XB, H, gw, NGW);
        if (BOTH(10)) GRID_BAR();
    }
    if (IN(11)) {
        pg8::Gemm g{H, WUP, M, DFF, DM}; pg8::StaticOrder S; S.init(M, DFF, F.G, bx); pg8::EpiRelu2 E{Ab, DFF};
        pg8::gemm_phase<pg8::EpiRelu2, pg8::StaticOrder, false, PG8_SP2>(F.lds + RING_OFF, g, S, E);
        if (BOTH(11)) GRID_BAR();
    }
    if (IN(12)) {
        pg8::Gemm g{Ab, WDN, M, DM, DFF}; pg8::StaticOrder S; S.init(M, DM, F.G, bx); pg8::EpiNorm E{T3, DM, SSQ};
        pg8::gemm_phase<pg8::EpiNorm, pg8::StaticOrder, PG8_ALIGN, PG8_SP2>(F.lds + RING_OFF, g, S, E);
        if (BOTH(12)) GRID_BAR();
    }
    if (IN(13)) {
        row_phase<true, false, false>(F, XB, T3, SSQ, mlp_post_g, nullptr, out, nullptr, gw, NGW);
    }
#undef IN
#undef BOTH
}

extern "C" void kernel_launch(void* const* d_in, const int* in_sizes, int n_in, void* d_out, int out_size, void* d_ws, size_t ws_size, hipStream_t stream) {
    static int grid = 0;
    if (grid == 0) {
        if (n_in != 26 || in_sizes[0] != M * DM || out_size != M * DM || ws_size < WS_END) { fprintf(stderr, "kernel_launch: unexpected shapes (n_in %d, in0 %d, out %d, ws %zu < %zu?); nothing launched\n", n_in, n_in > 0 ? in_sizes[0] : -1, out_size, ws_size, (size_t)WS_END); grid = -1; return; }
        int dev = 0, cus = 0, per_cu = 0;
        if (hipGetDevice(&dev) != hipSuccess || hipDeviceGetAttribute(&cus, hipDeviceAttributeMultiprocessorCount, dev) != hipSuccess) { grid = -1; return; }
        if (hipFuncSetAttribute((const void*)skel_fwd, hipFuncAttributeMaxDynamicSharedMemorySize, LDS_BYTES) != hipSuccess) { fprintf(stderr, "kernel_launch: hipFuncSetAttribute failed\n"); grid = -1; return; }
        if (hipOccupancyMaxActiveBlocksPerMultiprocessor(&per_cu, (const void*)skel_fwd, NWAVES * 64, LDS_BYTES) != hipSuccess || per_cu < 1)
            fprintf(stderr, "kernel_launch: note: occupancy query reports %d workgroups per CU\n", per_cu);
        (void)hipGetLastError();
        grid = cus;
    }
    if (grid < 0) return;
    if (hipMemsetAsync((char*)d_ws + WS_CTL, 0, CTL_ZERO_BYTES, stream) != hipSuccess) return;
    Args a{};
    for (int i = 0; i < 26; ++i) a.in[i] = (const float*)d_in[i];
    a.out = (float*)d_out; a.ws = (unsigned char*)d_ws;
#if MK_PER_PHASE
    for (int li = 0; li < N_PHASES; ++li) { a.ph_lo = li; a.ph_hi = li + 1; a.li = li;
        hipLaunchKernelGGL(skel_fwd, dim3(grid), dim3(NWAVES * 64), LDS_BYTES, stream, a); }
#else
#if defined(PROBE_DUP)
    a.ph_lo = 0; a.ph_hi = PROBE_DUP + 1; a.li = 0;
    hipLaunchKernelGGL(skel_fwd, dim3(grid), dim3(NWAVES * 64), LDS_BYTES, stream, a);
    a.ph_lo = PROBE_DUP; a.ph_hi = N_PHASES; a.li = 1;
    hipLaunchKernelGGL(skel_fwd, dim3(grid), dim3(NWAVES * 64), LDS_BYTES, stream, a);
#else
    a.ph_lo = 0; a.ph_hi = N_PHASES; a.li = 0;
    hipLaunchKernelGGL(skel_fwd, dim3(grid), dim3(NWAVES * 64), LDS_BYTES, stream, a);
#endif
#endif
    const hipError_t le = hipPeekAtLastError();
    if (le != hipSuccess) fprintf(stderr, "kernel_launch: launch failed: %s\n", hipGetErrorName(le));
}
```

```cpp
#include <hip/hip_runtime.h>
#ifndef MID_FENCE
#define MID_FENCE 2
#endif
#include <cstdio>
#include <cstdint>
namespace pg8 {
#define PG8_LAS __attribute__((address_space(3)))
typedef unsigned short bf16_t;
typedef short bf16x8 __attribute__((ext_vector_type(8)));
typedef float f32x4 __attribute__((ext_vector_type(4)));
typedef unsigned u32x4 __attribute__((ext_vector_type(4)));
constexpr int BM = 256, BK = 64, HALF = 128, HTB = HALF * BK * 2  , STAGE_BYTES = 8 * HTB, NXCD = 8, WGM = 8;

__host__ __device__ __forceinline__ int lds_byte(int r, int c) { const int st = (r >> 4) * 2 + (c >> 5), rr = r & 15, cc = c & 31, ob = rr * 64 + cc * 2; return st * 1024 + (ob ^ (((ob >> 9) & 1) << 5)); }
__host__ __device__ __forceinline__ void stage_rc(int b, int& R, int& C) { const int st = b / 1024, sb = b % 1024, swz = sb ^ (((sb >> 9) & 1) << 5); R = (st >> 1) * 16 + swz / 64; C = (st & 1) * 32 + (swz % 64) / 2; }
__host__ __device__ __forceinline__ int perm32(int rho) { const int n = rho >> 4, i = rho & 15; return 8 * (i >> 2) + 4 * n + (i & 3); }

struct Unit { int pm, pn; };
struct Gemm { const bf16_t* A; const bf16_t* Bt; int M, N, K; };

struct StaticOrder {
    int nM, nN, nwg, G, c;
    __host__ __device__ void init(int M, int N, int G_, int c_) { nM = M / BM; nN = N / BM; nwg = nM * nN; G = G_; c = c_; }
    __host__ __device__ bool next(int i, Unit& u) const {
        const long L = (long)i * G + c; if (L >= nwg) return false;
        int wgid = (int)L; { const int q = nwg / NXCD, r = nwg % NXCD, xcd = wgid % NXCD, off = wgid / NXCD; wgid = (xcd < r ? xcd * (q + 1) : r * (q + 1) + (xcd - r) * q) + off; }
        const int nig = WGM * nN, gid = wgid / nig, fm = gid * WGM, gsz = (nM - fm) < WGM ? (nM - fm) : WGM;
        u.pm = fm + ((wgid % nig) % gsz); u.pn = (wgid % nig) / gsz; return true;
    }
    __device__ __forceinline__ void a_ready(const Unit&) const {}
    __device__ __forceinline__ void done(const Unit&) const {}
};

__device__ __forceinline__ unsigned cvt_pk_bf16(float lo, float hi) { unsigned r; asm volatile("s_nop 0\n\tv_cvt_pk_bf16_f32 %0, %1, %2" : "=v"(r) : "v"(lo), "v"(hi)); return r; }
typedef float f32x2 __attribute__((ext_vector_type(2)));
__device__ __forceinline__ u32x4 pack8(const f32x4 a, const f32x4 b) { u32x4 w; w.x = cvt_pk_bf16(a[0], a[1]); w.y = cvt_pk_bf16(a[2], a[3]); w.z = cvt_pk_bf16(b[0], b[1]); w.w = cvt_pk_bf16(b[2], b[3]); return w; }
__device__ __forceinline__ float bf_lo(unsigned w) { return __uint_as_float(w << 16); }
__device__ __forceinline__ float bf_hi(unsigned w) { return __uint_as_float(w & 0xffff0000u); }
__device__ __forceinline__ void unpack8(const u32x4 w, f32x4& a, f32x4& b) { a = (f32x4){bf_lo(w.x), bf_hi(w.x), bf_lo(w.y), bf_hi(w.y)}; b = (f32x4){bf_lo(w.z), bf_hi(w.z), bf_lo(w.w), bf_hi(w.w)}; }
__device__ __forceinline__ float gelu_tanh(float x) { const float u = x * (0.7978845608028654f + 0.035677408136300125f * x * x);
    const float e = __builtin_amdgcn_exp2f(-2.885390081777927f * u); return x * __builtin_amdgcn_rcpf(1.0f + e); }
__device__ __forceinline__ float sigmoid_f(float z) { return __builtin_amdgcn_rcpf(1.0f + __builtin_amdgcn_exp2f(-1.4426950408889634f * z)); }
__device__ __forceinline__ f32x4 gelu4(f32x4 v) { return (f32x4){gelu_tanh(v[0]), gelu_tanh(v[1]), gelu_tanh(v[2]), gelu_tanh(v[3])}; }
__device__ __forceinline__ f32x4 sigm4(f32x4 v) { return (f32x4){sigmoid_f(v[0]), sigmoid_f(v[1]), sigmoid_f(v[2]), sigmoid_f(v[3])}; }
__device__ __forceinline__ float hsum4(f32x4 v) { return (v[0] + v[1]) + (v[2] + v[3]); }

struct EpiPlain {
    static constexpr bool PERM = true, AFTER_DRAIN = false, HAS_MID = false;
    bf16_t* O; int ldc;
    __device__ __forceinline__ void operator()(const f32x4 (&acc)[2][2][4][2], const Unit& u, int wr, int wc, int fr, int fq) const {
        const int row0 = u.pm * BM + wr * 64 + fr, col0 = u.pn * BM + wc * 32 + 8 * fq;
#pragma unroll
        for (int ai = 0; ai < 2; ++ai)
#pragma unroll
            for (int m = 0; m < 4; ++m) { bf16_t* rowp = O + (size_t)(row0 + ai * HALF + m * 16) * ldc + col0;
#pragma unroll
                for (int bj = 0; bj < 2; ++bj) *(u32x4*)(rowp + bj * HALF) = pack8(acc[ai][bj][m][0], acc[ai][bj][m][1]); }
    }
};
struct EpiRelu2 {
    static constexpr bool PERM = true, AFTER_DRAIN = false, HAS_MID = false;
    bf16_t* O; int ldc;
    __device__ __forceinline__ void operator()(const f32x4 (&acc)[2][2][4][2], const Unit& u, int wr, int wc, int fr, int fq) const {
        const int row0 = u.pm * BM + wr * 64 + fr, col0 = u.pn * BM + wc * 32 + 8 * fq;
#pragma unroll
        for (int ai = 0; ai < 2; ++ai)
#pragma unroll
            for (int m = 0; m < 4; ++m) { bf16_t* rowp = O + (size_t)(row0 + ai * HALF + m * 16) * ldc + col0;
#pragma unroll
                for (int bj = 0; bj < 2; ++bj) { f32x4 v0 = acc[ai][bj][m][0], v1 = acc[ai][bj][m][1];
                    v0 = __builtin_elementwise_max(v0, (f32x4){0.f, 0.f, 0.f, 0.f}); v1 = __builtin_elementwise_max(v1, (f32x4){0.f, 0.f, 0.f, 0.f});
                    *(u32x4*)(rowp + bj * HALF) = pack8(v0 * v0, v1 * v1); } }
    }
};
struct EpiNorm {
    static constexpr bool PERM = true, AFTER_DRAIN = false, HAS_MID = false;
    bf16_t* O; int ldc; float* ssq;
    __device__ __forceinline__ void operator()(const f32x4 (&acc)[2][2][4][2], const Unit& u, int wr, int wc, int fr, int fq) const {
        const int row0 = u.pm * BM + wr * 64 + fr, col0 = u.pn * BM + wc * 32 + 8 * fq;
#pragma unroll
        for (int ai = 0; ai < 2; ++ai)
#pragma unroll
            for (int m = 0; m < 4; ++m) { const int row = row0 + ai * HALF + m * 16; bf16_t* rowp = O + (size_t)row * ldc + col0; float q = 0.f;
#pragma unroll
                for (int bj = 0; bj < 2; ++bj) { const f32x4 v0 = acc[ai][bj][m][0], v1 = acc[ai][bj][m][1]; q += hsum4(v0 * v0) + hsum4(v1 * v1);
                    *(u32x4*)(rowp + bj * HALF) = pack8(v0, v1); }
                q += __shfl_xor(q, 16); q += __shfl_xor(q, 32);
                if (fq == 0) ssq[(size_t)row * 64 + u.pn * 4 + wc] = q; }
    }
};
__device__ __forceinline__ unsigned gq4(const f32x4 g) { unsigned r = 0u; r = __builtin_amdgcn_cvt_pk_u8_f32(g[0] * 256.f - 0.5f, 0, r); r = __builtin_amdgcn_cvt_pk_u8_f32(g[1] * 256.f - 0.5f, 1, r);
    r = __builtin_amdgcn_cvt_pk_u8_f32(g[2] * 256.f - 0.5f, 2, r); r = __builtin_amdgcn_cvt_pk_u8_f32(g[3] * 256.f - 0.5f, 3, r); return r; }
__device__ __forceinline__ f32x4 gdq4(const unsigned w) { return (f32x4){((float)(w & 0xffu) + 0.5f) * (1.f / 256.f), ((float)((w >> 8) & 0xffu) + 0.5f) * (1.f / 256.f), ((float)((w >> 16) & 0xffu) + 0.5f) * (1.f / 256.f), ((float)(w >> 24) + 0.5f) * (1.f / 256.f)}; }
typedef unsigned u32x2 __attribute__((ext_vector_type(2)));
constexpr size_t GFRAG_TILE = 65536;
__device__ __forceinline__ size_t gfrag_off(int pm, int gt, int wave, int lane) { return ((size_t)(pm * 32 + gt) * 8 + wave) * 8192 + (size_t)lane * 8; }
struct EpiMerge {
    static constexpr bool PERM = true, AFTER_DRAIN = false, HAS_MID = true;
    const unsigned char* G; bf16_t* MG; int tmid;
    __device__ __forceinline__ void mid(f32x4 (&acc)[2][2][4][2], const Unit& u, int wr, int wc, int fr, int fq) const {
        size_t off0 = gfrag_off(u.pm, u.pn, wr * 4 + wc, fq * 16 + fr); asm volatile("" : "+v"(off0));
#pragma unroll
        for (int ai = 0; ai < 2; ++ai)
#pragma unroll
            for (int m = 0; m < 4; ++m) { const unsigned char* gp = G + off0 + (size_t)((ai * 4 + m) * 2) * 512;
#pragma unroll
                for (int bj = 0; bj < 2; ++bj) { const u32x2 wa = *(const u32x2*)(gp + bj * 512), wb = *(const u32x2*)(gp + (size_t)16 * GFRAG_TILE + bj * 512);
                    f32x4 a0 = gdq4(wa.x), a1 = gdq4(wa.y); const f32x4 b0 = gdq4(wb.x), b1 = gdq4(wb.y);
#pragma unroll
                    for (int e = 0; e < 4; ++e) { a0[e] *= __builtin_amdgcn_rcpf(b0[e]); a1[e] *= __builtin_amdgcn_rcpf(b1[e]); }
                    acc[ai][bj][m][0] *= a0; acc[ai][bj][m][1] *= a1; }
                if ((m & (MID_FENCE - 1)) == MID_FENCE - 1) asm volatile("" ::: "memory"); }
    }
    __device__ __forceinline__ void operator()(const f32x4 (&acc)[2][2][4][2], const Unit& u, int wr, int wc, int fr, int fq) const {
        const int row0 = u.pm * BM + wr * 64 + fr, col0 = u.pn * BM + wc * 32 + 8 * fq;
        const unsigned char* gb = G + gfrag_off(u.pm, u.pn + 16, wr * 4 + wc, fq * 16 + fr);
#pragma unroll
        for (int ai = 0; ai < 2; ++ai)
#pragma unroll
            for (int m = 0; m < 4; ++m) { const size_t row = (size_t)(row0 + ai * HALF + m * 16);
#pragma unroll
                for (int bj = 0; bj < 2; ++bj) { const u32x2 wb = *(const u32x2*)(gb + (size_t)((ai * 4 + m) * 2 + bj) * 512); const f32x4 b0 = gdq4(wb.x), b1 = gdq4(wb.y);
                    *(u32x4*)(MG + row * 4096 + col0 + bj * HALF) = pack8(acc[ai][bj][m][0] * b0, acc[ai][bj][m][1] * b1); } }
    }
};
struct EpiProj {
    static constexpr bool PERM = true, AFTER_DRAIN = false, HAS_MID = false;
    bf16_t *Q, *K, *V, *U, *VB; unsigned char* G; const float* rope; const float* bgate; float* lnstat; float sc;
    __device__ __forceinline__ void operator()(const f32x4 (&acc)[2][2][4][2], const Unit& u, int wr, int wc, int fr, int fq) const {
        const int pn = u.pn, lc0 = wc * 32 + 8 * fq; int row0 = u.pm * BM + wr * 64 + fr; asm volatile("" : "+v"(row0));
        if (pn < 24) {
            bf16_t* base = pn < 12 ? Q : K; const int colt = (pn < 12 ? pn : pn - 12) * BM + lc0; const float sgn = (fq & 2) ? 1.f : -1.f;
#pragma unroll
            for (int ai = 0; ai < 2; ++ai)
#pragma unroll
                for (int m = 0; m < 4; ++m) { const size_t row = (size_t)(row0 + ai * HALF + m * 16); bf16_t* rowp = base + row * 3072 + colt;
                    f32x4 c0 = {0.f, 0.f, 0.f, 0.f}, c1 = c0, s0 = c0, s1 = c0;
                    if (wc == 0) { const float* rp = rope + row * 32 + 8 * (fq & 1); c0 = *(const f32x4*)rp; c1 = *(const f32x4*)(rp + 4); s0 = *(const f32x4*)(rp + 16); s1 = *(const f32x4*)(rp + 20); }
#pragma unroll
                    for (int bj = 0; bj < 2; ++bj) { f32x4 v0 = acc[ai][bj][m][0] * sc, v1 = acc[ai][bj][m][1] * sc;
                        if (wc == 0) { f32x4 p0, p1;
#pragma unroll
                            for (int e = 0; e < 4; ++e) { p0[e] = __shfl_xor(v0[e], 32); p1[e] = __shfl_xor(v1[e], 32); }
                            v0 = v0 * c0 + (p0 * s0) * sgn; v1 = v1 * c1 + (p1 * s1) * sgn; }
                        *(u32x4*)(rowp + bj * HALF) = pack8(v0, v1); } }
        } else if (pn < 36) {
            const int colt = (pn - 24) * BM + lc0;
#pragma unroll
            for (int ai = 0; ai < 2; ++ai)
#pragma unroll
                for (int m = 0; m < 4; ++m) { bf16_t* rowp = V + (size_t)(row0 + ai * HALF + m * 16) * 3072 + colt;
#pragma unroll
                    for (int bj = 0; bj < 2; ++bj) *(u32x4*)(rowp + bj * HALF) = pack8(acc[ai][bj][m][0] * sc, acc[ai][bj][m][1] * sc); }
        } else if (pn < 44) {
            const int colt = (pn - 36) * BM + lc0;
#pragma unroll
            for (int ai = 0; ai < 2; ++ai)
#pragma unroll
                for (int m = 0; m < 4; ++m) { bf16_t* rowp = U + (size_t)(row0 + ai * HALF + m * 16) * 2048 + colt;
#pragma unroll
                    for (int bj = 0; bj < 2; ++bj) *(u32x4*)(rowp + bj * HALF) = pack8(gelu4(acc[ai][bj][m][0]), gelu4(acc[ai][bj][m][1])); }
        } else if (pn < 52) {
            const int colt = (pn - 44) * BM + lc0;
#pragma unroll
            for (int ai = 0; ai < 2; ++ai)
#pragma unroll
                for (int m = 0; m < 4; ++m) { const size_t row = (size_t)(row0 + ai * HALF + m * 16); bf16_t* rowp = VB + row * 2048 + colt; float s = 0.f, q = 0.f;
#pragma unroll
                    for (int bj = 0; bj < 2; ++bj) { const f32x4 v0 = gelu4(acc[ai][bj][m][0]), v1 = gelu4(acc[ai][bj][m][1]);
                        s += hsum4(v0) + hsum4(v1); q += hsum4(v0 * v0) + hsum4(v1 * v1); *(u32x4*)(rowp + bj * HALF) = pack8(v0, v1); }
                    s += __shfl_xor(s, 16); s += __shfl_xor(s, 32); q += __shfl_xor(q, 16); q += __shfl_xor(q, 32);
                    if (fq == 0) *(f32x2*)(lnstat + (row * 32 + (pn - 44) * 4 + wc) * 2) = (f32x2){s, q}; }
        }
    }
};
struct EpiGates {
    static constexpr bool PERM = true, AFTER_DRAIN = false, HAS_MID = false;
    unsigned char* G; const float* bgate; float inv;
    __device__ __forceinline__ void operator()(const f32x4 (&acc)[2][2][4][2], const Unit& u, int wr, int wc, int fr, int fq) const {
        int colt = u.pn * BM + wc * 32 + 8 * fq; size_t goff = gfrag_off(u.pm, u.pn, wr * 4 + wc, fq * 16 + fr);
        asm volatile("" : "+v"(colt), "+v"(goff));
        f32x4 bv[2][2];
#pragma unroll
        for (int bj = 0; bj < 2; ++bj) { bv[bj][0] = *(const f32x4*)(bgate + colt + bj * HALF); bv[bj][1] = *(const f32x4*)(bgate + colt + bj * HALF + 4); }
        unsigned char* gbase = G + goff;
#pragma unroll
        for (int ai = 0; ai < 2; ++ai)
#pragma unroll
            for (int m = 0; m < 4; ++m) { unsigned char* gp = gbase + (size_t)((ai * 4 + m) * 2) * 512;
#pragma unroll
                for (int bj = 0; bj < 2; ++bj) { u32x2 w; w.x = gq4(sigm4(acc[ai][bj][m][0] * inv + bv[bj][0])); w.y = gq4(sigm4(acc[ai][bj][m][1] * inv + bv[bj][1])); *(u32x2*)(gp + bj * 512) = w; } }
    }
};
struct EpiGatesQK {
    static constexpr bool PERM = true, AFTER_DRAIN = false, HAS_MID = false;
    EpiGates eg; EpiProj ep;
    __device__ __forceinline__ void operator()(const f32x4 (&acc)[2][2][4][2], const Unit& u, int wr, int wc, int fr, int fq) const {
        if (u.pn < 32) eg(acc, u, wr, wc, fr, fq);
        else { Unit v = u; v.pn = u.pn - 32; ep(acc, v, wr, wc, fr, fq); }
    }
};
struct EpiProjUV {
    static constexpr bool PERM = true, AFTER_DRAIN = false, HAS_MID = false;
    EpiProj ep;
    __device__ __forceinline__ void operator()(const f32x4 (&acc)[2][2][4][2], const Unit& u, int wr, int wc, int fr, int fq) const { Unit v = u; v.pn = u.pn + 36; ep(acc, v, wr, wc, fr, fq); }
};
struct SmallOrder {
    int nN, nwg, c;
    __device__ void init(int M, int N, int first, int bx) { nN = N / BM; nwg = (M / BM) * nN; c = bx - first; }
    __device__ bool next(int i, Unit& u) const { if (i != 0 || c < 0 || c >= nwg) return false; u.pm = c / nN; u.pn = c % nN; return true; }
    __device__ __forceinline__ void a_ready(const Unit&) const {}
    __device__ __forceinline__ void done(const Unit&) const {}
};
typedef int v4i32_t __attribute__((ext_vector_type(4))); typedef int v8i32_t __attribute__((ext_vector_type(8)));
__device__ __forceinline__ v8i32_t cat8(const bf16x8 lo, const bf16x8 hi) { return __builtin_shufflevector(__builtin_bit_cast(v4i32_t, lo), __builtin_bit_cast(v4i32_t, hi), 0, 1, 2, 3, 4, 5, 6, 7); }
template <class Epi, class Sched, bool ALIGN_EPI = false, bool SP2 = false, bool FP8 = false>
__device__ __forceinline__ void gemm_phase(PG8_LAS unsigned char* lds, const Gemm g, const Sched& S, const Epi& E) {
    const int tid = threadIdx.x, wid = __builtin_amdgcn_readfirstlane(tid >> 6), lane = tid & 63, wr = wid >> 2, wc = wid & 3, fr = lane & 15, fq = lane >> 4;
    const int K = g.K, nt = K / BK;
    unsigned voffA[2], voffB[2];
#pragma unroll
    for (int i = 0; i < 2; ++i) { int R, C; stage_rc(tid * 16 + i * 8192, R, C); const int Rb = Epi::PERM ? ((R & ~31) + perm32(R & 31)) : R;
        voffA[i] = (unsigned)(R * K + C) * 2u; voffB[i] = (unsigned)(Rb * K + C) * 2u; }
    const size_t kstep = (size_t)(BK * 2);
    const size_t hstep = (size_t)HALF * K * 2;
    const size_t tstep = 2 * hstep;
    const unsigned ldsw = (unsigned)wid * 1024u;
    const int aoff = lds_byte(wr * 64 + fr, FP8 ? fq * 16 : fq * 8), boff = lds_byte(wc * 32 + fr, FP8 ? fq * 16 : fq * 8);

#define PG8_SA(b, h) (((b) * 2 + (h)) * HTB)
#define PG8_SB(b, h) ((4 + (b) * 2 + (h)) * HTB)
#define PG8_STAGE(bufoff, gbase, voff) do { _Pragma("unroll") for (int _i = 0; _i < 2; ++_i) \
        __builtin_amdgcn_global_load_lds((const unsigned*)((const char*)(gbase) + (voff)[_i]), (PG8_LAS unsigned*)(lds + (bufoff) + ldsw + _i * 8192), 16, 0, 0); } while (0)
#define PG8_LDA(dst, b, h) do { if constexpr (FP8) { _Pragma("unroll") for (int m = 0; m < 4; ++m) dst##8[m] = cat8(*(const PG8_LAS bf16x8*)(lds + PG8_SA(b, h) + aoff + m * 2048), *(const PG8_LAS bf16x8*)(lds + PG8_SA(b, h) + aoff + m * 2048 + 16)); } \
        else { _Pragma("unroll") for (int m = 0; m < 4; ++m) _Pragma("unroll") for (int k = 0; k < 2; ++k) dst[m][k] = *(const PG8_LAS bf16x8*)(lds + PG8_SA(b, h) + aoff + m * 2048 + k * 1024); } } while (0)
#define PG8_LDB(dst, b, h) do { if constexpr (FP8) { _Pragma("unroll") for (int n = 0; n < 2; ++n) dst##8[n] = cat8(*(const PG8_LAS bf16x8*)(lds + PG8_SB(b, h) + boff + n * 2048), *(const PG8_LAS bf16x8*)(lds + PG8_SB(b, h) + boff + n * 2048 + 16)); } \
        else { _Pragma("unroll") for (int n = 0; n < 2; ++n) _Pragma("unroll") for (int k = 0; k < 2; ++k) dst[n][k] = *(const PG8_LAS bf16x8*)(lds + PG8_SB(b, h) + boff + n * 2048 + k * 1024); } } while (0)
#define PG8_MMA(ai, bj, At, Bt) do { __builtin_amdgcn_s_setprio(1); \
        if constexpr (FP8) { _Pragma("unroll") for (int m = 0; m < 4; ++m) _Pragma("unroll") for (int n = 0; n < 2; ++n) \
            asm volatile("v_mfma_scale_f32_16x16x128_f8f6f4 %0, %1, %2, %0, %3, %3 op_sel_hi:[0,0,0]" : "+v"(acc[ai][bj][m][n]) : "v"(Bt##8[n]), "v"(At##8[m]), "v"(sc8)); } \
        else { _Pragma("unroll") for (int m = 0; m < 4; ++m) _Pragma("unroll") for (int n = 0; n < 2; ++n) _Pragma("unroll") for (int k = 0; k < 2; ++k) \
            acc[ai][bj][m][n] = __builtin_amdgcn_mfma_f32_16x16x32_bf16(Bt[n][k], At[m][k], acc[ai][bj][m][n], 0, 0, 0); } \
        __builtin_amdgcn_s_setprio(0); } while (0)
#define PG8_WAIT_V(n) asm volatile("s_waitcnt vmcnt(" #n ")" ::: "memory")
#define PG8_WAIT_L(n) asm volatile("s_waitcnt lgkmcnt(" #n ")" ::: "memory")
#define PG8_BAR __builtin_amdgcn_s_barrier()
#define PG8_SCHED __builtin_amdgcn_sched_barrier(0)
    Unit cur, nxt; int ui = 0;
    if (!S.next(0, cur)) return;
    f32x4 acc[2][2][4][2];
#pragma unroll
    for (int a = 0; a < 2; ++a)
#pragma unroll
        for (int b = 0; b < 2; ++b)
#pragma unroll
            for (int m = 0; m < 4; ++m)
#pragma unroll
                for (int n = 0; n < 2; ++n) acc[a][b][m][n] = (f32x4){0.f, 0.f, 0.f, 0.f};
    bf16x8 At[4][2], B0[2][2], B1[2][2];
    v8i32_t At8[4], B08[2], B18[2];
    const unsigned sc8 = 0x7F7F7F7Fu;
    const char* cA = (const char*)g.A + (size_t)cur.pm * tstep; const char* cB = (const char*)g.Bt + (size_t)cur.pn * tstep;
    S.a_ready(cur);
    if constexpr (SP2) {
        PG8_STAGE(PG8_SB(0, 0), cB, voffB); PG8_STAGE(PG8_SB(0, 1), cB + hstep, voffB); PG8_STAGE(PG8_SA(0, 0), cA, voffA); PG8_STAGE(PG8_SA(0, 1), cA + hstep, voffA);
        if (wr == 1) PG8_BAR;
        PG8_WAIT_V(2); PG8_BAR;
        PG8_STAGE(PG8_SB(1, 0), cB + kstep, voffB); PG8_STAGE(PG8_SA(1, 0), cA + kstep, voffA); PG8_STAGE(PG8_SB(1, 1), cB + hstep + kstep, voffB);
        PG8_WAIT_V(6); PG8_BAR;
    } else {
        PG8_STAGE(PG8_SB(0, 0), cB, voffB); PG8_STAGE(PG8_SA(0, 0), cA, voffA); PG8_STAGE(PG8_SB(0, 1), cB + hstep, voffB); PG8_STAGE(PG8_SA(0, 1), cA + hstep, voffA);
        if (wr == 1) PG8_BAR;
        PG8_WAIT_V(4); PG8_BAR;
        PG8_STAGE(PG8_SB(1, 0), cB + kstep, voffB); PG8_STAGE(PG8_SA(1, 0), cA + kstep, voffA); PG8_STAGE(PG8_SB(1, 1), cB + hstep + kstep, voffB);
        PG8_WAIT_V(6); PG8_BAR;
    }
    for (;;) {
        const bool has_next = S.next(ui + 1, nxt);
        const char* nA = has_next ? (const char*)g.A + (size_t)nxt.pm * tstep : cA; const char* nB = has_next ? (const char*)g.Bt + (size_t)nxt.pn * tstep : cB;
#define PG8_KITER(t) do { \
            const bool last = ((t) == nt - 2); \
            const char* a1 = cA + (size_t)((t) + 1) * kstep; \
            const char* a2 = last ? nA : cA + (size_t)((t) + 2) * kstep; const char* b2 = last ? nB : cB + (size_t)((t) + 2) * kstep; \
            const char* a3 = a2 + kstep; const char* b3 = b2 + kstep; \
            if (last && has_next) S.a_ready(nxt); \
            PG8_LDB(B0, 0, 0); PG8_LDB(B1, 0, 1); PG8_SCHED; PG8_LDA(At, 0, 0); PG8_STAGE(PG8_SA(1, 1), a1 + hstep, voffA); \
            PG8_WAIT_V(8); PG8_WAIT_L(0); PG8_BAR; PG8_MMA(0, 0, At, B0); PG8_MMA(0, 1, At, B1); PG8_BAR; PG8_SCHED; \
            PG8_LDA(At, 0, 1); PG8_STAGE(PG8_SB(0, 0), b2, voffB); PG8_STAGE(PG8_SB(0, 1), b2 + hstep, voffB); PG8_STAGE(PG8_SA(0, 0), a2, voffA); \
            PG8_WAIT_V(8); PG8_WAIT_L(0); PG8_BAR; PG8_MMA(1, 0, At, B0); PG8_MMA(1, 1, At, B1); PG8_BAR; PG8_SCHED; \
            PG8_LDB(B0, 1, 0); PG8_LDB(B1, 1, 1); PG8_SCHED; PG8_LDA(At, 1, 0); PG8_STAGE(PG8_SA(0, 1), a2 + hstep, voffA); \
            PG8_WAIT_V(8); PG8_WAIT_L(0); PG8_BAR; PG8_MMA(0, 0, At, B0); PG8_MMA(0, 1, At, B1); PG8_BAR; PG8_SCHED; \
            PG8_LDA(At, 1, 1); PG8_STAGE(PG8_SB(1, 0), b3, voffB); PG8_STAGE(PG8_SB(1, 1), b3 + hstep, voffB); PG8_STAGE(PG8_SA(1, 0), a3, voffA); \
            PG8_WAIT_V(8); PG8_WAIT_L(0); PG8_BAR; PG8_MMA(1, 0, At, B0); PG8_MMA(1, 1, At, B1); PG8_BAR; PG8_SCHED; \
        } while (0)
        static_assert(SP2, "this copy of the body keeps only the two-super-phase K-loop");
        if constexpr (Epi::HAS_MID) {
            const int tm = E.tmid;
            for (int t = 0; t < tm; t += 2) PG8_KITER(t);
            E.mid(acc, cur, wr, wc, fr, fq);
            for (int t = tm; t < nt; t += 2) PG8_KITER(t);
        } else {
            for (int t = 0; t < nt; t += 2) PG8_KITER(t);
        }
#undef PG8_KITER
        if constexpr (FP8) asm volatile("s_nop 15\n\ts_nop 15" ::: "memory");
        if constexpr (ALIGN_EPI) { if (wr == 0) PG8_BAR; }
        if constexpr (!Epi::AFTER_DRAIN) { E(acc, cur, wr, wc, fr, fq); S.done(cur); }
        if (!has_next) break;
#pragma unroll
        for (int a = 0; a < 2; ++a)
#pragma unroll
            for (int b = 0; b < 2; ++b)
#pragma unroll
                for (int m = 0; m < 4; ++m)
#pragma unroll
                    for (int n = 0; n < 2; ++n) acc[a][b][m][n] = (f32x4){0.f, 0.f, 0.f, 0.f};
        cur = nxt; cA = nA; cB = nB; ++ui;
        if constexpr (ALIGN_EPI) { if (wr == 1) PG8_BAR; }
    }
    PG8_WAIT_V(0);
    if constexpr (!ALIGN_EPI) { if (wr == 0) PG8_BAR; }
    PG8_BAR;
    if constexpr (Epi::AFTER_DRAIN) { E.fused(acc, cur, wr, wc, fr, fq, lds, wid, lane); S.done(cur); }
#undef PG8_SA
#undef PG8_SB
#undef PG8_STAGE
#undef PG8_LDA
#undef PG8_LDB
#undef PG8_MMA
#undef PG8_WAIT_V
#undef PG8_WAIT_L
#undef PG8_BAR
#undef PG8_SCHED
}
}
#ifndef PG8_SP2
#define PG8_SP2 true
#endif
#ifndef PG8_ALIGN
#define PG8_ALIGN true
#endif
constexpr int NWAVES = 8;
#ifndef MK_PER_PHASE
#define MK_PER_PHASE 0
#endif
constexpr int N_PHASES = 14;

constexpr int BATCH = 4, SEQ = 4096, DM = 4096, M = BATCH * SEQ;
constexpr int AW = 1024, QKVW = 3072, SGW = 2048, INW = 13312, GW = 8192, NPROJ = INW + GW;
constexpr int XAW = 512, NMEM = 256, MROWS = BATCH * NMEM, DFF = 16384;
constexpr float EPS = 1e-6f;
constexpr float FP8_SH = 32.f, FP8_SW = 2048.f;

constexpr size_t MiB = 1u << 20;
constexpr size_t WS_CTL = 0, CTL_ZERO_BYTES = 1 * MiB;
constexpr size_t WS_ROPE = 1 * MiB;
constexpr size_t WS_LNST = 3 * MiB;
constexpr size_t WS_SSQ = 7 * MiB;
constexpr size_t WS_LSE = 11 * MiB;
constexpr size_t WS_WSP = 13 * MiB;
constexpr size_t WS_WING = 16 * MiB;
constexpr size_t WS_WG8 = 48 * MiB;
constexpr size_t WS_H8 = 1058 * MiB;
constexpr size_t WS_WA = 184 * MiB;
constexpr size_t WS_WOUT = 208 * MiB;
constexpr size_t WS_WXQ = 240 * MiB;
constexpr size_t WS_WKV = 244 * MiB;
constexpr size_t WS_WXO = 252 * MiB;
constexpr size_t WS_H = 256 * MiB;
constexpr size_t WS_Q = 384 * MiB, WS_K = 480 * MiB, WS_V = 576 * MiB;
constexpr size_t WS_U = 672 * MiB, WS_VB = 736 * MiB;
constexpr size_t WS_G = 800 * MiB;
constexpr size_t WS_MRG = 1056 * MiB;
constexpr size_t WS_OG = 1056 * MiB;
constexpr size_t WS_KVX = 1216 * MiB;
constexpr size_t WS_MB = 1218 * MiB;
constexpr size_t WS_T = 384 * MiB;
constexpr size_t WS_QX = 512 * MiB, WS_OX = 528 * MiB;
constexpr size_t WS_A = 384 * MiB;
constexpr size_t WS_WUP = 896 * MiB;
constexpr size_t WS_WDN = 1024 * MiB;
constexpr size_t WS_YAB = 16 * MiB;
constexpr size_t WS_T3 = 256 * MiB;
constexpr size_t WS_XB = 16 * MiB;
constexpr size_t WS_END = 1226 * MiB;
constexpr int CW_TMO = 0, CW_CODE = 1, CW_BAR = 4096, CW_TICKET = 16384;

constexpr int RING_OFF = 0, RING_BYTES = 131072;
constexpr int ATT_KSTR = 272;
constexpr int ATT_K_OFF = 0, ATT_V_OFF = 256 * ATT_KSTR, ATT_END = ATT_V_OFF + 272 * ATT_KSTR;
constexpr int MISC_OFF = 144384, LDS_BYTES = 147456;
static_assert(ATT_END <= MISC_OFF && MISC_OFF + 128 <= LDS_BYTES, "LDS map");

#define GAS __attribute__((address_space(1)))
#define LAS __attribute__((address_space(3)))
typedef unsigned short bf16;
typedef unsigned v4u __attribute__((ext_vector_type(4)));
typedef unsigned v2u __attribute__((ext_vector_type(2)));
typedef float f32x4 __attribute__((ext_vector_type(4)));
typedef float f32x2 __attribute__((ext_vector_type(2)));
typedef short bf16x8 __attribute__((ext_vector_type(8)));
typedef short s16x4 __attribute__((ext_vector_type(4)));
typedef GAS unsigned gu32;
#define RLX_AGENT __ATOMIC_RELAXED, __HIP_MEMORY_SCOPE_AGENT
#define LDS_WAIT() asm volatile("s_waitcnt lgkmcnt(0)" ::: "memory")
#define VM_WAIT() asm volatile("s_waitcnt vmcnt(0)" ::: "memory")
__device__ __forceinline__ unsigned f2bf(float f) { unsigned u = __builtin_bit_cast(unsigned, f); return (u + 0x7fffu + ((u >> 16) & 1u)) >> 16; }
__device__ __forceinline__ unsigned pk2(float lo, float hi) { return f2bf(lo) | (f2bf(hi) << 16); }
__device__ __forceinline__ float bflo(unsigned w) { return __uint_as_float(w << 16); }
__device__ __forceinline__ float bfhi(unsigned w) { return __uint_as_float(w & 0xffff0000u); }

#define XB_TMO      128
#define XB_XCNT(j)  (256  + 64 * (j))
#define XB_XSUB(j)  (1280 + 64 * (j))
#define XB_XGEN(j)  (2304 + 64 * (j))
#define XB_TOP      3328
#define XB_TOPGEN   3392
#define XCD_BAR_WORDS 3456
#define XB_SPIN_CAP (1u << 18)

__device__ __forceinline__ unsigned xb_ld(unsigned* p)              { return __hip_atomic_load(p, __ATOMIC_RELAXED, __HIP_MEMORY_SCOPE_AGENT); }
__device__ __forceinline__ unsigned xb_add(unsigned* p, unsigned v) { return __hip_atomic_fetch_add(p, v, __ATOMIC_RELAXED, __HIP_MEMORY_SCOPE_AGENT); }
__device__ __forceinline__ unsigned xb_xcc_id() { return (unsigned)__builtin_amdgcn_s_getreg((3 << 11) | 20) & 0xFu; }
#define XB_SPIN(cond, bar) do { unsigned _sp = 0; while (cond) { __builtin_amdgcn_s_sleep(1); \
    if ((++_sp & 255u) == 0u) { if (xb_ld(&(bar)[XB_TMO])) break; if (_sp > XB_SPIN_CAP) { atomicAdd(&(bar)[XB_TMO], 1u); break; } } } } while (0)

struct XcdBarrier {
    unsigned* bar; unsigned x;
    volatile LAS unsigned* st;
};

__device__ __forceinline__ XcdBarrier xcd_barrier_post(unsigned* bar, volatile LAS unsigned* st) {
    XcdBarrier b; b.bar = bar; b.x = xb_xcc_id(); b.st = st;
    if (threadIdx.x == 0) (void)xb_add(&bar[XB_XCNT(b.x)], 1u);
    return b;
}
__device__ __forceinline__ void xcd_barrier_complete(unsigned* bar, unsigned x, unsigned& nloc, unsigned& nx) {
    const unsigned G = gridDim.x * gridDim.y * gridDim.z;
    unsigned sum, cnt, mine, sp = 0u;
    for (;;) {
        sum = 0u; cnt = 0u; mine = 0u;
#pragma unroll
        for (unsigned j = 0; j < 16; ++j) { const unsigned c = xb_ld(&bar[XB_XCNT(j)]); sum += c; cnt += (c > 0u) ? 1u : 0u; mine = (j == x) ? c : mine; }
        if (sum == G) break;
        __builtin_amdgcn_s_sleep(1);
        if ((++sp & 255u) == 0u) { if (xb_ld(&bar[XB_TMO])) break; if (sp > XB_SPIN_CAP) { atomicAdd(&bar[XB_TMO], 1u); break; } }
    }
    nloc = mine > 0u ? mine : 1u; nx = cnt > 0u ? cnt : 1u;
}

__device__ __forceinline__ void xcd_barrier(const XcdBarrier& b) {
    asm volatile("s_waitcnt vmcnt(0)" ::: "memory");
    __syncthreads();
    if (threadIdx.x == 0) {
        unsigned* bar = b.bar;
        __builtin_amdgcn_s_waitcnt(0);
        unsigned nloc = b.st[0], nx = b.st[1];
        if (nloc == 0u) { xcd_barrier_complete(bar, b.x, nloc, nx); b.st[0] = nloc; b.st[1] = nx; }
        const unsigned old = xb_add(&bar[XB_XSUB(b.x)], 1u);
        const unsigned gen = old / nloc;
        if (old + 1u == (gen + 1u) * nloc) {
            __builtin_amdgcn_fence(__ATOMIC_RELEASE, "agent");
            asm volatile("s_waitcnt vmcnt(0)" ::: "memory");
            const unsigned og = xb_add(&bar[XB_TOP], 1u);
            const unsigned tg = og / nx;
            if (og + 1u == (tg + 1u) * nx) xb_add(&bar[XB_TOPGEN], 1u);
            else XB_SPIN(xb_ld(&bar[XB_TOPGEN]) == tg, bar);
            __builtin_amdgcn_fence(__ATOMIC_ACQUIRE, "agent");
            xb_add(&bar[XB_XGEN(b.x)], 1u);
            asm volatile("s_waitcnt vmcnt(0)" ::: "memory");
        } else {
            XB_SPIN(xb_ld(&bar[XB_XGEN(b.x)]) == gen, bar);
            __builtin_amdgcn_fence(__ATOMIC_ACQUIRE, "agent");
            asm volatile("s_waitcnt vmcnt(0)" ::: "memory");
        }
    }
    __syncthreads();
}

struct Frame {
    LAS unsigned char* lds;
    volatile LAS unsigned* MISC;
    gu32* ctl;
    int tid, lane, wave;
    int vcu, G;
    unsigned char* ws;
};
__device__ __forceinline__ float wave_sum(float v) {
#pragma unroll
    for (int o = 1; o < 64; o <<= 1) v += __shfl_xor(v, o);
    return v;
}
__device__ __forceinline__ void p0_transpose_item(const float* W, int K, int N, bf16* WT, int row_off, LAS float* scr, int item, int lane, int ldk = 0, int koff = 0) {
    if (ldk == 0) ldk = K;
    const int nblk = N / 32, kb = item / nblk, nb = item % nblk, k0 = 64 * kb, n0 = 32 * nb;
#pragma unroll 8
    for (int i = 0; i < 32; ++i) { const int kk = 2 * i + (lane >> 5); scr[kk * 33 + (lane & 31)] = W[(size_t)(k0 + kk) * N + n0 + (lane & 31)]; }
    LDS_WAIT(); asm volatile("" ::: "memory");
    const int c = lane & 7;
#pragma unroll
    for (int j = 0; j < 4; ++j) { const int n = (lane >> 3) + 8 * j; const LAS float* s = scr + (8 * c) * 33 + n;
        v4u o; o.x = pk2(s[0 * 33], s[1 * 33]); o.y = pk2(s[2 * 33], s[3 * 33]); o.z = pk2(s[4 * 33], s[5 * 33]); o.w = pk2(s[6 * 33], s[7 * 33]);
        *(GAS v4u*)(WT + (size_t)(row_off + n0 + n) * ldk + koff + k0 + 8 * c) = o; }
    LDS_WAIT(); asm volatile("" ::: "memory");
}
__device__ __forceinline__ float sat8(float v) { return __builtin_amdgcn_fmed3f(v, -448.f, 448.f); }
__device__ __forceinline__ unsigned fp8x4(float a, float b, float c, float d) { int w = 0; w = __builtin_amdgcn_cvt_pk_fp8_f32(sat8(a), sat8(b), w, false); w = __builtin_amdgcn_cvt_pk_fp8_f32(sat8(c), sat8(d), w, true); return (unsigned)w; }
__device__ __forceinline__ void rms_row_to_bf16(const float* xrow, const float* g, bf16* orow, int lane, unsigned char* o8row = nullptr) {
    const GAS f32x4* xr = (const GAS f32x4*)xrow + lane; const GAS f32x4* gr = (const GAS f32x4*)g + lane;
    f32x4 v[16]; float s = 0.f;
#pragma unroll
    for (int j = 0; j < 16; ++j) { v[j] = xr[64 * j]; s += (v[j].x * v[j].x + v[j].y * v[j].y) + (v[j].z * v[j].z + v[j].w * v[j].w); }
    const float r = 1.0f / sqrtf(wave_sum(s) * (1.f / 4096.f) + EPS);
    GAS v2u* o8 = (GAS v2u*)orow + lane;
#pragma unroll
    for (int j = 0; j < 16; ++j) { const f32x4 gg = gr[64 * j]; const f32x4 hv = (f32x4){v[j].x * r * gg.x, v[j].y * r * gg.y, v[j].z * r * gg.z, v[j].w * r * gg.w};
        v2u o; o.x = pk2(hv.x, hv.y); o.y = pk2(hv.z, hv.w); o8[64 * j] = o;
        if (o8row) ((GAS unsigned*)o8row + lane)[64 * j] = fp8x4(hv.x * FP8_SH, hv.y * FP8_SH, hv.z * FP8_SH, hv.w * FP8_SH); }
}
template <bool XIB, bool XOB>
__device__ __forceinline__ void row_norm_res(const void* xin, const bf16* trow, const float* ssq, const float* gpost, const float* gpre, void* xout, bf16* hout, int lane) {
    const float r1 = 1.0f / sqrtf(wave_sum(ssq[lane]) * (1.f / 4096.f) + EPS);
    const GAS v2u* tr = (const GAS v2u*)trow + lane; const GAS f32x4* gp = (const GAS f32x4*)gpost + lane;
    f32x4 v[16]; float s = 0.f;
#pragma unroll
    for (int j = 0; j < 16; ++j) { f32x4 xv;
        if (XIB) { const v2u xw = ((const GAS v2u*)xin + lane)[64 * j]; xv = (f32x4){bflo(xw.x), bfhi(xw.x), bflo(xw.y), bfhi(xw.y)}; } else xv = ((const GAS f32x4*)xin + lane)[64 * j];
        const v2u tw = tr[64 * j]; const f32x4 gg = gp[64 * j];
        f32x4 o; o.x = xv.x + bflo(tw.x) * r1 * gg.x; o.y = xv.y + bfhi(tw.x) * r1 * gg.y; o.z = xv.z + bflo(tw.y) * r1 * gg.z; o.w = xv.w + bfhi(tw.y) * r1 * gg.w;
        v[j] = o; s += (o.x * o.x + o.y * o.y) + (o.z * o.z + o.w * o.w);
        if (XOB) { v2u ow; ow.x = pk2(o.x, o.y); ow.y = pk2(o.z, o.w); ((GAS v2u*)xout + lane)[64 * j] = ow; } else ((GAS f32x4*)xout + lane)[64 * j] = o; }
    if (hout) {
        const float r2 = 1.0f / sqrtf(wave_sum(s) * (1.f / 4096.f) + EPS);
        const GAS f32x4* gq = (const GAS f32x4*)gpre + lane; GAS v2u* o8 = (GAS v2u*)hout + lane;
#pragma unroll
        for (int j = 0; j < 16; ++j) { const f32x4 gg = gq[64 * j]; v2u o; o.x = pk2(v[j].x * r2 * gg.x, v[j].y * r2 * gg.y); o.y = pk2(v[j].z * r2 * gg.z, v[j].w * r2 * gg.w); o8[64 * j] = o; }
    }
}
__device__ __forceinline__ unsigned cvt2(float lo, float hi) { typedef float f2_t __attribute__((ext_vector_type(2))); typedef __bf16 b2_t __attribute__((ext_vector_type(2))); const f2_t v = {lo, hi}; return __builtin_bit_cast(unsigned, __builtin_convertvector(v, b2_t)); }
template <bool XIB, bool XOB, bool HOUT>
__device__ __forceinline__ void row_phase(Frame& F, const void* xin, const bf16* T, const float* SSQ, const float* gpost, const float* gpre, void* xout, bf16* H, int gw, int NGW) {
    LAS float* gl = (LAS float*)F.lds;
    for (int i = F.tid; i < 1024; i += NWAVES * 64) { *(LAS f32x4*)(gl + 4 * i) = *(const GAS f32x4*)(gpost + 4 * i); if (HOUT) *(LAS f32x4*)(gl + 4096 + 4 * i) = *(const GAS f32x4*)(gpre + 4 * i); }
    __syncthreads();
    v4u xb[8]; f32x4 xf[16]; v4u tb[8]; float sq = 0.f;
#define ROW_ISSUE(m_) do { int mo_ = (m_); asm volatile("" : "+s"(mo_));     \
        const size_t ro_ = (size_t)mo_ * DM + 8 * F.lane; \
        _Pragma("unroll") for (int j = 0; j < 8; ++j) { \
            if constexpr (XIB) xb[j] = *(const GAS v4u*)((const bf16*)xin + ro_ + 512 * j);     \
            tb[j] = *(const GAS v4u*)(T + ro_ + 512 * j); } \
        sq = SSQ[(size_t)(m_) * 64 + F.lane]; } while (0)
    int m = gw; if (m < M) ROW_ISSUE(m);
    for (; m < M; m += NGW) {
        if constexpr (!XIB) { int mx = m; asm volatile("" : "+s"(mx)); const float* xr = (const float*)xin + (size_t)mx * DM + 8 * F.lane;
#pragma unroll
            for (int j = 0; j < 8; ++j) { xf[2 * j] = *(const GAS f32x4*)(xr + 512 * j); xf[2 * j + 1] = *(const GAS f32x4*)(xr + 512 * j + 4); } }
        const float r1 = 1.0f / sqrtf(wave_sum(sq) * (1.f / 4096.f) + EPS);
        f32x4 v[16]; float s = 0.f;
#pragma unroll
        for (int j = 0; j < 8; ++j) { f32x4 x0, x1;
            if constexpr (XIB) { const v4u w = xb[j]; x0 = (f32x4){bflo(w.x), bfhi(w.x), bflo(w.y), bfhi(w.y)}; x1 = (f32x4){bflo(w.z), bfhi(w.z), bflo(w.w), bfhi(w.w)}; } else { x0 = xf[2 * j]; x1 = xf[2 * j + 1]; }
            const v4u tw = tb[j]; const f32x4 t0 = (f32x4){bflo(tw.x), bfhi(tw.x), bflo(tw.y), bfhi(tw.y)}, t1 = (f32x4){bflo(tw.z), bfhi(tw.z), bflo(tw.w), bfhi(tw.w)};
            const f32x4 g0 = *(const LAS f32x4*)(gl + 8 * F.lane + 512 * j), g1 = *(const LAS f32x4*)(gl + 8 * F.lane + 512 * j + 4);
            const f32x4 o0 = x0 + t0 * r1 * g0, o1 = x1 + t1 * r1 * g1; v[2 * j] = o0; v[2 * j + 1] = o1;
            s += ((o0.x * o0.x + o0.y * o0.y) + (o0.z * o0.z + o0.w * o0.w)) + ((o1.x * o1.x + o1.y * o1.y) + (o1.z * o1.z + o1.w * o1.w)); }
        int ms = m; asm volatile("" : "+s"(ms)); const size_t ro = (size_t)ms * DM + 8 * F.lane;
        if (m + NGW < M) ROW_ISSUE(m + NGW);
#pragma unroll
        for (int j = 0; j < 8; ++j) {
            if constexpr (XOB) { v4u o; o.x = cvt2(v[2 * j].x, v[2 * j].y); o.y = cvt2(v[2 * j].z, v[2 * j].w); o.z = cvt2(v[2 * j + 1].x, v[2 * j + 1].y); o.w = cvt2(v[2 * j + 1].z, v[2 * j + 1].w); *(GAS v4u*)((bf16*)xout + ro + 512 * j) = o; }
            else { *(GAS f32x4*)((float*)xout + ro + 512 * j) = v[2 * j]; *(GAS f32x4*)((float*)xout + ro + 512 * j + 4) = v[2 * j + 1]; } }
        if constexpr (HOUT) {
            const float r2 = 1.0f / sqrtf(wave_sum(s) * (1.f / 4096.f) + EPS);
#pragma unroll
            for (int j = 0; j < 8; ++j) { const f32x4 g0 = *(const LAS f32x4*)(gl + 4096 + 8 * F.lane + 512 * j), g1 = *(const LAS f32x4*)(gl + 4096 + 8 * F.lane + 512 * j + 4);
                v4u o; o.x = cvt2(v[2 * j].x * r2 * g0.x, v[2 * j].y * r2 * g0.y); o.y = cvt2(v[2 * j].z * r2 * g0.z, v[2 * j].w * r2 * g0.w);
                o.z = cvt2(v[2 * j + 1].x * r2 * g1.x, v[2 * j + 1].y * r2 * g1.y); o.w = cvt2(v[2 * j + 1].z * r2 * g1.z, v[2 * j + 1].w * r2 * g1.w); *(GAS v4u*)(H + ro + 512 * j) = o; } }
    }
#undef ROW_ISSUE
    __syncthreads();
}
__device__ __forceinline__ void sincos_d(float angf, float& sn, float& cs) {
    const double a = (double)angf; const double n = __builtin_rint(a * 0.6366197723675814);
    double r = __builtin_fma(-n, 1.5707963267948966, a); r = __builtin_fma(-n, 6.123233995736766e-17, r);
    const double r2 = r * r;
    double sp = 1.0 / 6227020800.0; sp = sp * r2 - 1.0 / 39916800.0; sp = sp * r2 + 1.0 / 362880.0; sp = sp * r2 - 1.0 / 5040.0; sp = sp * r2 + 1.0 / 120.0; sp = sp * r2 - 1.0 / 6.0; sp = sp * r2 + 1.0; sp = sp * r;
    double cp = -1.0 / 87178291200.0; cp = cp * r2 + 1.0 / 479001600.0; cp = cp * r2 - 1.0 / 3628800.0; cp = cp * r2 + 1.0 / 40320.0; cp = cp * r2 - 1.0 / 720.0; cp = cp * r2 + 1.0 / 24.0; cp = cp * r2 - 0.5; cp = cp * r2 + 1.0;
    const int q = (int)n & 3;
    const double s = (q == 0) ? sp : (q == 1) ? cp : (q == 2) ? -sp : -cp;
    const double c = (q == 0) ? cp : (q == 1) ? -sp : (q == 2) ? -cp : sp;
    sn = (float)s; cs = (float)c;
}

typedef short v4i16_t __attribute__((ext_vector_type(4)));
__device__ __forceinline__ s16x4 vtr(const LAS unsigned char* p) { return __builtin_bit_cast(s16x4, __builtin_amdgcn_ds_read_tr16_b64_v4i16((LAS v4i16_t*)p)); }
__device__ __forceinline__ unsigned cvtpk(float lo, float hi) { unsigned r; asm volatile("s_nop 0\n\tv_cvt_pk_bf16_f32 %0, %1, %2\n\ts_nop 1" : "=v"(r) : "v"(lo), "v"(hi)); return r; }
constexpr float ATT_C2 = 0.08838834764831845f * 1.4426950408889634f;
constexpr float ATT_SCALE = 0.08838834764831845f;

template <int NR>
__device__ __forceinline__ void att_issue(v4u (&st)[NR / 32], const bf16* src, size_t gstride, int tid) {
#pragma unroll
    for (int it = 0; it < NR / 32; ++it) st[it] = *(const GAS v4u*)(src + (size_t)((tid >> 4) + 32 * it) * gstride + (tid & 15) * 8);
}
template <int NR>
__device__ __forceinline__ void att_write(const v4u (&st)[NR / 32], LAS unsigned char* img, int lrow0, int tid) {
#pragma unroll
    for (int it = 0; it < NR / 32; ++it) *(LAS v4u*)(img + (lrow0 + (tid >> 4) + 32 * it) * ATT_KSTR + (tid & 15) * 16) = st[it];
}
__device__ __forceinline__ void att_q(bf16x8 (&qf)[4], const bf16* qrow, int lane) {
#pragma unroll
    for (int s = 0; s < 4; ++s) qf[s] = *(const GAS bf16x8*)(qrow + 32 * s + 8 * (lane >> 4));
}
template <int NT, bool BAND>
__device__ __forceinline__ void att_core(const LAS unsigned char* Kimg, const LAS unsigned char* Vimg, int krow0, int kmin, int rot  ,
                                         const bf16x8 (&qf)[4]  , bf16* orow  , float* lse_out  , int lane) {
    const int fr = lane & 15, fq = lane >> 4;
    f32x4 sc[NT];
    const LAS unsigned char* kb = Kimg + fr * ATT_KSTR + 16 * fq;
#pragma unroll
    for (int T = 0; T < NT; ++T) { sc[T] = (f32x4){0.f, 0.f, 0.f, 0.f}; const int trow = (krow0 + rot + 16 * T) & 255;
#pragma unroll
        for (int s = 0; s < 4; ++s) { const bf16x8 kf = *(const LAS bf16x8*)(kb + trow * ATT_KSTR + 64 * s);
            sc[T] = __builtin_amdgcn_mfma_f32_16x16x32_bf16(kf, qf[s], sc[T], 0, 0, 0); } }
    const float NEG = -__builtin_inff();
    if (BAND) {
#pragma unroll
        for (int r = 0; r < 4; ++r) { if (4 * fq + r < fr) sc[0][r] = NEG; if (4 * fq + r > fr) sc[NT - 1][r] = NEG; }
        if (kmin > 0) {
#pragma unroll
            for (int T = 0; T < NT; ++T)
#pragma unroll
                for (int r = 0; r < 4; ++r) if (krow0 + 16 * T + 4 * fq + r < kmin) sc[T][r] = NEG;
        }
    }
    float mx = sc[0][0];
#pragma unroll
    for (int T = 0; T < NT; ++T)
#pragma unroll
        for (int r = 0; r < 4; ++r) mx = fmaxf(mx, sc[T][r]);
    mx = fmaxf(mx, __shfl_xor(mx, 16)); mx = fmaxf(mx, __shfl_xor(mx, 32));
    const float mL = mx * ATT_C2; float l = 0.f;
#pragma unroll
    for (int T = 0; T < NT; ++T)
#pragma unroll
        for (int r = 0; r < 4; ++r) { const float p = __builtin_amdgcn_exp2f(sc[T][r] * ATT_C2 - mL); sc[T][r] = p; l += p; }
    l += __shfl_xor(l, 16); l += __shfl_xor(l, 32);
    constexpr int NKS = (NT + 1) / 2;
    f32x4 oa[8];
#pragma unroll
    for (int c = 0; c < 8; ++c) oa[c] = (f32x4){0.f, 0.f, 0.f, 0.f};
    const LAS unsigned char* vb = Vimg + (4 * fq + (fr >> 2)) * ATT_KSTR + 8 * (fr & 3);
#pragma unroll
    for (int ks = 0; ks < NKS; ++ks) { const int vr0 = (krow0 + rot + 32 * ks) & 255, vr1 = (krow0 + rot + 32 * ks + 16) & 255;
        v4u pw; pw.x = cvtpk(sc[2 * ks][0], sc[2 * ks][1]); pw.y = cvtpk(sc[2 * ks][2], sc[2 * ks][3]);
        if (2 * ks + 1 < NT) { pw.z = cvtpk(sc[2 * ks + 1 < NT ? 2 * ks + 1 : 0][0], sc[2 * ks + 1 < NT ? 2 * ks + 1 : 0][1]); pw.w = cvtpk(sc[2 * ks + 1 < NT ? 2 * ks + 1 : 0][2], sc[2 * ks + 1 < NT ? 2 * ks + 1 : 0][3]); }
        else { pw.z = 0u; pw.w = 0u; }
        const bf16x8 pf = __builtin_bit_cast(bf16x8, pw);
#pragma unroll
        for (int c = 0; c < 8; ++c) { const s16x4 lo = vtr(vb + vr0 * ATT_KSTR + 32 * c), hi = vtr(vb + vr1 * ATT_KSTR + 32 * c);
            const bf16x8 vf = __builtin_shufflevector(lo, hi, 0, 1, 2, 3, 4, 5, 6, 7);
            oa[c] = __builtin_amdgcn_mfma_f32_16x16x32_bf16(vf, pf, oa[c], 0, 0, 0); }
    }
    const float rl = 1.0f / l;
#pragma unroll
    for (int c = 0; c < 8; ++c) { v2u o; o.x = cvtpk(oa[c][0] * rl, oa[c][1] * rl); o.y = cvtpk(oa[c][2] * rl, oa[c][3] * rl); *(GAS v2u*)(orow + 16 * c + 4 * fq) = o; }
    if (lse_out && fq == 0) *lse_out = mx * ATT_SCALE + __logf(l);
}
struct SaUnit { int g, d, qb, h; size_t tok0, col; };
__device__ __forceinline__ SaUnit sa_unit(int i, int per, int G, int bx) {
    int c, h;
    if (per > 0) { c = (bx >> 3) * per + i; h = bx & 7; } else { const int idx = bx + i * G; c = idx >> 3; h = idx & 7; }
    SaUnit u; u.g = c >> 7; const int cc = c & 127, sh = 2 * u.g, nblk = 32 >> sh; u.d = 1 << sh;
    u.qb = cc % nblk; const int t1 = cc / nblk, r = t1 % u.d, b = t1 / u.d; u.h = h;
    u.tok0 = (size_t)b * SEQ + r; u.col = (size_t)u.g * 1024 + h * 128; return u;
}
__device__ __forceinline__ void sa_issue(v4u (&stK)[8], v4u (&stV)[8], const bf16* K, const bf16* V, const SaUnit& u, bool shared, int tid) {
    const size_t gs = (size_t)u.d * QKVW; const int pb = 128 * (u.qb - 1) + (tid >> 4); const int fix = u.qb == 0 ? 128 : 0;
    const size_t base = u.tok0 * QKVW + u.col + (tid & 15) * 8;
    if (!shared) {
#pragma unroll
        for (int it = 0; it < 4; ++it) { const size_t off = base + (size_t)(pb + 32 * it + fix) * gs; stK[it] = *(const GAS v4u*)(K + off); stV[it] = *(const GAS v4u*)(V + off); } }
#pragma unroll
    for (int it = 4; it < 8; ++it) { const size_t off = base + (size_t)(pb + 32 * it) * gs; stK[it] = *(const GAS v4u*)(K + off); stV[it] = *(const GAS v4u*)(V + off); }
}
__device__ __forceinline__ void sa_write(const v4u (&stK)[8], const v4u (&stV)[8], LAS unsigned char* Kimg, LAS unsigned char* Vimg, bool shared, int rot, int tid) {
    if (!shared) {
#pragma unroll
        for (int it = 0; it < 4; ++it) { const int o = ((((tid >> 4) + 32 * it) + rot) & 255) * ATT_KSTR + (tid & 15) * 16; *(LAS v4u*)(Kimg + o) = stK[it]; *(LAS v4u*)(Vimg + o) = stV[it]; } }
#pragma unroll
    for (int it = 4; it < 8; ++it) { const int o = ((((tid >> 4) + 32 * it) + rot) & 255) * ATT_KSTR + (tid & 15) * 16; *(LAS v4u*)(Kimg + o) = stK[it]; *(LAS v4u*)(Vimg + o) = stV[it]; }
}
__device__ __forceinline__ void self_attn_stream(Frame& F, const bf16* Q, const bf16* K, const bf16* V, bf16* OG, float* LSE) {
    LAS unsigned char* Kimg = F.lds + ATT_K_OFF; LAS unsigned char* Vimg = F.lds + ATT_V_OFF;
    const int bx = (int)blockIdx.x, G = F.G, per = (G % 8 == 0 && 3072 % G == 0) ? 3072 / G : 0, n = per ? per : (3072 - bx + G - 1) / G;
    if (n <= 0) return;
    v4u stK[8], stV[8]; SaUnit u = sa_unit(0, per, G, bx); bool shared = false; int rot = 0;
    size_t tok = u.tok0 + (size_t)(128 * u.qb + 16 * F.wave + (F.lane & 15)) * u.d;
    bf16x8 qn[4]; att_q(qn, Q + tok * QKVW + u.col, F.lane);
    sa_issue(stK, stV, K, V, u, false, F.tid);
    for (int i = 0; i < n; ++i) {
        sa_write(stK, stV, Kimg, Vimg, shared, rot, F.tid);
        __syncthreads();
        bf16x8 qf[4];
#pragma unroll
        for (int s = 0; s < 4; ++s) qf[s] = qn[s];
        const int kmin = u.qb == 0 ? 128 : 0, crot = rot; bf16* orow = OG + ((size_t)u.g * M + tok) * AW + u.h * 128; float* lse = LSE + ((size_t)u.g * M + tok) * 8 + u.h;
        const bool more = i + 1 < n;
        if (more) { const SaUnit nu = sa_unit(i + 1, per, G, bx);
            shared = (nu.g == u.g) && (nu.tok0 == u.tok0) && (nu.h == u.h) && (nu.qb == u.qb + 1);
            rot = shared ? (rot ^ 128) : 0; u = nu;
            tok = u.tok0 + (size_t)(128 * u.qb + 16 * F.wave + (F.lane & 15)) * u.d;
            sa_issue(stK, stV, K, V, u, shared, F.tid); att_q(qn, Q + tok * QKVW + u.col, F.lane); }
        att_core<9, true>(Kimg, Vimg, 16 * F.wave, kmin, crot, qf, orow, lse, F.lane);
        __syncthreads();
    }
}
__device__ __forceinline__ void cross_attn_stream(Frame& F, const bf16* QX, const bf16* KVX, bf16* OX) {
    LAS unsigned char* Kimg = F.lds + ATT_K_OFF; LAS unsigned char* Vimg = F.lds + ATT_V_OFF;
    const int per = (512 % F.G == 0) ? 512 / F.G : 0;
    const int n = per ? per : (512 - (int)blockIdx.x + F.G - 1) / F.G; int loaded = -1;
    for (int i = 0; i < n; ++i) { const int idx = per ? (int)blockIdx.x * per + i : (int)blockIdx.x + i * F.G; if (idx >= 512) break;
        const int qblk = idx & 31, bh = idx >> 5, h = bh & 3, b = bh >> 2;
        if (bh != loaded) { if (loaded >= 0) __syncthreads();
            const size_t off = (size_t)b * NMEM * 1024 + h * 128;
            v4u stK[8], stV[8]; att_issue<256>(stK, KVX + off, 1024, F.tid); att_issue<256>(stV, KVX + off + 512, 1024, F.tid);
            att_write<256>(stK, Kimg, 0, F.tid); att_write<256>(stV, Vimg, 0, F.tid);
            __syncthreads(); loaded = bh; }
        const size_t tok = (size_t)b * SEQ + 128 * qblk + 16 * F.wave + (F.lane & 15);
        bf16x8 qf[4]; att_q(qf, QX + tok * XAW + h * 128, F.lane);
        att_core<16, false>(Kimg, Vimg, 0, 0, 0, qf, OX + tok * XAW + h * 128, nullptr, F.lane);
    }
    __syncthreads();
}
__device__ __forceinline__ void sgu_unit(Frame& F, int idx, const bf16* U, bf16* YB, const bf16* VB, const float* lnstat, const float* lng, const float* lnb, const bf16* WSP, const float* bsp) {
    const int g = idx & 15, cn = idx >> 4, C0 = g * 128; const size_t tok0 = (size_t)cn * 128;
    LAS unsigned char* img = F.lds; LAS f32x2* stat = (LAS f32x2*)(F.lds + 40960);
    if (F.tid < 128) { const float* sp = lnstat + (tok0 + F.tid) * 64; float s = 0.f, q = 0.f;
#pragma unroll
        for (int k = 0; k < 16; ++k) { const f32x4 v = *(const GAS f32x4*)(sp + 4 * k); s += v.x + v.z; q += v.y + v.w; }
        const float mu = s * (1.f / 2048.f), var = q * (1.f / 2048.f) - mu * mu; stat[F.tid] = (f32x2){mu, 1.0f / sqrtf(var + EPS)}; }
    __syncthreads();
    { const int ch = F.tid & 15; const float* gp = lng + C0 + 8 * ch; const float* bp = lnb + C0 + 8 * ch;
      const f32x4 g0 = *(const GAS f32x4*)gp, g1 = *(const GAS f32x4*)(gp + 4), b0 = *(const GAS f32x4*)bp, b1 = *(const GAS f32x4*)(bp + 4);
      v4u raw[4];
#pragma unroll
      for (int it = 0; it < 4; ++it) raw[it] = *(const GAS v4u*)(VB + (tok0 + (F.tid >> 4) + 32 * it) * SGW + C0 + 8 * ch);
#pragma unroll
      for (int it = 0; it < 4; ++it) { const int j = (F.tid >> 4) + 32 * it; const f32x2 st = stat[j]; const v4u w = raw[it]; v4u o;
          o.x = cvtpk((bflo(w.x) - st.x) * st.y * g0.x + b0.x, (bfhi(w.x) - st.x) * st.y * g0.y + b0.y); o.y = cvtpk((bflo(w.y) - st.x) * st.y * g0.z + b0.z, (bfhi(w.y) - st.x) * st.y * g0.w + b0.w);
          o.z = cvtpk((bflo(w.z) - st.x) * st.y * g1.x + b1.x, (bfhi(w.z) - st.x) * st.y * g1.y + b1.y); o.w = cvtpk((bflo(w.w) - st.x) * st.y * g1.z + b1.z, (bfhi(w.w) - st.x) * st.y * g1.w + b1.w);
          *(LAS v4u*)(img + j * ATT_KSTR + ch * 16) = o; } }
    __syncthreads();
    const int fr = F.lane & 15, fq = F.lane >> 4, w = F.wave, nsteps = (w >> 1) + 1;
    f32x4 acc[8];
#pragma unroll
    for (int c = 0; c < 8; ++c) acc[c] = (f32x4){0.f, 0.f, 0.f, 0.f};
    const bf16* wrow = WSP + ((size_t)g * 128 + 16 * w + fr) * 128 + 8 * fq;
    const LAS unsigned char* vb = img + (8 * fq + (fr >> 2)) * ATT_KSTR + 8 * (fr & 3);
    for (int s = 0; s < nsteps; ++s) { const bf16x8 wf = *(const GAS bf16x8*)(wrow + 32 * s);
#pragma unroll
        for (int c = 0; c < 8; ++c) { const s16x4 lo = vtr(vb + (32 * s) * ATT_KSTR + 32 * c), hi = vtr(vb + (32 * s + 4) * ATT_KSTR + 32 * c);
            const bf16x8 vf = __builtin_shufflevector(lo, hi, 0, 1, 2, 3, 4, 5, 6, 7);
            acc[c] = __builtin_amdgcn_mfma_f32_16x16x32_bf16(vf, wf, acc[c], 0, 0, 0); } }
    const float bias = bsp[g * 128 + 16 * w + fr];
    const bf16* urow = U + (tok0 + 16 * w + fr) * SGW + C0 + 4 * fq; bf16* yrow = YB + (tok0 + 16 * w + fr) * (AW + SGW) + AW + C0 + 4 * fq;
#pragma unroll
    for (int c = 0; c < 8; ++c) { const v2u uw = *(const GAS v2u*)(urow + 16 * c); v2u o;
        o.x = cvtpk(bflo(uw.x) * (acc[c][0] + bias), bfhi(uw.x) * (acc[c][1] + bias)); o.y = cvtpk(bflo(uw.y) * (acc[c][2] + bias), bfhi(uw.y) * (acc[c][3] + bias));
        *(GAS v2u*)(yrow + 16 * c) = o; }
    __syncthreads();
}

__device__ __forceinline__ void sgu_stream(Frame& F, int per, const bf16* U, bf16* YB, const bf16* VB, const float* lnstat, const float* lng, const float* lnb, const bf16* WSP, const float* bsp) {
    const int idx0 = (int)blockIdx.x * per, cn = idx0 >> 4, g0 = idx0 & 15; const size_t tok0 = (size_t)cn * 128;
    LAS unsigned char* img = F.lds; LAS f32x2* stat = (LAS f32x2*)(F.lds + 40960);
    if (F.tid < 128) { const float* sp = lnstat + (tok0 + F.tid) * 64; float s = 0.f, q = 0.f;
#pragma unroll
        for (int k = 0; k < 16; ++k) { const f32x4 v = *(const GAS f32x4*)(sp + 4 * k); s += v.x + v.z; q += v.y + v.w; }
        const float mu = s * (1.f / 2048.f), var = q * (1.f / 2048.f) - mu * mu; stat[F.tid] = (f32x2){mu, 1.0f / sqrtf(var + EPS)}; }
    const int ch = F.tid & 15, fr = F.lane & 15, fq = F.lane >> 4, w = F.wave, nsteps = (w >> 1) + 1;
    v4u raw[4];
#pragma unroll
    for (int it = 0; it < 4; ++it) raw[it] = *(const GAS v4u*)(VB + (tok0 + (F.tid >> 4) + 32 * it) * SGW + g0 * 128 + 8 * ch);
    __syncthreads();
    const LAS unsigned char* vb = img + (8 * fq + (fr >> 2)) * ATT_KSTR + 8 * (fr & 3);
    for (int i = 0; i < per; ++i) { const int g = g0 + i, C0 = g * 128;
        { const float* gp = lng + C0 + 8 * ch; const float* bp = lnb + C0 + 8 * ch;
          const f32x4 ga = *(const GAS f32x4*)gp, gb = *(const GAS f32x4*)(gp + 4), ba = *(const GAS f32x4*)bp, bb = *(const GAS f32x4*)(bp + 4);
#pragma unroll
          for (int it = 0; it < 4; ++it) { const int j = (F.tid >> 4) + 32 * it; const f32x2 st = stat[j]; const v4u wv = raw[it]; v4u o;
              o.x = cvtpk((bflo(wv.x) - st.x) * st.y * ga.x + ba.x, (bfhi(wv.x) - st.x) * st.y * ga.y + ba.y); o.y = cvtpk((bflo(wv.y) - st.x) * st.y * ga.z + ba.z, (bfhi(wv.y) - st.x) * st.y * ga.w + ba.w);
              o.z = cvtpk((bflo(wv.z) - st.x) * st.y * gb.x + bb.x, (bfhi(wv.z) - st.x) * st.y * gb.y + bb.y); o.w = cvtpk((bflo(wv.w) - st.x) * st.y * gb.z + bb.z, (bfhi(wv.w) - st.x) * st.y * gb.w + bb.w);
              *(LAS v4u*)(img + j * ATT_KSTR + ch * 16) = o; } }
        __syncthreads();
        const bf16* wrow = WSP + ((size_t)g * 128 + 16 * w + fr) * 128 + 8 * fq;
        bf16x8 wf[4];
#pragma unroll
        for (int s = 0; s < 4; ++s) wf[s] = *(const GAS bf16x8*)(wrow + 32 * (s < nsteps ? s : 0));
        const bf16* urow = U + (tok0 + 16 * w + fr) * SGW + C0 + 4 * fq; bf16* yrow = YB + (tok0 + 16 * w + fr) * (AW + SGW) + AW + C0 + 4 * fq;
        v2u uw[8];
#pragma unroll
        for (int c = 0; c < 8; ++c) uw[c] = *(const GAS v2u*)(urow + 16 * c);
        const float bias = bsp[g * 128 + 16 * w + fr];
        if (i + 1 < per) {
#pragma unroll
            for (int it = 0; it < 4; ++it) raw[it] = *(const GAS v4u*)(VB + (tok0 + (F.tid >> 4) + 32 * it) * SGW + C0 + 128 + 8 * ch); }
        f32x4 acc[8];
#pragma unroll
        for (int c = 0; c < 8; ++c) acc[c] = (f32x4){0.f, 0.f, 0.f, 0.f};
#pragma unroll
        for (int s = 0; s < 4; ++s) { if (s < nsteps) {
#pragma unroll
            for (int c = 0; c < 8; ++c) { const s16x4 lo = vtr(vb + (32 * s) * ATT_KSTR + 32 * c), hi = vtr(vb + (32 * s + 4) * ATT_KSTR + 32 * c);
                const bf16x8 vf = __builtin_shufflevector(lo, hi, 0, 1, 2, 3, 4, 5, 6, 7);
                acc[c] = __builtin_amdgcn_mfma_f32_16x16x32_bf16(vf, wf[s], acc[c], 0, 0, 0); } } }
#pragma unroll
        for (int c = 0; c < 8; ++c) { v2u o;
            o.x = cvtpk(bflo(uw[c].x) * (acc[c][0] + bias), bfhi(uw[c].x) * (acc[c][1] + bias)); o.y = cvtpk(bflo(uw[c].y) * (acc[c][2] + bias), bfhi(uw[c].y) * (acc[c][3] + bias));
            *(GAS v2u*)(yrow + 16 * c) = o; }
        __syncthreads();
    }
}

struct ConvJob { const float* W; bf16* WT; int K, N, row_off, ldk, koff, item, fp8, ldn; };
__device__ __forceinline__ void conv_load(f32x4 (&v)[16], const ConvJob& j, int lane) {
    const int nblk = j.N >> 6, kb = j.item / nblk, nb = j.item - kb * nblk;
    const float* src = j.W + (size_t)(64 * kb + (lane >> 4)) * j.ldn + 64 * nb + 4 * (lane & 15); const size_t st = (size_t)4 * j.ldn;
#pragma unroll
    for (int i = 0; i < 16; ++i) v[i] = *(const GAS f32x4*)(src + i * st);
}
__device__ __forceinline__ void conv_to_lds(const f32x4 (&v)[16], LAS unsigned char* scr, int lane) {
#pragma unroll
    for (int i = 0; i < 16; ++i) { v2u o; o.x = cvt2(v[i].x, v[i].y); o.y = cvt2(v[i].z, v[i].w); *(LAS v2u*)(scr + ((lane >> 4) + 4 * i) * 144 + 8 * (lane & 15)) = o; }
}
__device__ __forceinline__ void conv_store(const ConvJob& j, const LAS unsigned char* scr, int lane) {
    const int nblk = j.N >> 6, kb = j.item / nblk, nb = j.item - kb * nblk, i16 = lane & 15, fq = lane >> 4;
    const LAS unsigned char* rb = scr + (8 * fq + (i16 >> 2)) * 144 + 8 * (i16 & 3);
    bf16* dst = j.WT + (size_t)(j.row_off + 64 * nb + i16) * j.ldk + j.koff + 64 * kb + 8 * fq;
#pragma unroll
    for (int jj = 0; jj < 8; ++jj) { const int nb16 = jj & 3, kh = jj >> 2;
        const s16x4 lo = vtr(rb + (32 * kh) * 144 + 32 * nb16), hi = vtr(rb + (32 * kh + 4) * 144 + 32 * nb16);
        const bf16x8 o = __builtin_shufflevector(lo, hi, 0, 1, 2, 3, 4, 5, 6, 7);
        if (j.fp8) { const v4u w = __builtin_bit_cast(v4u, o); v2u q;
            q.x = fp8x4(bflo(w.x) * FP8_SW, bfhi(w.x) * FP8_SW, bflo(w.y) * FP8_SW, bfhi(w.y) * FP8_SW); q.y = fp8x4(bflo(w.z) * FP8_SW, bfhi(w.z) * FP8_SW, bflo(w.w) * FP8_SW, bfhi(w.w) * FP8_SW);
            *(GAS v2u*)((unsigned char*)j.WT + (size_t)(j.row_off + 64 * nb + i16 + 16 * nb16) * j.ldk + j.koff + 64 * kb + 8 * fq + 32 * kh) = q; }
        else *(GAS bf16x8*)(dst + (size_t)(16 * nb16) * j.ldk + 32 * kh) = o; }
}
#define CONV_STREAM(LO_, HI_, CTR_, DECODE_) do { \
        LAS unsigned char* scr_ = F.lds + RING_OFF + F.wave * 16384; volatile LAS unsigned* tkL_ = (volatile LAS unsigned*)(F.lds + MISC_OFF + 64); \
        f32x4 cv_[16]; ConvJob cur_, nxt_; unsigned tv_ = 0u; int rnd_ = 0; \
        if (F.tid == 0) { tkL_[0] = __hip_atomic_fetch_add((CTR_), 1u, __ATOMIC_RELAXED, __HIP_MEMORY_SCOPE_AGENT); tkL_[1] = __hip_atomic_fetch_add((CTR_), 1u, __ATOMIC_RELAXED, __HIP_MEMORY_SCOPE_AGENT); } \
        __syncthreads(); \
        int tc_ = (int)tkL_[0], tn_ = (int)tkL_[1]; \
        __syncthreads(); \
        int it_ = (LO_) + 8 * tc_ + F.wave; bool have_ = it_ < (HI_); \
        if (have_) { DECODE_(it_, cur_); conv_load(cv_, cur_, F.lane); } \
        while ((LO_) + 8 * tc_ < (HI_)) { \
            if (F.tid == 0) tv_ = __hip_atomic_fetch_add((CTR_), 1u, __ATOMIC_RELAXED, __HIP_MEMORY_SCOPE_AGENT); \
            if (have_) conv_to_lds(cv_, scr_, F.lane); \
            const int itn_ = (LO_) + 8 * tn_ + F.wave; const bool more_ = itn_ < (HI_); \
            if (more_) { DECODE_(itn_, nxt_); conv_load(cv_, nxt_, F.lane); } \
            if (have_) { asm volatile("s_waitcnt lgkmcnt(0)" ::: "memory"); conv_store(cur_, scr_, F.lane); asm volatile("s_waitcnt lgkmcnt(0)" ::: "memory"); } \
            if (F.tid == 0) tkL_[rnd_ & 1] = tv_; \
            __syncthreads(); \
            tc_ = tn_; tn_ = (int)tkL_[rnd_ & 1]; cur_ = nxt_; have_ = more_; ++rnd_; } \
        __syncthreads(); \
    } while (0)

struct Args { const float* in[26]; float* out; unsigned char* ws; int ph_lo, ph_hi, li, pad; };
constexpr float ROPE_INV[16] = {1.0f, 0.44036659598350525f, 0.1939227432012558f, 0.08539710193872452f, 0.03760603070259094f, 0.01656043902039528f, 0.007292664609849453f, 0.0032114458736032248f,
    0.0014142135623842478f, 0.000622772378847003f, 0.00027424818836152554f, 0.00012076973507646471f, 5.318296098266728e-05f, 2.34199997066753e-05f, 1.0313386155758053e-05f, 4.541670477919979e-06f};

__global__ void __launch_bounds__(NWAVES * 64, 2) skel_fwd(Args args) {
    extern __shared__ __attribute__((aligned(16))) unsigned char lds[];
    Frame F;
    F.lds = (LAS unsigned char*)lds;
    F.MISC = (volatile LAS unsigned*)(F.lds + MISC_OFF);
    F.tid = threadIdx.x; F.lane = F.tid & 63; F.wave = __builtin_amdgcn_readfirstlane(F.tid >> 6);
    F.G = gridDim.x; { const int bx = blockIdx.x; F.vcu = (F.G % 8 == 0) ? (bx % 8) * (F.G / 8) + bx / 8 : bx; }
    unsigned char* ws = args.ws; F.ws = ws;
    F.ctl = (gu32*)(ws + WS_CTL);
    const float* x = args.in[0]; const float* mem = args.in[1]; const int* positions = (const int*)args.in[2]; const float* mix_pre_g = args.in[3]; const float* w_in = args.in[4];
    const float* sgu_ln_g = args.in[5]; const float* sgu_ln_b = args.in[6]; const float* w_spatial = args.in[7]; const float* b_spatial = args.in[8];
    const float* w_branch_a = args.in[9]; const float* w_branch_b = args.in[10]; const float* w_gate = args.in[11]; const float* b_gate = args.in[12]; const float* w_out = args.in[13];
    const float* mix_post_g = args.in[14]; const float* xa_pre_g = args.in[15]; const float* mem_norm_g = args.in[16];
    const float* w_xq = args.in[17]; const float* w_xk = args.in[18]; const float* w_xv = args.in[19]; const float* w_xo = args.in[20];
    const float* xa_post_g = args.in[21]; const float* mlp_pre_g = args.in[22]; const float* w_up = args.in[23]; const float* w_down = args.in[24]; const float* mlp_post_g = args.in[25];
    float* out = args.out;
    float* ROPE = (float*)(ws + WS_ROPE); float* LNST = (float*)(ws + WS_LNST); float* SSQ = (float*)(ws + WS_SSQ); float* LSE = (float*)(ws + WS_LSE);
    bf16* WSP = (bf16*)(ws + WS_WSP); bf16* WING = (bf16*)(ws + WS_WING); unsigned char* WG8 = ws + WS_WG8; unsigned char* H8 = ws + WS_H8; bf16* WAB = (bf16*)(ws + WS_WA); bf16* WOUT = (bf16*)(ws + WS_WOUT);
    bf16* WXQ = (bf16*)(ws + WS_WXQ); bf16* WKV = (bf16*)(ws + WS_WKV); bf16* WXO = (bf16*)(ws + WS_WXO); bf16* WUP = (bf16*)(ws + WS_WUP); bf16* WDN = (bf16*)(ws + WS_WDN);
    bf16* H = (bf16*)(ws + WS_H); bf16* Qb = (bf16*)(ws + WS_Q); bf16* Kb = (bf16*)(ws + WS_K); bf16* Vb = (bf16*)(ws + WS_V); bf16* Ub = (bf16*)(ws + WS_U); bf16* VBb = (bf16*)(ws + WS_VB);
    unsigned char* Gb = ws + WS_G; bf16* MRG = (bf16*)(ws + WS_MRG); bf16* OG = (bf16*)(ws + WS_OG); bf16* KVX = (bf16*)(ws + WS_KVX); bf16* MB = (bf16*)(ws + WS_MB);
    bf16* T = (bf16*)(ws + WS_T); bf16* QX = (bf16*)(ws + WS_QX); bf16* OX = (bf16*)(ws + WS_OX); bf16* Ab = (bf16*)(ws + WS_A); bf16* T3 = (bf16*)(ws + WS_T3); bf16* XB = (bf16*)(ws + WS_XB); bf16* YAB = (bf16*)(ws + WS_YAB); constexpr int YABW = AW + SGW;

    for (int u = F.tid; u < (LDS_BYTES - MISC_OFF) / 4; u += NWAVES * 64) ((LAS unsigned*)(F.lds + MISC_OFF))[u] = 0u;
    __syncthreads();
#if MK_PER_PHASE
#define GRID_BAR() do { } while (0)
#else
    XcdBarrier bar = xcd_barrier_post((unsigned*)(F.ctl + CW_BAR) + args.li * XCD_BAR_WORDS, F.MISC + 8);
#define GRID_BAR() xcd_barrier(bar)
#endif
    const int lo = args.ph_lo, hi = args.ph_hi;
#define IN(k) (lo <= (k) && (k) < hi)
#define BOTH(k) (IN(k) && IN((k) + 1))
    const int gw = F.vcu * NWAVES + F.wave, NGW = F.G * NWAVES, bx = (int)blockIdx.x;
    const int gtid = bx * (NWAVES * 64) + F.tid, NGT = F.G * NWAVES * 64;
    constexpr int I_UP = 64 * (DFF / 64), I_DN = (DFF / 64) * (DM / 64), P7_BUSY = 144, CONV_PER_WAVE = 18;
    const int conv_early = (F.G > P7_BUSY) ? (((F.G - P7_BUSY) * NWAVES * CONV_PER_WAVE < I_UP + I_DN) ? (F.G - P7_BUSY) * NWAVES * CONV_PER_WAVE : I_UP + I_DN) : 0;

    if (IN(0)) {
        constexpr int I_IN = 64 * (2 * SGW / 64), I_G = 64 * (GW / 64), I_A = 16 * 64, I_B = 32 * 64, I_O = 64 * 64, I_XQ = 64 * 8, I_XO = 8 * 64;
        constexpr int I_QK8 = 64 * (3 * QKVW / 64) / 2;
        constexpr int NITEMS = I_IN + I_G + I_A + I_B + I_O + 3 * I_XQ + I_XO + 2 * I_QK8;
#define P0_DECODE(r_, J) do { int r = (r_); \
            if (r < I_IN) { J = ConvJob{w_in + 3 * QKVW, WING, DM, 2 * SGW, 0, DM, 0, r, 0, INW}; break; } r -= I_IN; \
            if (r < I_G) { J = ConvJob{w_gate, (bf16*)WG8, DM, GW, 0, DM, 0, r, 1, GW}; break; } r -= I_G; \
            if (r < I_A) { J = ConvJob{w_branch_a, WAB, AW, DM, 0, AW + SGW, 0, r, 0, DM}; break; } r -= I_A; \
            if (r < I_B) { J = ConvJob{w_branch_b, WAB, SGW, DM, 0, AW + SGW, AW, r, 0, DM}; break; } r -= I_B; \
            if (r < I_O) { J = ConvJob{w_out, WOUT, DM, DM, 0, DM, 0, r, 0, DM}; break; } r -= I_O; \
            if (r < I_XQ) { J = ConvJob{w_xq, WXQ, DM, XAW, 0, DM, 0, r, 0, XAW}; break; } r -= I_XQ; \
            if (r < I_XQ) { J = ConvJob{w_xk, WKV, DM, XAW, 0, DM, 0, r, 0, XAW}; break; } r -= I_XQ; \
            if (r < I_XQ) { J = ConvJob{w_xv, WKV, DM, XAW, XAW, DM, 0, r, 0, XAW}; break; } r -= I_XQ; \
            if (r < I_XO) { J = ConvJob{w_xo, WXO, XAW, DM, 0, XAW, 0, r, 0, DM}; break; } r -= I_XO; \
            if (r < I_QK8) { J = ConvJob{w_in, (bf16*)WG8, DM, 3 * QKVW / 2, GW, DM, 0, r, 1, INW}; break; } r -= I_QK8; \
            J = ConvJob{w_in + 3 * QKVW / 2, (bf16*)WG8, DM, 3 * QKVW / 2, GW + 3 * QKVW / 2, DM, 0, r, 1, INW}; } while (0)
        for (int m = gw; m < M; m += NGW) rms_row_to_bf16(x + (size_t)m * DM, mix_pre_g, H + (size_t)m * DM, F.lane, H8 + (size_t)m * DM);
        for (int m = gw; m < MROWS; m += NGW) rms_row_to_bf16(mem + (size_t)m * DM, mem_norm_g, MB + (size_t)m * DM, F.lane);
        __syncthreads();
        CONV_STREAM(0, NITEMS, F.ctl + CW_TICKET, P0_DECODE);
#undef P0_DECODE
        for (int i = gtid; i < M * 16; i += NGT) { const int tok = i >> 4, k = i & 15; const float ang = (float)positions[tok] * ROPE_INV[k]; float sn, cs; sincos_d(ang, sn, cs);
            ROPE[(size_t)tok * 32 + k] = cs; ROPE[(size_t)tok * 32 + 16 + k] = sn; }
        for (int i = gtid; i < 16 * 128 * 128; i += NGT) { const int jj = i & 127, ii = (i >> 7) & 127; WSP[i] = (bf16)(jj <= ii ? f2bf(w_spatial[i]) : 0u); }
        if (BOTH(0)) GRID_BAR();
    }
    if (IN(1)) {
        { pg8::Gemm g{H, WING, M, 2 * SGW, DM}; pg8::StaticOrder S; S.init(M, 2 * SGW, F.G, bx);
          pg8::EpiProjUV E{pg8::EpiProj{Qb, Kb, Vb, Ub, VBb, Gb, ROPE, b_gate, LNST, 1.0f}};
          pg8::gemm_phase<pg8::EpiProjUV, pg8::StaticOrder, PG8_ALIGN, PG8_SP2>(F.lds + RING_OFF, g, S, E); }
        VM_WAIT(); __syncthreads();
        { pg8::Gemm g{(const bf16*)H8, (const bf16*)WG8, M, GW + 3 * QKVW, DM / 2}; pg8::StaticOrder S; S.init(M, GW + 3 * QKVW, F.G, bx);
          constexpr float inv8 = 1.0f / (FP8_SH * FP8_SW);
          pg8::EpiGatesQK E{pg8::EpiGates{Gb, b_gate, inv8}, pg8::EpiProj{Qb, Kb, Vb, Ub, VBb, Gb, ROPE, b_gate, LNST, inv8}};
          pg8::gemm_phase<pg8::EpiGatesQK, pg8::StaticOrder, PG8_ALIGN, PG8_SP2, true>(F.lds + RING_OFF, g, S, E); }
        if (BOTH(1)) GRID_BAR();
    }
    if (IN(2)) {
        for (int i = F.tid; i < 16 * ATT_KSTR / 4; i += NWAVES * 64) ((LAS unsigned*)(F.lds + ATT_V_OFF + 256 * ATT_KSTR))[i] = 0u;
        __syncthreads();
        self_attn_stream(F, Qb, Kb, Vb, OG, LSE);
        { const int per = (2048 % F.G == 0) ? 2048 / F.G : 0;
          if (per == 1 || per == 2 || per == 4 || per == 8 || per == 16) sgu_stream(F, per, Ub, YAB, VBb, LNST, sgu_ln_g, sgu_ln_b, WSP, b_spatial);
          else for (int idx = bx; idx < 2048; idx += F.G) sgu_unit(F, idx, Ub, YAB, VBb, LNST, sgu_ln_g, sgu_ln_b, WSP, b_spatial); }
        if (BOTH(2)) GRID_BAR();
    }
    if (IN(3)) {
        for (int i = gtid; i < M * 8 * 16; i += NGT) { const int ch = i & 15, hh = (i >> 4) & 7; const size_t tok = (size_t)(i >> 7);
            const float l0 = LSE[tok * 8 + hh], l1 = LSE[((size_t)M + tok) * 8 + hh], l2 = LSE[((size_t)2 * M + tok) * 8 + hh];
            const float mx = fmaxf(l0, fmaxf(l1, l2)); float e0 = __expf(l0 - mx), e1 = __expf(l1 - mx), e2 = __expf(l2 - mx); const float inv = 1.0f / (e0 + e1 + e2); e0 *= inv; e1 *= inv; e2 *= inv;
            const size_t o = tok * AW + hh * 128 + ch * 8;
            const v4u a = *(const GAS v4u*)(OG + o), b = *(const GAS v4u*)(OG + (size_t)M * AW + o), c = *(const GAS v4u*)(OG + (size_t)2 * M * AW + o); v4u y;
            y.x = pk2(e0 * bflo(a.x) + e1 * bflo(b.x) + e2 * bflo(c.x), e0 * bfhi(a.x) + e1 * bfhi(b.x) + e2 * bfhi(c.x));
            y.y = pk2(e0 * bflo(a.y) + e1 * bflo(b.y) + e2 * bflo(c.y), e0 * bfhi(a.y) + e1 * bfhi(b.y) + e2 * bfhi(c.y));
            y.z = pk2(e0 * bflo(a.z) + e1 * bflo(b.z) + e2 * bflo(c.z), e0 * bfhi(a.z) + e1 * bfhi(b.z) + e2 * bfhi(c.z));
            y.w = pk2(e0 * bflo(a.w) + e1 * bflo(b.w) + e2 * bflo(c.w), e0 * bfhi(a.w) + e1 * bfhi(b.w) + e2 * bfhi(c.w));
            *(GAS v4u*)(YAB + tok * YABW + hh * 128 + ch * 8) = y; }
        if (BOTH(3)) GRID_BAR();
    }
    if (IN(4)) {
        pg8::Gemm g{YAB, WAB, M, DM, YABW}; pg8::StaticOrder S; S.init(M, DM, F.G, bx); pg8::EpiMerge E{Gb, MRG, AW / pg8::BK};
        pg8::gemm_phase<pg8::EpiMerge, pg8::StaticOrder, PG8_ALIGN, PG8_SP2>(F.lds + RING_OFF, g, S, E);
        if (BOTH(4)) GRID_BAR();
    }
    if (IN(5)) {
        pg8::Gemm g{MRG, WOUT, M, DM, DM}; pg8::StaticOrder S; S.init(M, DM, F.G, bx); pg8::EpiNorm E{T, DM, SSQ};
        pg8::gemm_phase<pg8::EpiNorm, pg8::StaticOrder, PG8_ALIGN, PG8_SP2>(F.lds + RING_OFF, g, S, E);
        if (BOTH(5)) GRID_BAR();
    }
    if (IN(6)) {
        row_phase<false, true, true>(F, x, T, SSQ, mix_post_g, xa_pre_g, XB, H, gw, NGW);
#define P6_DECODE(r_, J) do { const int r = (r_); if (r < I_UP) J = ConvJob{w_up, WUP, DM, DFF, 0, DM, 0, r, 0, DFF}; else J = ConvJob{w_down, WDN, DFF, DM, 0, DFF, 0, r - I_UP, 0, DM}; } while (0)
        __syncthreads();
        CONV_STREAM(conv_early, I_UP + I_DN, F.ctl + CW_TICKET + 64, P6_DECODE);
        if (BOTH(6)) GRID_BAR();
    }
    if (IN(7)) {
        if (bx < 128) { pg8::Gemm g{H, WXQ, M, XAW, DM}; pg8::SmallOrder S; S.init(M, XAW, 0, bx); pg8::EpiPlain E{QX, XAW};
            pg8::gemm_phase<pg8::EpiPlain, pg8::SmallOrder, false, PG8_SP2>(F.lds + RING_OFF, g, S, E); }
        else if (bx < P7_BUSY) { pg8::Gemm g{MB, WKV, MROWS, 2 * XAW, DM}; pg8::SmallOrder S; S.init(MROWS, 2 * XAW, 128, bx); pg8::EpiPlain E{KVX, 2 * XAW};
            pg8::gemm_phase<pg8::EpiPlain, pg8::SmallOrder, false, PG8_SP2>(F.lds + RING_OFF, g, S, E); }
        else { CONV_STREAM(0, conv_early, F.ctl + CW_TICKET + 128, P6_DECODE); }
#undef P6_DECODE
        if (BOTH(7)) GRID_BAR();
    }
    if (IN(8)) {
        cross_attn_stream(F, QX, KVX, OX);
        if (BOTH(8)) GRID_BAR();
    }
    if (IN(9)) {
        pg8::Gemm g{OX, WXO, M, DM, XAW}; pg8::StaticOrder S; S.init(M, DM, F.G, bx); pg8::EpiNorm E{T, DM, SSQ};
        pg8::gemm_phase<pg8::EpiNorm, pg8::StaticOrder, PG8_ALIGN, PG8_SP2>(F.lds + RING_OFF, g, S, E);
        if (BOTH(9)) GRID_BAR();
    }
    if (IN(10)) {
        row_phase<true, true, true>(F, XB, T, SSQ, xa_post_g, mlp_pre_g, XB, H, gw, NGW);
        if (BOTH(10)) GRID_BAR();
    }
    if (IN(11)) {
        pg8::Gemm g{H, WUP, M, DFF, DM}; pg8::StaticOrder S; S.init(M, DFF, F.G, bx); pg8::EpiRelu2 E{Ab, DFF};
        pg8::gemm_phase<pg8::EpiRelu2, pg8::StaticOrder, false, PG8_SP2>(F.lds + RING_OFF, g, S, E);
        if (BOTH(11)) GRID_BAR();
    }
    if (IN(12)) {
        pg8::Gemm g{Ab, WDN, M, DM, DFF}; pg8::StaticOrder S; S.init(M, DM, F.G, bx); pg8::EpiNorm E{T3, DM, SSQ};
        pg8::gemm_phase<pg8::EpiNorm, pg8::StaticOrder, PG8_ALIGN, PG8_SP2>(F.lds + RING_OFF, g, S, E);
        if (BOTH(12)) GRID_BAR();
    }
    if (IN(13)) {
        row_phase<true, false, false>(F, XB, T3, SSQ, mlp_post_g, nullptr, out, nullptr, gw, NGW);
    }
#undef IN
#undef BOTH
}

extern "C" void kernel_launch(void* const* d_in, const int* in_sizes, int n_in, void* d_out, int out_size, void* d_ws, size_t ws_size, hipStream_t stream) {
    static int grid = 0;
    if (grid == 0) {
        if (n_in != 26 || in_sizes[0] != M * DM || out_size != M * DM || ws_size < WS_END) { fprintf(stderr, "kernel_launch: unexpected shapes (n_in %d, in0 %d, out %d, ws %zu < %zu?); nothing launched\n", n_in, n_in > 0 ? in_sizes[0] : -1, out_size, ws_size, (size_t)WS_END); grid = -1; return; }
        int dev = 0, cus = 0, per_cu = 0;
        if (hipGetDevice(&dev) != hipSuccess || hipDeviceGetAttribute(&cus, hipDeviceAttributeMultiprocessorCount, dev) != hipSuccess) { grid = -1; return; }
        if (hipFuncSetAttribute((const void*)skel_fwd, hipFuncAttributeMaxDynamicSharedMemorySize, LDS_BYTES) != hipSuccess) { fprintf(stderr, "kernel_launch: hipFuncSetAttribute failed\n"); grid = -1; return; }
        if (hipOccupancyMaxActiveBlocksPerMultiprocessor(&per_cu, (const void*)skel_fwd, NWAVES * 64, LDS_BYTES) != hipSuccess || per_cu < 1)
            fprintf(stderr, "kernel_launch: note: occupancy query reports %d workgroups per CU\n", per_cu);
        (void)hipGetLastError();
        grid = cus;
    }
    if (grid < 0) return;
    if (hipMemsetAsync((char*)d_ws + WS_CTL, 0, CTL_ZERO_BYTES, stream) != hipSuccess) return;
    Args a{};
    for (int i = 0; i < 26; ++i) a.in[i] = (const float*)d_in[i];
    a.out = (float*)d_out; a.ws = (unsigned char*)d_ws;
#if MK_PER_PHASE
    for (int li = 0; li < N_PHASES; ++li) { a.ph_lo = li; a.ph_hi = li + 1; a.li = li;
        hipLaunchKernelGGL(skel_fwd, dim3(grid), dim3(NWAVES * 64), LDS_BYTES, stream, a); }
#else
#if defined(PROBE_DUP)
    a.ph_lo = 0; a.ph_hi = PROBE_DUP + 1; a.li = 0;
    hipLaunchKernelGGL(skel_fwd, dim3(grid), dim3(NWAVES * 64), LDS_BYTES, stream, a);
    a.ph_lo = PROBE_DUP; a.ph_hi = N_PHASES; a.li = 1;
    hipLaunchKernelGGL(skel_fwd, dim3(grid), dim3(NWAVES * 64), LDS_BYTES, stream, a);
#else
    a.ph_lo = 0; a.ph_hi = N_PHASES; a.li = 0;
    hipLaunchKernelGGL(skel_fwd, dim3(grid), dim3(NWAVES * 64), LDS_BYTES, stream, a);
#endif
#endif
    const hipError_t le = hipPeekAtLastError();
    if (le != hipSuccess) fprintf(stderr, "kernel_launch: launch failed: %s\n", hipGetErrorName(le));
}
```
